# Optimizing an MI355X kernel written in HIP

```python
import math
import jax, jax.numpy as jnp
from jax import lax
import numpy as np

D_MODEL = 2048
BATCH = 4
SEQ = 4096
DEPTH = 2

N_EVEN = (DEPTH + 1) // 2
N_ODD = DEPTH // 2

SSD_WIDTH = D_MODEL
SSD_HEAD_DIM = 64
SSD_HEADS = SSD_WIDTH // SSD_HEAD_DIM
SSD_GROUPS = 4
SSD_STATE = 128
SSD_CONV = 4
SSD_CHUNK = 256
SSD_CONV_DIM = SSD_WIDTH + 2 * SSD_GROUPS * SSD_STATE

ATT_HEADS = 16
ATT_HEAD_DIM = 128
ATT_WIDTH = ATT_HEADS * ATT_HEAD_DIM
MOBA_BLOCK = 256
MOBA_TOPK = 3
MOBA_Q_CHUNK = 64
ROPE_THETA = 500000.0
ROPE_DIM = ATT_HEAD_DIM // 4

_Z_END = SSD_WIDTH
_XBC_END = _Z_END + SSD_CONV_DIM
_DT_END = _XBC_END + SSD_HEADS
_Q_END = _DT_END + ATT_WIDTH
_K_END = _Q_END + ATT_WIDTH
_V_END = _K_END + ATT_WIDTH
IN0_WIDTH = _V_END + ATT_WIDTH
SPLITS0 = (_Z_END, _XBC_END, _DT_END, _Q_END, _K_END, _V_END)
MIX0_WIDTH = SSD_WIDTH + ATT_WIDTH

S5_WIDTH = D_MODEL
S5_GROUP = 16
S5_GROUPS = S5_WIDTH // S5_GROUP
S5_STATE = 64
S5_SCAN_CHUNK = 128
S5_C_STD = 0.5

DEEPNORM_ALPHA = (2 * DEPTH) ** 0.25
DEEPNORM_BETA = (8 * DEPTH) ** -0.25
LN_EPS = 1e-5
RMS_EPS = 1e-5
NEG_INF = -1e30

kernel_name = 'hybrid_ssd_moba_s5_deepnorm'


def layer_norm(x, g, b):
    xf = x.astype(jnp.float32)
    mu = jnp.mean(xf, axis=-1, keepdims=True)
    var = jnp.mean(jnp.square(xf - mu), axis=-1, keepdims=True)
    y = (xf - mu) * lax.rsqrt(var + LN_EPS) * g.astype(jnp.float32) + b.astype(jnp.float32)
    return y.astype(x.dtype)


def rms_norm(x, g):
    xf = x.astype(jnp.float32)
    return xf * lax.rsqrt(jnp.mean(jnp.square(xf), axis=-1, keepdims=True) + RMS_EPS) * g.astype(jnp.float32)


def causal_depthwise_conv(x, w, b):
    k = w.shape[0]
    y = lax.conv_general_dilated(x, w[:, None, :].astype(x.dtype), window_strides=(1,),
                                 padding=[(k - 1, 0)], dimension_numbers=('NWC', 'WIO', 'NWC'),
                                 feature_group_count=x.shape[-1])
    return y + b.astype(x.dtype)


def segsum(a):
    t = a.shape[-1]
    cs = jnp.cumsum(a, axis=-1)
    diff = cs[..., :, None] - cs[..., None, :]
    return jnp.where(jnp.tril(jnp.ones((t, t), dtype=bool)), diff, -jnp.inf)


def ssd_chunked_scan(x, a, b, c):
    bsz, s, h, p = x.shape
    g, n = b.shape[-2:]
    r = h // g
    pad = (-s) % SSD_CHUNK
    x = jnp.pad(x, ((0, 0), (0, pad), (0, 0), (0, 0)))
    a = jnp.pad(a, ((0, 0), (0, pad), (0, 0)))
    b = jnp.pad(b, ((0, 0), (0, pad), (0, 0), (0, 0)))
    c = jnp.pad(c, ((0, 0), (0, pad), (0, 0), (0, 0)))
    nc, l = (s + pad) // SSD_CHUNK, SSD_CHUNK
    x = x.reshape(bsz, nc, l, g, r, p)
    a = a.reshape(bsz, nc, l, g, r).transpose(0, 3, 4, 1, 2)
    b = b.reshape(bsz, nc, l, g, n)
    c = c.reshape(bsz, nc, l, g, n)
    a_cum = jnp.cumsum(a, axis=-1)
    decay = jnp.exp(segsum(a))
    cb = jnp.einsum('bclgn,bcsgn->bcgls', c, b)
    y_diag = jnp.einsum('bcgls,bgrcls,bcsgrp->bclgrp', cb, decay, x)
    decay_to_end = jnp.exp(a_cum[..., -1:] - a_cum)
    states = jnp.einsum('bclgn,bgrcl,bclgrp->bcgrpn', b, decay_to_end, x)
    states = jnp.concatenate([jnp.zeros_like(states[:, :1]), states], axis=1)
    chunk_decay = jnp.exp(segsum(jnp.pad(a_cum[..., -1], ((0, 0), (0, 0), (0, 0), (1, 0)))))
    states = jnp.einsum('bgrzc,bcgrpn->bzgrpn', chunk_decay, states)[:, :-1]
    y_off = jnp.einsum('bclgn,bcgrpn,bgrcl->bclgrp', c, states, jnp.exp(a_cum))
    y = (y_diag + y_off).reshape(bsz, nc * l, h, p)
    return y[:, :s]


def apply_partial_rotary(x, pos):
    half = ROPE_DIM // 2
    inv_freq = ROPE_THETA ** (-(jnp.arange(half, dtype=jnp.float32) * 2.0 / ROPE_DIM))
    ang = pos.astype(jnp.float32)[:, None] * inv_freq[None, :]
    cos = jnp.cos(ang)[None, :, None, :]
    sin = jnp.sin(ang)[None, :, None, :]
    xr = x[..., :ROPE_DIM].astype(jnp.float32)
    x1, x2 = xr[..., :half], xr[..., half:]
    rot = jnp.concatenate([x1 * cos - x2 * sin, x1 * sin + x2 * cos], axis=-1)
    return jnp.concatenate([rot.astype(x.dtype), x[..., ROPE_DIM:]], axis=-1)


def moba_attention(q, k, v):
    bsz, s, h, dh = q.shape
    s_pad = -(-s // MOBA_BLOCK) * MOBA_BLOCK
    padw = ((0, 0), (0, s_pad - s), (0, 0), (0, 0))
    q, k, v = jnp.pad(q, padw), jnp.pad(k, padw), jnp.pad(v, padw)
    nb = s_pad // MOBA_BLOCK
    n_sel = min(MOBA_TOPK, nb - 1)
    scale = dh ** -0.5
    kb = k.reshape(bsz, nb, MOBA_BLOCK, h, dh).transpose(0, 3, 1, 2, 4)
    vb = v.reshape(bsz, nb, MOBA_BLOCK, h, dh).transpose(0, 3, 1, 2, 4)
    k_mean = jnp.mean(kb.astype(jnp.float32), axis=3)
    b_ix = jnp.arange(bsz)[:, None, None]
    h_ix = jnp.arange(h)[None, None, :]
    blk_ids = jnp.arange(nb)

    def query_chunk(ci):
        start = ci * MOBA_Q_CHUNK
        blk = start // MOBA_BLOCK
        qc = lax.dynamic_slice_in_dim(q, start, MOBA_Q_CHUNK, axis=1).astype(jnp.float32)
        qpos = start + jnp.arange(MOBA_Q_CHUNK)
        blk_start = blk * MOBA_BLOCK
        k_own = lax.dynamic_slice_in_dim(k, blk_start, MOBA_BLOCK, axis=1).astype(jnp.float32)
        v_own = lax.dynamic_slice_in_dim(v, blk_start, MOBA_BLOCK, axis=1).astype(jnp.float32)
        kpos = blk_start + jnp.arange(MOBA_BLOCK)
        s_own = jnp.einsum('bqhd,bkhd->bqhk', qc, k_own) * scale
        causal = (kpos[None, :] <= qpos[:, None])[None, :, None, :]
        s_own = jnp.where(causal, s_own, NEG_INF)
        if n_sel == 0:
            p = jax.nn.softmax(s_own, axis=-1)
            return jnp.einsum('bqhk,bkhd->bqhd', p, v_own).astype(q.dtype)
        gate = jnp.einsum('bqhd,bhnd->bqhn', qc, k_mean)
        gate = jnp.where((blk_ids < blk)[None, None, None, :], gate, NEG_INF)
        _, top_i = lax.top_k(gate, n_sel)
        valid = jnp.arange(n_sel) < blk
        scores = []
        for r in range(n_sel):
            k_r = kb[b_ix, h_ix, top_i[..., r]].astype(jnp.float32)
            s_r = jnp.einsum('bqhd,bqhkd->bqhk', qc, k_r) * scale
            scores.append(jnp.where(valid[r], s_r, NEG_INF))
        scores.append(s_own)
        p = jax.nn.softmax(jnp.concatenate(scores, axis=-1), axis=-1)
        out = jnp.einsum('bqhk,bkhd->bqhd', p[..., n_sel * MOBA_BLOCK:], v_own)
        for r in range(n_sel):
            v_r = vb[b_ix, h_ix, top_i[..., r]].astype(jnp.float32)
            out = out + jnp.einsum('bqhk,bqhkd->bqhd', p[..., r * MOBA_BLOCK:(r + 1) * MOBA_BLOCK], v_r)
        return out.astype(q.dtype)

    out = lax.map(query_chunk, jnp.arange(s_pad // MOBA_Q_CHUNK))
    out = out.transpose(1, 0, 2, 3, 4).reshape(bsz, s_pad, h, dh)
    return out[:, :s]


def ssd_moba_mixer(x, w_in, conv_w, conv_b, dt_bias, a_log, d_skip, norm_g, w_out):
    bsz, s, _ = x.shape
    f32 = jnp.float32
    z, xbc, dt, q, k, v, gate = jnp.split(x @ w_in, SPLITS0, axis=-1)
    xbc = jax.nn.silu(causal_depthwise_conv(xbc, conv_w, conv_b))
    xs, bm, cm = jnp.split(xbc, (SSD_WIDTH, SSD_WIDTH + SSD_GROUPS * SSD_STATE), axis=-1)
    dt = jax.nn.softplus(dt.astype(f32) + dt_bias.astype(f32))
    a = -jnp.exp(a_log.astype(f32))
    xh = xs.astype(f32).reshape(bsz, s, SSD_HEADS, SSD_HEAD_DIM)
    y = ssd_chunked_scan(xh * dt[..., None], dt * a,
                         bm.astype(f32).reshape(bsz, s, SSD_GROUPS, SSD_STATE),
                         cm.astype(f32).reshape(bsz, s, SSD_GROUPS, SSD_STATE))
    y = (y + d_skip.astype(f32)[:, None] * xh).reshape(bsz, s, SSD_WIDTH)
    y_a = rms_norm(y * jax.nn.silu(z.astype(f32)), norm_g).astype(x.dtype)
    pos = jnp.arange(s)
    q = apply_partial_rotary(q.reshape(bsz, s, ATT_HEADS, ATT_HEAD_DIM), pos)
    k = apply_partial_rotary(k.reshape(bsz, s, ATT_HEADS, ATT_HEAD_DIM), pos)
    v = v.reshape(bsz, s, ATT_HEADS, ATT_HEAD_DIM)
    y_b = moba_attention(q, k, v).reshape(bsz, s, ATT_WIDTH) * jax.nn.silu(gate)
    return jnp.concatenate([y_a, y_b], axis=-1) @ w_out


def _linear_recurrence(e1, e2):
    a1, b1 = e1
    a2, b2 = e2
    return a1 * a2, a2 * b1 + b2


def s5_ssm(u, lam_re, lam_im, log_dt, b_re, b_im, c_re, c_im, d_skip):
    bsz, s, w = u.shape
    f32 = jnp.float32
    lam = lax.complex(lam_re.astype(f32), lam_im.astype(f32))
    dt = jnp.exp(log_dt.astype(f32))[:, None]
    lam_bar = jnp.exp(lam * dt)
    b_bar = ((lam_bar - 1.0) / lam)[..., None] * lax.complex(b_re.astype(f32), b_im.astype(f32))
    c_mat = lax.complex(c_re.astype(f32), c_im.astype(f32))
    nch = s // S5_SCAN_CHUNK
    ug = u.astype(f32).reshape(bsz, nch, S5_SCAN_CHUNK, S5_GROUPS, S5_GROUP).transpose(1, 0, 2, 3, 4)

    def step(h, u_blk):
        bu = jnp.einsum('gnm,blgm->blgn', b_bar, u_blk.astype(jnp.complex64))
        bu = bu.at[:, 0].add(lam_bar * h)
        a = jnp.broadcast_to(lam_bar, bu.shape)
        _, hs = lax.associative_scan(_linear_recurrence, (a, bu), axis=1)
        y = jnp.einsum('gmn,blgn->blgm', c_mat, hs).real
        return hs[:, -1], y

    h0 = jnp.zeros((bsz, S5_GROUPS, S5_STATE), jnp.complex64)
    _, ys = lax.scan(step, h0, ug)
    y = ys.transpose(1, 0, 2, 3, 4).reshape(bsz, s, w)
    return (y + d_skip.astype(f32) * u.astype(f32)).astype(u.dtype)


def s5_mixer(x, w_in, lam_re, lam_im, log_dt, b_re, b_im, c_re, c_im, d_skip, w_glu, w_out):
    u, gate = jnp.split(x @ w_in, 2, axis=-1)
    y = jax.nn.gelu(s5_ssm(u, lam_re, lam_im, log_dt, b_re, b_im, c_re, c_im, d_skip))
    ga, gb = jnp.split(y @ w_glu, 2, axis=-1)
    y = ga * jax.nn.sigmoid(gb)
    return (y * jax.nn.silu(gate)) @ w_out


def setup_inputs(seed: int = 0) -> dict:
    key = jax.random.key(seed)
    ks = jax.random.split(key, 24)
    f32 = jnp.float32

    def nrm(k, shape, std):
        return jax.random.normal(k, shape, f32) * std

    x = nrm(ks[0], (BATCH, SEQ, D_MODEL), 1.0)
    in0_w = nrm(ks[1], (N_EVEN, D_MODEL, IN0_WIDTH), D_MODEL ** -0.5)
    conv_w = nrm(ks[2], (N_EVEN, SSD_CONV, SSD_CONV_DIM), SSD_CONV ** -0.5)
    conv_b = nrm(ks[3], (N_EVEN, SSD_CONV_DIM), 0.01)
    dt0 = jnp.exp(jax.random.uniform(ks[4], (N_EVEN, SSD_HEADS), f32, math.log(1e-3), math.log(1e-1)))
    dt_bias = dt0 + jnp.log(-jnp.expm1(-dt0))
    a_log = jnp.log(jax.random.uniform(ks[5], (N_EVEN, SSD_HEADS), f32, 1.0, 16.0))
    ssd_d = 1.0 + nrm(ks[6], (N_EVEN, SSD_HEADS), 0.1)
    ssd_norm_g = 1.0 + nrm(ks[7], (N_EVEN, SSD_WIDTH), 0.02)
    out0_w = nrm(ks[8], (N_EVEN, MIX0_WIDTH, D_MODEL), DEEPNORM_BETA * MIX0_WIDTH ** -0.5)
    in1_w = nrm(ks[9], (N_ODD, D_MODEL, 2 * S5_WIDTH), D_MODEL ** -0.5)
    s5_lam_re = -0.5 + nrm(ks[10], (N_ODD, S5_GROUPS, S5_STATE), 0.01)
    s5_lam_im = math.pi * jnp.arange(S5_STATE, dtype=f32) + nrm(ks[11], (N_ODD, S5_GROUPS, S5_STATE), 0.01)
    s5_log_dt = jax.random.uniform(ks[12], (N_ODD, S5_GROUPS), f32, math.log(1e-3), math.log(1e-1))
    s5_b_re = nrm(ks[13], (N_ODD, S5_GROUPS, S5_STATE, S5_GROUP), (2 * S5_GROUP) ** -0.5)
    s5_b_im = nrm(ks[14], (N_ODD, S5_GROUPS, S5_STATE, S5_GROUP), (2 * S5_GROUP) ** -0.5)
    s5_c_re = nrm(ks[15], (N_ODD, S5_GROUPS, S5_GROUP, S5_STATE), S5_C_STD)
    s5_c_im = nrm(ks[16], (N_ODD, S5_GROUPS, S5_GROUP, S5_STATE), S5_C_STD)
    s5_d = nrm(ks[17], (N_ODD, S5_WIDTH), 1.0)
    glu_w = nrm(ks[18], (N_ODD, S5_WIDTH, 2 * S5_WIDTH), S5_WIDTH ** -0.5)
    out1_w = nrm(ks[19], (N_ODD, S5_WIDTH, D_MODEL), DEEPNORM_BETA * S5_WIDTH ** -0.5)
    ln_g = 1.0 + nrm(ks[20], (DEPTH, D_MODEL), 0.02)
    ln_b = nrm(ks[21], (DEPTH, D_MODEL), 0.02)
    return {'x': x, 'in0_w': in0_w, 'conv_w': conv_w, 'conv_b': conv_b, 'dt_bias': dt_bias,
            'a_log': a_log, 'ssd_d': ssd_d, 'ssd_norm_g': ssd_norm_g, 'out0_w': out0_w,
            'in1_w': in1_w, 's5_lam_re': s5_lam_re, 's5_lam_im': s5_lam_im, 's5_log_dt': s5_log_dt,
            's5_b_re': s5_b_re, 's5_b_im': s5_b_im, 's5_c_re': s5_c_re, 's5_c_im': s5_c_im,
            's5_d': s5_d, 'glu_w': glu_w, 'out1_w': out1_w, 'ln_g': ln_g, 'ln_b': ln_b}


def reference(x, in0_w, conv_w, conv_b, dt_bias, a_log, ssd_d, ssd_norm_g, out0_w,
              in1_w, s5_lam_re, s5_lam_im, s5_log_dt, s5_b_re, s5_b_im, s5_c_re, s5_c_im,
              s5_d, glu_w, out1_w, ln_g, ln_b):
    for layer in range(DEPTH):
        i = layer // 2
        if layer % 2 == 0:
            h = ssd_moba_mixer(x, in0_w[i], conv_w[i], conv_b[i], dt_bias[i], a_log[i],
                               ssd_d[i], ssd_norm_g[i], out0_w[i])
        else:
            h = s5_mixer(x, in1_w[i], s5_lam_re[i], s5_lam_im[i], s5_log_dt[i], s5_b_re[i],
                         s5_b_im[i], s5_c_re[i], s5_c_im[i], s5_d[i], glu_w[i], out1_w[i])
        x = layer_norm(DEEPNORM_ALPHA * x + h, ln_g[layer], ln_b[layer])
    return x
```

```cpp
#include <hip/hip_runtime.h>
#include <hip/hip_cooperative_groups.h>
#include <cstdio>
#include <cstdint>
namespace cg = cooperative_groups;
namespace pg8 {
#define PG8_LAS __attribute__((address_space(3)))
typedef unsigned short bf16_t;
typedef short bf16x8 __attribute__((ext_vector_type(8)));
typedef float f32x4 __attribute__((ext_vector_type(4)));
typedef unsigned u32x4 __attribute__((ext_vector_type(4)));
constexpr int BM = 256, BK = 64, HALF = 128, HTB = HALF * BK * 2  , STAGE_BYTES = 8 * HTB, NXCD = 8, WGM = 8;

__host__ __device__ __forceinline__ int lds_byte(int r, int c) { const int st = (r >> 4) * 2 + (c >> 5), rr = r & 15, cc = c & 31, ob = rr * 64 + cc * 2; return st * 1024 + (ob ^ (((ob >> 9) & 1) << 5)); }
__host__ __device__ __forceinline__ void stage_rc(int b, int& R, int& C) { const int st = b / 1024, sb = b % 1024, swz = sb ^ (((sb >> 9) & 1) << 5); R = (st >> 1) * 16 + swz / 64; C = (st & 1) * 32 + (swz % 64) / 2; }
__host__ __device__ __forceinline__ int perm32(int rho) { const int n = rho >> 4, i = rho & 15; return 8 * (i >> 2) + 4 * n + (i & 3); }

struct Unit { int pm, pn; };
struct Gemm { const bf16_t* A; const bf16_t* Bt; int M, N, K; };

struct StaticOrder {
    int nM, nN, nwg, G, c;
    __host__ __device__ void init(int M, int N, int G_, int c_) { nM = M / BM; nN = N / BM; nwg = nM * nN; G = G_; c = c_; }
    __host__ __device__ bool next(int i, Unit& u) const {
        const long L = (long)i * G + c; if (L >= nwg) return false;
        int wgid = (int)L; { const int q = nwg / NXCD, r = nwg % NXCD, xcd = wgid % NXCD, off = wgid / NXCD; wgid = (xcd < r ? xcd * (q + 1) : r * (q + 1) + (xcd - r) * q) + off; }
        const int nig = WGM * nN, gid = wgid / nig, fm = gid * WGM, gsz = (nM - fm) < WGM ? (nM - fm) : WGM;
        u.pm = fm + ((wgid % nig) % gsz); u.pn = (wgid % nig) / gsz; return true;
    }
    __device__ __forceinline__ void a_ready(const Unit&) const {}
    __device__ __forceinline__ void done(const Unit&) const {}
};
__device__ __forceinline__ unsigned cvt_pk_bf16(float lo, float hi) { unsigned r; asm volatile("v_cvt_pk_bf16_f32 %0, %1, %2" : "=v"(r) : "v"(lo), "v"(hi)); return r; }
template <class Epi, class Sched, bool STAMP = false>
__device__ __forceinline__ void gemm_phase(PG8_LAS unsigned char* lds, const Gemm g, const Sched& S, const Epi& E, unsigned long long* stamps) {
    const int tid = threadIdx.x, wid = __builtin_amdgcn_readfirstlane(tid >> 6), lane = tid & 63, wr = wid >> 2, wc = wid & 3, fr = lane & 15, fq = lane >> 4;
    const int K = g.K, nt = K / BK;
    int ts_lo = 0, ts_hi = 0, nts = 0; const unsigned long long rt_entry = STAMP ? (unsigned long long)wall_clock64() : 0ull;
#define PG8_STAMP() do { if (STAMP && wid == 0 && nts < 64) { const unsigned long long _c = (unsigned long long)clock64(); \
        ts_lo = (lane == nts) ? (int)(unsigned)_c : ts_lo; ts_hi = (lane == nts) ? (int)(unsigned)(_c >> 32) : ts_hi; ++nts; } } while (0)
    PG8_STAMP();
    unsigned voffA[2], voffB[2];
#pragma unroll
    for (int i = 0; i < 2; ++i) { int R, C; stage_rc(tid * 16 + i * 8192, R, C); const int Rb = Epi::PERM ? ((R & ~31) + perm32(R & 31)) : R;
        voffA[i] = (unsigned)(R * K + C) * 2u; voffB[i] = (unsigned)(Rb * K + C) * 2u; }
    const size_t kstep = (size_t)(BK * 2);
    const size_t hstep = (size_t)HALF * K * 2;
    const size_t tstep = 2 * hstep;
    const unsigned ldsw = (unsigned)wid * 1024u;
    const int aoff = lds_byte(wr * 64 + fr, fq * 8), boff = lds_byte(wc * 32 + fr, fq * 8);
#define PG8_SA(b, h) (((b) * 2 + (h)) * HTB)
#define PG8_SB(b, h) ((4 + (b) * 2 + (h)) * HTB)
#define PG8_STAGE(bufoff, gbase, voff) do { _Pragma("unroll") for (int _i = 0; _i < 2; ++_i) \
        __builtin_amdgcn_global_load_lds((const unsigned*)((const char*)(gbase) + (voff)[_i]), (PG8_LAS unsigned*)(lds + (bufoff) + ldsw + _i * 8192), 16, 0, 0); } while (0)
#define PG8_LDA(dst, b, h) do { _Pragma("unroll") for (int m = 0; m < 4; ++m) _Pragma("unroll") for (int k = 0; k < 2; ++k) dst[m][k] = *(const PG8_LAS bf16x8*)(lds + PG8_SA(b, h) + aoff + m * 2048 + k * 1024); } while (0)
#define PG8_LDB(dst, b, h) do { _Pragma("unroll") for (int n = 0; n < 2; ++n) _Pragma("unroll") for (int k = 0; k < 2; ++k) dst[n][k] = *(const PG8_LAS bf16x8*)(lds + PG8_SB(b, h) + boff + n * 2048 + k * 1024); } while (0)
#define PG8_MMA(ai, bj, At, Bt) do { __builtin_amdgcn_s_setprio(1); _Pragma("unroll") for (int m = 0; m < 4; ++m) _Pragma("unroll") for (int n = 0; n < 2; ++n) _Pragma("unroll") for (int k = 0; k < 2; ++k) \
        acc[ai][bj][m][n] = __builtin_amdgcn_mfma_f32_16x16x32_bf16(Bt[n][k], At[m][k], acc[ai][bj][m][n], 0, 0, 0); __builtin_amdgcn_s_setprio(0); } while (0)
#define PG8_WAIT_V(n) asm volatile("s_waitcnt vmcnt(" #n ")" ::: "memory")
#define PG8_WAIT_L(n) asm volatile("s_waitcnt lgkmcnt(" #n ")" ::: "memory")
#define PG8_BAR __builtin_amdgcn_s_barrier()
#define PG8_SCHED __builtin_amdgcn_sched_barrier(0)
    Unit cur, nxt; int ui = 0;
    if (!S.next(0, cur)) return;
    f32x4 acc[2][2][4][2];
#pragma unroll
    for (int a = 0; a < 2; ++a)
#pragma unroll
        for (int b = 0; b < 2; ++b)
#pragma unroll
            for (int m = 0; m < 4; ++m)
#pragma unroll
                for (int n = 0; n < 2; ++n) acc[a][b][m][n] = (f32x4){0.f, 0.f, 0.f, 0.f};
    bf16x8 At[4][2], B0[2][2], B1[2][2];
    const char* cA = (const char*)g.A + (size_t)cur.pm * tstep; const char* cB = (const char*)g.Bt + (size_t)cur.pn * tstep;
    S.a_ready(cur);
    PG8_STAGE(PG8_SB(0, 0), cB, voffB); PG8_STAGE(PG8_SA(0, 0), cA, voffA); PG8_STAGE(PG8_SB(0, 1), cB + hstep, voffB); PG8_STAGE(PG8_SA(0, 1), cA + hstep, voffA);
    if (wr == 1) PG8_BAR;
    PG8_WAIT_V(4); PG8_BAR;
    PG8_STAGE(PG8_SB(1, 0), cB + kstep, voffB); PG8_STAGE(PG8_SA(1, 0), cA + kstep, voffA); PG8_STAGE(PG8_SB(1, 1), cB + hstep + kstep, voffB);
    PG8_WAIT_V(6); PG8_BAR;
    PG8_STAMP();
    for (;;) {
        const bool has_next = S.next(ui + 1, nxt);
        const char* nA = has_next ? (const char*)g.A + (size_t)nxt.pm * tstep : cA; const char* nB = has_next ? (const char*)g.Bt + (size_t)nxt.pn * tstep : cB;
        for (int t = 0; t < nt; t += 2) {
            if constexpr (Epi::MID >= 0) { if (t == Epi::MID) E.mid(acc, cur, ui, wr, wc, fr, fq); }
            const bool last = (t == nt - 2);
            const char* a1 = cA + (size_t)(t + 1) * kstep;
            const char* a2 = last ? nA : cA + (size_t)(t + 2) * kstep; const char* b2 = last ? nB : cB + (size_t)(t + 2) * kstep;
            const char* a3 = a2 + kstep; const char* b3 = b2 + kstep;
            if (last && has_next) S.a_ready(nxt);
            PG8_LDB(B0, 0, 0); PG8_SCHED; PG8_LDA(At, 0, 0); PG8_STAGE(PG8_SA(1, 1), a1 + hstep, voffA);
            PG8_WAIT_L(8); PG8_BAR; PG8_WAIT_L(0); PG8_MMA(0, 0, At, B0); PG8_BAR; PG8_SCHED;
            PG8_LDB(B1, 0, 1); PG8_STAGE(PG8_SB(0, 0), b2, voffB);
            PG8_BAR; PG8_WAIT_L(0); PG8_MMA(0, 1, At, B1); PG8_BAR;
            PG8_LDA(At, 0, 1); PG8_STAGE(PG8_SA(0, 0), a2, voffA);
            PG8_BAR; PG8_WAIT_L(0); PG8_MMA(1, 0, At, B0); PG8_BAR; PG8_SCHED;
            PG8_STAGE(PG8_SB(0, 1), b2 + hstep, voffB);
            PG8_WAIT_V(6); PG8_BAR; PG8_MMA(1, 1, At, B1); PG8_BAR;
            PG8_LDB(B0, 1, 0); PG8_SCHED; PG8_LDA(At, 1, 0); PG8_STAGE(PG8_SA(0, 1), a2 + hstep, voffA);
            PG8_WAIT_L(8); PG8_BAR; PG8_WAIT_L(0); PG8_MMA(0, 0, At, B0); PG8_BAR; PG8_SCHED;
            PG8_LDB(B1, 1, 1); PG8_STAGE(PG8_SB(1, 0), b3, voffB);
            PG8_BAR; PG8_WAIT_L(0); PG8_MMA(0, 1, At, B1); PG8_BAR;
            PG8_LDA(At, 1, 1); PG8_STAGE(PG8_SA(1, 0), a3, voffA);
            PG8_BAR; PG8_WAIT_L(0); PG8_MMA(1, 0, At, B0); PG8_BAR; PG8_SCHED;
            PG8_STAGE(PG8_SB(1, 1), b3 + hstep, voffB);
            PG8_WAIT_V(6); PG8_BAR; PG8_MMA(1, 1, At, B1); PG8_BAR;
        }
        PG8_STAMP();
        if constexpr (!Epi::AFTER_DRAIN) { E(acc, cur, wr, wc, fr, fq); S.done(cur); }
        PG8_STAMP();
        if (!has_next) break;
#pragma unroll
        for (int a = 0; a < 2; ++a)
#pragma unroll
            for (int b = 0; b < 2; ++b)
#pragma unroll
                for (int m = 0; m < 4; ++m)
#pragma unroll
                    for (int n = 0; n < 2; ++n) acc[a][b][m][n] = (f32x4){0.f, 0.f, 0.f, 0.f};
        cur = nxt; cA = nA; cB = nB; ++ui;
    }
    PG8_WAIT_V(0);
    if (wr == 0) PG8_BAR;
    PG8_BAR;
    if constexpr (Epi::AFTER_DRAIN) { E.fused(acc, cur, wr, wc, fr, fq, lds, wid, lane); S.done(cur); }
    PG8_STAMP();
    if (STAMP && wid == 0) { stamps[lane] = lane < nts ? (((unsigned long long)(unsigned)ts_hi << 32) | (unsigned)ts_lo) : 0ull;
        if (lane == 62) stamps[62] = rt_entry; if (lane == 63) stamps[63] = (unsigned long long)wall_clock64(); }
#undef PG8_STAMP
#undef PG8_SA
#undef PG8_SB
#undef PG8_STAGE
#undef PG8_LDA
#undef PG8_LDB
#undef PG8_MMA
#undef PG8_WAIT_V
#undef PG8_WAIT_L
#undef PG8_BAR
#undef PG8_SCHED
}
}

using pg8::bf16_t; using pg8::bf16x8; using pg8::f32x4; using pg8::u32x4; using pg8::Unit;
#define LAS __attribute__((address_space(3)))
typedef short s16x4 __attribute__((ext_vector_type(4)));
typedef short v4i16_t __attribute__((ext_vector_type(4)));
typedef unsigned u32x2 __attribute__((ext_vector_type(2)));
typedef LAS unsigned char* ldsp;

constexpr int M = 16384, DM = 2048, SEQ = 4096;
constexpr int N0P = 13568;
constexpr float ALPHA = 1.41421356237309515f;
constexpr int LDS_BYTES = 131072 + 8192;

constexpr size_t OFF_XB = 0;
constexpr size_t OFF_W0T = 67108864;
constexpr size_t OFF_RB = 122683392;
constexpr size_t OFF_SIN = OFF_RB + 67108864;
constexpr size_t OFF_K = 223346688;
constexpr size_t OFF_V = 290455552;
constexpr size_t OFF_G = 357564416;
constexpr size_t OFF_WO0 = 424673280;
constexpr size_t OFF_W1 = 441450496;
constexpr size_t OFF_WG = 458227712;
constexpr size_t OFF_WO1 = 475004928;
constexpr size_t OFF_DT = 483393536;
constexpr size_t OFF_CUM = 485490688;
constexpr size_t OFF_SSQ = 487587840;
constexpr size_t OFF_KM = 489684992;
constexpr size_t OFF_CT = 490209280;
constexpr size_t OFF_STB = 490471424;
constexpr size_t WS_END = 490733568;

struct Params {
    const float *x, *in0_w, *conv_w, *conv_b, *dt_bias, *a_log, *ssd_d, *ssd_norm_g, *out0_w, *in1_w,
                *lam_re, *lam_im, *log_dt, *b_re, *b_im, *c_re, *c_im, *s5_d, *glu_w, *out1_w, *ln_g, *ln_b;
    float* out; unsigned char* ws;
};

__constant__ float INVF[16] = {1.000000000e+00f, 4.403665960e-01f, 1.939227432e-01f, 8.539710194e-02f, 3.760603070e-02f, 1.656043902e-02f, 7.292664610e-03f, 3.211445874e-03f,
                               1.414213562e-03f, 6.227723788e-04f, 2.742481884e-04f, 1.207697351e-04f, 5.318296098e-05f, 2.341999971e-05f, 1.031338616e-05f, 4.541670478e-06f};

#define LDS_WAIT() asm volatile("s_waitcnt lgkmcnt(0)" ::: "memory")
__device__ __forceinline__ unsigned pk2(float lo, float hi) { return pg8::cvt_pk_bf16(lo, hi); }
__device__ __forceinline__ float bf_lo(unsigned u) { return __uint_as_float(u << 16); }
__device__ __forceinline__ float bf_hi(unsigned u) { return __uint_as_float(u & 0xffff0000u); }
__device__ __forceinline__ float bf1(bf16_t h) { return __uint_as_float(((unsigned)h) << 16); }
__device__ __forceinline__ float silu_f(float v) { return v / (1.f + __expf(-v)); }
__device__ __forceinline__ float sigmoid_f(float v) { return 1.f / (1.f + __expf(-v)); }
__device__ __forceinline__ float softplus_f(float v) { return fmaxf(v, 0.f) + log1pf(__expf(-fabsf(v))); }
__device__ __forceinline__ float gelu_tanh_f(float v) { const float u = 0.7978845608028654f * (v + 0.044715f * v * v * v); const float t = 1.f - 2.f / (1.f + __expf(2.f * u)); return 0.5f * v * (1.f + t); }
__device__ __forceinline__ s16x4 vtr(const LAS unsigned char* p) { return __builtin_bit_cast(s16x4, __builtin_amdgcn_ds_read_tr16_b64_v4i16((LAS v4i16_t*)p)); }
__device__ __forceinline__ bf16x8 cat8(s16x4 lo, s16x4 hi) { return __builtin_shufflevector(lo, hi, 0, 1, 2, 3, 4, 5, 6, 7); }
__device__ __forceinline__ f32x4 mfma16(bf16x8 a, bf16x8 b, f32x4 c) { return __builtin_amdgcn_mfma_f32_16x16x32_bf16(a, b, c, 0, 0, 0); }
__device__ __forceinline__ void sincos_d(double a, float& s, float& c) {
    const double k = rint(a * 0.63661977236758134308);
    double r = fma(-k, 1.57079632679489661923, a); r = fma(-k, 6.123233995736766e-17, r);
    const double r2 = r * r;
    const double sp = r * (1.0 + r2 * (-1.0 / 6.0 + r2 * (1.0 / 120.0 + r2 * (-1.0 / 5040.0 + r2 * (1.0 / 362880.0 + r2 * (-1.0 / 39916800.0 + r2 * (1.0 / 6227020800.0)))))));
    const double cp = 1.0 + r2 * (-0.5 + r2 * (1.0 / 24.0 + r2 * (-1.0 / 720.0 + r2 * (1.0 / 40320.0 + r2 * (-1.0 / 3628800.0 + r2 * (1.0 / 479001600.0 + r2 * (-1.0 / 87178291200.0)))))));
    const int q = ((int)k) & 3;
    const double ss = (q == 0) ? sp : (q == 1) ? cp : (q == 2) ? -sp : -cp;
    const double cc = (q == 0) ? cp : (q == 1) ? -sp : (q == 2) ? -cp : sp;
    s = (float)ss; c = (float)cc;
}

struct EpiIn0 {
    static constexpr bool PERM = false, AFTER_DRAIN = false; static constexpr int MID = -1;
    bf16_t *A0, *XBCraw, *Kb, *Vb, *Gb; float *DTf, *kmean; const float *ctab, *stab, *dt_bias;
    __device__ __forceinline__ void mid(f32x4 (&)[2][2][4][2], const Unit&, int, int, int, int, int) const {}
    __device__ __forceinline__ void operator()(const f32x4 (&acc)[2][2][4][2], const Unit& u, int wr, int wc, int fr, int fq) const {
        const int pn = u.pn, rowb = u.pm * 256 + wr * 64 + fr, colw = wc * 32 + 4 * fq;
        if (pn >= 52) {
            if (pn == 52 && wc == 0) {
#pragma unroll
                for (int ai = 0; ai < 2; ++ai)
#pragma unroll
                    for (int m = 0; m < 4; ++m) { const int row = rowb + ai * 128 + m * 16;
#pragma unroll
                        for (int n = 0; n < 2; ++n) { const f32x4 v = acc[ai][0][m][n]; const f32x4 bb = *(const f32x4*)(dt_bias + 16 * n + 4 * fq); f32x4 r;
                            r[0] = softplus_f(v[0] + bb[0]); r[1] = softplus_f(v[1] + bb[1]); r[2] = softplus_f(v[2] + bb[2]); r[3] = softplus_f(v[3] + bb[3]);
                            *(f32x4*)(DTf + (size_t)row * 32 + 16 * n + 4 * fq) = r; } }
            }
            return;
        }
        bf16_t* dst; int ld; int mode;
        if (pn < 8) { dst = A0 + 256 * pn; ld = 4096; mode = 0; }
        else if (pn < 20) { dst = XBCraw + 256 * (pn - 8); ld = 3072; mode = 0; }
        else if (pn < 28) { dst = A0 + 2048 + 256 * (pn - 20); ld = 4096; mode = 1; }
        else if (pn < 36) { dst = Kb + 256 * (pn - 28); ld = 2048; mode = 2; }
        else if (pn < 44) { dst = Vb + 256 * (pn - 36); ld = 2048; mode = 0; }
        else { dst = Gb + 256 * (pn - 44); ld = 2048; mode = 3; }
        const bool rot = (mode == 1 || mode == 2) && (wc == 0);
        f32x4 cs[2][2];
#pragma unroll
        for (int bj = 0; bj < 2; ++bj)
#pragma unroll
            for (int n = 0; n < 2; ++n) cs[bj][n] = (f32x4){0.f, 0.f, 0.f, 0.f};
#pragma unroll
        for (int ai = 0; ai < 2; ++ai)
#pragma unroll
            for (int m = 0; m < 4; ++m) { const int row = rowb + ai * 128 + m * 16; f32x4 v[2][2];
#pragma unroll
                for (int bj = 0; bj < 2; ++bj)
#pragma unroll
                    for (int n = 0; n < 2; ++n) v[bj][n] = acc[ai][bj][m][n];
                if (rot) { const int pos = row & (SEQ - 1); const f32x4 cv = *(const f32x4*)(ctab + pos * 16 + 4 * fq), sv = *(const f32x4*)(stab + pos * 16 + 4 * fq);
#pragma unroll
                    for (int bj = 0; bj < 2; ++bj) { const f32x4 x1 = v[bj][0], x2 = v[bj][1]; v[bj][0] = x1 * cv - x2 * sv; v[bj][1] = x1 * sv + x2 * cv; } }
                if (mode == 2) {
#pragma unroll
                    for (int bj = 0; bj < 2; ++bj)
#pragma unroll
                        for (int n = 0; n < 2; ++n) cs[bj][n] += v[bj][n]; }
                if (mode == 3) {
#pragma unroll
                    for (int bj = 0; bj < 2; ++bj)
#pragma unroll
                        for (int n = 0; n < 2; ++n)
#pragma unroll
                            for (int j = 0; j < 4; ++j) v[bj][n][j] = silu_f(v[bj][n][j]); }
                bf16_t* rp = dst + (size_t)row * ld + colw;
#pragma unroll
                for (int bj = 0; bj < 2; ++bj)
#pragma unroll
                    for (int n = 0; n < 2; ++n) { u32x2 o; o.x = pk2(v[bj][n][0], v[bj][n][1]); o.y = pk2(v[bj][n][2], v[bj][n][3]); *(u32x2*)(rp + bj * 128 + n * 16) = o; }
            }
        if (mode == 2) {
#pragma unroll
            for (int bj = 0; bj < 2; ++bj)
#pragma unroll
                for (int n = 0; n < 2; ++n)
#pragma unroll
                    for (int j = 0; j < 4; ++j) { float s = cs[bj][n][j]; s += __shfl_xor(s, 1); s += __shfl_xor(s, 2); s += __shfl_xor(s, 4); s += __shfl_xor(s, 8); cs[bj][n][j] = s; }
            if (fr == 0) { const int b = u.pm >> 4, blk = u.pm & 15;
#pragma unroll
                for (int bj = 0; bj < 2; ++bj) { const int head = 2 * (pn - 28) + bj; float* kp = kmean + ((size_t)((b * 16 + head) * 16 + blk)) * 128 + colw;
#pragma unroll
                    for (int n = 0; n < 2; ++n)
#pragma unroll
                        for (int j = 0; j < 4; ++j) __hip_atomic_fetch_add(kp + n * 16 + j, cs[bj][n][j], __ATOMIC_RELAXED, __HIP_MEMORY_SCOPE_AGENT); } }
        }
    }
};
struct EpiIn1 {
    static constexpr bool PERM = false, AFTER_DRAIN = false; static constexpr int MID = -1;
    bf16_t *U, *SG;
    __device__ __forceinline__ void mid(f32x4 (&)[2][2][4][2], const Unit&, int, int, int, int, int) const {}
    __device__ __forceinline__ void operator()(const f32x4 (&acc)[2][2][4][2], const Unit& u, int wr, int wc, int fr, int fq) const {
        const int pn = u.pn, rowb = u.pm * 256 + wr * 64 + fr, colw = wc * 32 + 4 * fq; const bool sg = pn >= 8;
        bf16_t* dst = sg ? SG + 256 * (pn - 8) : U + 256 * pn;
#pragma unroll
        for (int ai = 0; ai < 2; ++ai)
#pragma unroll
            for (int m = 0; m < 4; ++m) { bf16_t* rp = dst + (size_t)(rowb + ai * 128 + m * 16) * 2048 + colw;
#pragma unroll
                for (int bj = 0; bj < 2; ++bj)
#pragma unroll
                    for (int n = 0; n < 2; ++n) { f32x4 v = acc[ai][bj][m][n];
                        if (sg) { v[0] = silu_f(v[0]); v[1] = silu_f(v[1]); v[2] = silu_f(v[2]); v[3] = silu_f(v[3]); }
                        u32x2 o; o.x = pk2(v[0], v[1]); o.y = pk2(v[2], v[3]); *(u32x2*)(rp + bj * 128 + n * 16) = o; } }
    }
};
struct EpiGlu {
    static constexpr bool PERM = false, AFTER_DRAIN = false; static constexpr int MID = -1;
    bf16_t* A1; const bf16_t* SG;
    __device__ __forceinline__ void mid(f32x4 (&)[2][2][4][2], const Unit&, int, int, int, int, int) const {}
    __device__ __forceinline__ void operator()(const f32x4 (&acc)[2][2][4][2], const Unit& u, int wr, int wc, int fr, int fq) const {
        const int rowb = u.pm * 256 + wr * 64 + fr, colb = u.pn * 128 + wc * 32 + 4 * fq;
#pragma unroll
        for (int ai = 0; ai < 2; ++ai)
#pragma unroll
            for (int m = 0; m < 4; ++m) { const size_t ro = (size_t)(rowb + ai * 128 + m * 16) * 2048 + colb;
#pragma unroll
                for (int n = 0; n < 2; ++n) { const f32x4 ga = acc[ai][0][m][n], gb = acc[ai][1][m][n]; const u32x2 s = *(const u32x2*)(SG + ro + n * 16);
                    const float o0 = ga[0] * sigmoid_f(gb[0]) * bf_lo(s.x), o1 = ga[1] * sigmoid_f(gb[1]) * bf_hi(s.x), o2 = ga[2] * sigmoid_f(gb[2]) * bf_lo(s.y), o3 = ga[3] * sigmoid_f(gb[3]) * bf_hi(s.y);
                    u32x2 o; o.x = pk2(o0, o1); o.y = pk2(o2, o3); *(u32x2*)(A1 + ro + n * 16) = o; } }
    }
};
template <int MIDK> struct EpiOut {
    static constexpr bool PERM = false, AFTER_DRAIN = false; static constexpr int MID = MIDK;
    const float* resid; float* Y; const LAS float* rsl;
    __device__ __forceinline__ void mid(f32x4 (&acc)[2][2][4][2], const Unit& u, int ui, int wr, int wc, int fr, int fq) const {
        const LAS float* rp = rsl + ui * 256 + wr * 64 + fr;
#pragma unroll
        for (int ai = 0; ai < 2; ++ai)
#pragma unroll
            for (int m = 0; m < 4; ++m) { const float rs = rp[ai * 128 + m * 16];
#pragma unroll
                for (int bj = 0; bj < 2; ++bj)
#pragma unroll
                    for (int n = 0; n < 2; ++n) acc[ai][bj][m][n] *= rs; }
    }
    __device__ __forceinline__ void operator()(const f32x4 (&acc)[2][2][4][2], const Unit& u, int wr, int wc, int fr, int fq) const {
        const int rowb = u.pm * 256 + wr * 64 + fr, colb = u.pn * 256 + wc * 32 + 4 * fq;
#pragma unroll
        for (int ai = 0; ai < 2; ++ai)
#pragma unroll
            for (int m = 0; m < 4; ++m) { const size_t ro = (size_t)(rowb + ai * 128 + m * 16) * 2048 + colb;
#pragma unroll
                for (int bj = 0; bj < 2; ++bj)
#pragma unroll
                    for (int n = 0; n < 2; ++n) { const f32x4 r = *(const f32x4*)(resid + ro + bj * 128 + n * 16); *(f32x4*)(Y + ro + bj * 128 + n * 16) = r * ALPHA + acc[ai][bj][m][n]; } }
    }
};

__device__ __forceinline__ void transpose_item(const float* W, int Nsrc, int nsrc0, bf16_t* WT, int Kdim, int k0, int ndst0, const float* kscale, LAS float* scr, int lane) {
    if (nsrc0 >= 0) {
#pragma unroll 8
        for (int i = 0; i < 32; ++i) { const int kk = 2 * i + (lane >> 5); float v = W[(size_t)(k0 + kk) * Nsrc + nsrc0 + (lane & 31)]; if (kscale) v *= kscale[k0 + kk]; scr[kk * 33 + (lane & 31)] = v; }
    } else {
#pragma unroll 8
        for (int i = 0; i < 32; ++i) { const int kk = 2 * i + (lane >> 5); scr[kk * 33 + (lane & 31)] = 0.f; }
    }
    LDS_WAIT();
    const int c = lane & 7;
#pragma unroll
    for (int j = 0; j < 4; ++j) { const int n = (lane >> 3) + 8 * j; const LAS float* s = scr + (8 * c) * 33 + n;
        u32x4 o; o.x = pk2(s[0 * 33], s[1 * 33]); o.y = pk2(s[2 * 33], s[3 * 33]); o.z = pk2(s[4 * 33], s[5 * 33]); o.w = pk2(s[6 * 33], s[7 * 33]);
        *(u32x4*)(WT + (size_t)(ndst0 + n) * Kdim + k0 + 8 * c) = o; }
    LDS_WAIT();
}
__device__ __forceinline__ void p0_phase(const Params& P, ldsp lds) {
    const int tid = threadIdx.x, wave = __builtin_amdgcn_readfirstlane(tid >> 6), lane = tid & 63;
    const int gw = blockIdx.x * 8 + wave, NGW = gridDim.x * 8;
    const size_t gtid = (size_t)blockIdx.x * 512 + tid, nth = (size_t)gridDim.x * 512;
    unsigned char* ws = P.ws;
    LAS float* scr = (LAS float*)(lds + wave * 8704);
    constexpr int I0 = 32 * 424, I1 = 64 * 64, I2 = 32 * 128, I3 = 32 * 128, I4 = 32 * 64;
    for (int it = gw; it < I0 + I1 + I2 + I3 + I4; it += NGW) {
        int r = it;
        if (r < I0) { const int kb = r / 424, nb = r % 424, nd = 32 * nb; const int ns = nd < 5120 ? nd : (nd < 13312 ? nd + 32 : (nd == 13312 ? 5120 : -1));
            transpose_item(P.in0_w, 13344, ns, (bf16_t*)(ws + OFF_W0T), 2048, 64 * kb, nd, nullptr, scr, lane); continue; } r -= I0;
        if (r < I1) { const int kb = r / 64, nb = r % 64; transpose_item(P.out0_w, 2048, 32 * nb, (bf16_t*)(ws + OFF_WO0), 4096, 64 * kb, 32 * nb, kb < 32 ? P.ssd_norm_g : nullptr, scr, lane); continue; } r -= I1;
        if (r < I2) { const int kb = r / 128, nb = r % 128; transpose_item(P.in1_w, 4096, 32 * nb, (bf16_t*)(ws + OFF_W1), 2048, 64 * kb, 32 * nb, nullptr, scr, lane); continue; } r -= I2;
        if (r < I3) { const int kb = r / 128, nb = r % 128, nd = 32 * nb; const int ns = ((nd >> 7) & 1) * 2048 + 128 * (nd >> 8) + (nd & 127);
            transpose_item(P.glu_w, 4096, ns, (bf16_t*)(ws + OFF_WG), 2048, 64 * kb, nd, nullptr, scr, lane); continue; } r -= I3;
        { const int kb = r / 64, nb = r % 64; transpose_item(P.out1_w, 2048, 32 * nb, (bf16_t*)(ws + OFF_WO1), 2048, 64 * kb, 32 * nb, nullptr, scr, lane); }
    }
    { const f32x4* xs = (const f32x4*)P.x; u32x2* xd = (u32x2*)(ws + OFF_XB);
      for (size_t i = gtid; i < (size_t)M * DM / 4; i += nth) { const f32x4 v = xs[i]; u32x2 o; o.x = pk2(v[0], v[1]); o.y = pk2(v[2], v[3]); xd[i] = o; } }
    { float* ct = (float*)(ws + OFF_CT); float* st = (float*)(ws + OFF_STB);
      for (size_t i = gtid; i < 4096 * 16; i += nth) { const int pos = (int)(i >> 4), k = (int)(i & 15); const float ang = (float)pos * INVF[k]; float s, c; sincos_d((double)ang, s, c); ct[i] = c; st[i] = s; } }
    { float* km = (float*)(ws + OFF_KM); for (size_t i = gtid; i < 4 * 16 * 16 * 128; i += nth) km[i] = 0.f; }
}

__device__ __forceinline__ void conv_phase(const Params& P) {
    const int tid = threadIdx.x, wave = __builtin_amdgcn_readfirstlane(tid >> 6), lane = tid & 63;
    const size_t gtid = (size_t)blockIdx.x * 512 + tid, nth = (size_t)gridDim.x * 512;
    const bf16_t* XR = (const bf16_t*)(P.ws + OFF_RB); bf16_t* X2 = (bf16_t*)(P.ws + OFF_XB);
    for (size_t it = gtid; it < (size_t)1024 * 384; it += nth) {
        const int tb = (int)(it / 384), cc = (int)(it % 384), t0 = tb * 16, ch = cc * 8;
        float w[4][8], bb[8];
#pragma unroll
        for (int j = 0; j < 4; ++j) { const f32x4 a = *(const f32x4*)(P.conv_w + j * 3072 + ch), b = *(const f32x4*)(P.conv_w + j * 3072 + ch + 4);
            w[j][0] = a[0]; w[j][1] = a[1]; w[j][2] = a[2]; w[j][3] = a[3]; w[j][4] = b[0]; w[j][5] = b[1]; w[j][6] = b[2]; w[j][7] = b[3]; }
        { const f32x4 a = *(const f32x4*)(P.conv_b + ch), b = *(const f32x4*)(P.conv_b + ch + 4); bb[0] = a[0]; bb[1] = a[1]; bb[2] = a[2]; bb[3] = a[3]; bb[4] = b[0]; bb[5] = b[1]; bb[6] = b[2]; bb[7] = b[3]; }
        const bool first = (t0 & (SEQ - 1)) == 0;
        u32x4 raw[19];
#pragma unroll
        for (int r = 0; r < 19; ++r) { if (r < 3 && first) raw[r] = (u32x4){0u, 0u, 0u, 0u}; else raw[r] = *(const u32x4*)(XR + (size_t)(t0 - 3 + r) * 3072 + ch); }
#pragma unroll
        for (int r = 0; r < 16; ++r) { float o[8];
#pragma unroll
            for (int e = 0; e < 8; ++e) o[e] = bb[e];
#pragma unroll
            for (int j = 0; j < 4; ++j) { const u32x4 q = raw[r + j];
                o[0] += w[j][0] * bf_lo(q.x); o[1] += w[j][1] * bf_hi(q.x); o[2] += w[j][2] * bf_lo(q.y); o[3] += w[j][3] * bf_hi(q.y);
                o[4] += w[j][4] * bf_lo(q.z); o[5] += w[j][5] * bf_hi(q.z); o[6] += w[j][6] * bf_lo(q.w); o[7] += w[j][7] * bf_hi(q.w); }
#pragma unroll
            for (int e = 0; e < 8; ++e) o[e] = silu_f(o[e]);
            u32x4 ov; ov.x = pk2(o[0], o[1]); ov.y = pk2(o[2], o[3]); ov.z = pk2(o[4], o[5]); ov.w = pk2(o[6], o[7]);
            *(u32x4*)(X2 + (size_t)(t0 + r) * 3072 + ch) = ov; }
    }
    const float* DTf = (const float*)(P.ws + OFF_DT); float* CUM = (float*)(P.ws + OFF_CUM);
    for (int it = blockIdx.x * 8 + wave; it < 2048; it += gridDim.x * 8) {
        const int b = it >> 9, c = (it >> 5) & 15, h = it & 31; const size_t rowbase = (size_t)b * 4096 + c * 256 + 4 * lane;
        const float Ah = -__expf(P.a_log[h]);
        const float a0 = DTf[(rowbase + 0) * 32 + h] * Ah, a1 = DTf[(rowbase + 1) * 32 + h] * Ah, a2 = DTf[(rowbase + 2) * 32 + h] * Ah, a3 = DTf[(rowbase + 3) * 32 + h] * Ah;
        const float s0 = a0, s1 = s0 + a1, s2 = s1 + a2, s3 = s2 + a3;
        float x = s3;
#pragma unroll
        for (int o = 1; o < 64; o <<= 1) { const float t = __shfl_up(x, o); if (lane >= o) x += t; }
        const float off = x - s3;
        CUM[(rowbase + 0) * 32 + h] = off + s0; CUM[(rowbase + 1) * 32 + h] = off + s1; CUM[(rowbase + 2) * 32 + h] = off + s2; CUM[(rowbase + 3) * 32 + h] = off + s3;
    }
}

__device__ __forceinline__ void ssd_a_phase(const Params& P, ldsp lds) {
    const int tid = threadIdx.x, wave = __builtin_amdgcn_readfirstlane(tid >> 6), lane = tid & 63, quad = lane >> 4, li = lane & 15, qq = li >> 2, pp = li & 3;
    const bf16_t* X2 = (const bf16_t*)(P.ws + OFF_XB); const float* DTf = (const float*)(P.ws + OFF_DT); const float* CUM = (const float*)(P.ws + OFF_CUM); float* ST = (float*)(P.ws + OFF_RB);
    ldsp Bl = lds, Xl = lds + 69632;
    for (int item = blockIdx.x; item < 256; item += gridDim.x) {
        const int b = item >> 6, c = (item >> 2) & 15, g = item & 3; const size_t rowbase = (size_t)b * 4096 + c * 256;
        __syncthreads();
#pragma unroll
        for (int k = 0; k < 8; ++k) { const int idx = tid + 512 * k, r = idx >> 4, ch = idx & 15; *(LAS u32x4*)(Bl + r * 272 + ch * 16) = *(const u32x4*)(X2 + (rowbase + r) * 3072 + 2048 + g * 128 + ch * 8); }
        for (int hh = 0; hh < 8; ++hh) { const int h = g * 8 + hh;
            __syncthreads();
            const float cl = CUM[(rowbase + 255) * 32 + h];
#pragma unroll
            for (int k = 0; k < 4; ++k) { const int idx = tid + 512 * k, r = idx >> 3, ch = idx & 7; const size_t row = rowbase + r;
                const float w = __expf(cl - CUM[row * 32 + h]) * DTf[row * 32 + h]; const u32x4 v = *(const u32x4*)(X2 + row * 3072 + h * 64 + ch * 8); u32x4 o;
                o.x = pk2(bf_lo(v.x) * w, bf_hi(v.x) * w); o.y = pk2(bf_lo(v.y) * w, bf_hi(v.y) * w); o.z = pk2(bf_lo(v.z) * w, bf_hi(v.z) * w); o.w = pk2(bf_lo(v.w) * w, bf_hi(v.w) * w);
                *(LAS u32x4*)(Xl + r * 160 + ch * 16) = o; }
            __syncthreads();
            f32x4 acc[4];
#pragma unroll
            for (int pt = 0; pt < 4; ++pt) acc[pt] = (f32x4){0.f, 0.f, 0.f, 0.f};
#pragma unroll
            for (int ks = 0; ks < 8; ++ks) { const int l0 = 32 * ks + 8 * quad + qq;
                const bf16x8 bop = cat8(vtr(Bl + l0 * 272 + (16 * wave + 4 * pp) * 2), vtr(Bl + (l0 + 4) * 272 + (16 * wave + 4 * pp) * 2));
#pragma unroll
                for (int pt = 0; pt < 4; ++pt) { const bf16x8 aop = cat8(vtr(Xl + l0 * 160 + (16 * pt + 4 * pp) * 2), vtr(Xl + (l0 + 4) * 160 + (16 * pt + 4 * pp) * 2)); acc[pt] = mfma16(aop, bop, acc[pt]); } }
            float* sp = ST + ((size_t)((b * 16 + c) * 32 + h) * 64) * 128 + 16 * wave + li;
#pragma unroll
            for (int pt = 0; pt < 4; ++pt)
#pragma unroll
                for (int j = 0; j < 4; ++j) sp[(size_t)(16 * pt + 4 * quad + j) * 128] = acc[pt][j];
        }
    }
}
__device__ __forceinline__ void ssd_b_phase(const Params& P) {
    const size_t gtid = (size_t)blockIdx.x * 512 + threadIdx.x, nth = (size_t)gridDim.x * 512;
    const float* ST = (const float*)(P.ws + OFF_RB); bf16_t* SIN = (bf16_t*)(P.ws + OFF_SIN); const float* CUM = (const float*)(P.ws + OFF_CUM);
    for (size_t it = gtid; it < (size_t)4 * 32 * 64 * 32; it += nth) {
        const int n4 = (int)(it & 31), p = (int)((it >> 5) & 63), h = (int)((it >> 11) & 31), b = (int)(it >> 16);
        f32x4 cur = (f32x4){0.f, 0.f, 0.f, 0.f};
#pragma unroll 4
        for (int c = 0; c < 16; ++c) { const size_t base = ((size_t)((b * 16 + c) * 32 + h) * 64 + p) * 128 + 4 * n4;
            u32x2 o; o.x = pk2(cur[0], cur[1]); o.y = pk2(cur[2], cur[3]); *(u32x2*)(SIN + base) = o;
            const float dec = __expf(CUM[((size_t)b * 4096 + c * 256 + 255) * 32 + h]); const f32x4 st = *(const f32x4*)(ST + base); cur = cur * dec + st; }
    }
}
__device__ __forceinline__ void ssd_c_phase(const Params& P, ldsp lds) {
    const int tid = threadIdx.x, wave = __builtin_amdgcn_readfirstlane(tid >> 6), lane = tid & 63, quad = lane >> 4, li = lane & 15, qq = li >> 2, pp = li & 3;
    const bf16_t* X2 = (const bf16_t*)(P.ws + OFF_XB); const float* DTf = (const float*)(P.ws + OFF_DT); const float* CUM = (const float*)(P.ws + OFF_CUM);
    const bf16_t* SIN = (const bf16_t*)(P.ws + OFF_SIN); float* SSQ = (float*)(P.ws + OFF_SSQ); bf16_t* A0 = (bf16_t*)P.out;
    ldsp Bl = lds, Xl = lds + 69632, Sl = lds + 110592; LAS float* cuml = (LAS float*)(lds + 128000); LAS float* dtl = cuml + 256;
    for (int item = blockIdx.x; item < 256; item += gridDim.x) {
        const int b = item >> 6, c = (item >> 2) & 15, g = item & 3; const size_t rowbase = (size_t)b * 4096 + c * 256;
        __syncthreads();
#pragma unroll
        for (int k = 0; k < 8; ++k) { const int idx = tid + 512 * k, r = idx >> 4, ch = idx & 15; *(LAS u32x4*)(Bl + r * 272 + ch * 16) = *(const u32x4*)(X2 + (rowbase + r) * 3072 + 2048 + g * 128 + ch * 8); }
        bf16x8 qf[2][4];
#pragma unroll
        for (int nt = 0; nt < 2; ++nt)
#pragma unroll
            for (int ks = 0; ks < 4; ++ks) qf[nt][ks] = *(const bf16x8*)(X2 + (rowbase + 32 * wave + 16 * nt + li) * 3072 + 2560 + g * 128 + 32 * ks + 8 * quad);
        for (int hh = 0; hh < 8; ++hh) { const int h = g * 8 + hh;
            __syncthreads();
#pragma unroll
            for (int k = 0; k < 4; ++k) { const int idx = tid + 512 * k, r = idx >> 3, ch = idx & 7; *(LAS u32x4*)(Xl + r * 160 + ch * 16) = *(const u32x4*)(X2 + (rowbase + r) * 3072 + h * 64 + ch * 8); }
#pragma unroll
            for (int k = 0; k < 2; ++k) { const int idx = tid + 512 * k, r = idx >> 4, ch = idx & 15; *(LAS u32x4*)(Sl + r * 272 + ch * 16) = *(const u32x4*)(SIN + ((size_t)((b * 16 + c) * 32 + h) * 64 + r) * 128 + ch * 8); }
            if (tid < 256) { cuml[tid] = CUM[(rowbase + tid) * 32 + h]; dtl[tid] = DTf[(rowbase + tid) * 32 + h]; }
            __syncthreads();
            f32x4 oacc[2][4];
#pragma unroll
            for (int nt = 0; nt < 2; ++nt)
#pragma unroll
                for (int pt = 0; pt < 4; ++pt) oacc[nt][pt] = (f32x4){0.f, 0.f, 0.f, 0.f};
#pragma unroll
            for (int pt = 0; pt < 4; ++pt)
#pragma unroll
                for (int ks = 0; ks < 4; ++ks) { const bf16x8 a = *(const LAS bf16x8*)(Sl + (16 * pt + li) * 272 + (32 * ks + 8 * quad) * 2);
                    oacc[0][pt] = mfma16(a, qf[0][ks], oacc[0][pt]); oacc[1][pt] = mfma16(a, qf[1][ks], oacc[1][pt]); }
            int lq[2]; float cq[2];
#pragma unroll
            for (int nt = 0; nt < 2; ++nt) { lq[nt] = 32 * wave + 16 * nt + li; cq[nt] = cuml[lq[nt]]; const float e = __expf(cq[nt]);
#pragma unroll
                for (int pt = 0; pt < 4; ++pt) oacc[nt][pt] *= e; }
            const int nkt = (32 * wave + 31) / 64 + 1;
#pragma unroll 1
            for (int kt = 0; kt < nkt; ++kt) {
                {
                    f32x4 sacc[2][4];
#pragma unroll
                    for (int nt = 0; nt < 2; ++nt)
#pragma unroll
                        for (int mt = 0; mt < 4; ++mt) sacc[nt][mt] = (f32x4){0.f, 0.f, 0.f, 0.f};
#pragma unroll
                    for (int mt = 0; mt < 4; ++mt)
#pragma unroll
                        for (int ks = 0; ks < 4; ++ks) { const bf16x8 a = *(const LAS bf16x8*)(Bl + (64 * kt + 16 * mt + li) * 272 + (32 * ks + 8 * quad) * 2);
                            sacc[0][mt] = mfma16(a, qf[0][ks], sacc[0][mt]); sacc[1][mt] = mfma16(a, qf[1][ks], sacc[1][mt]); }
#pragma unroll
                    for (int mt = 0; mt < 4; ++mt) { const int s0 = 64 * kt + 16 * mt + 4 * quad; const f32x4 cs = *(const LAS f32x4*)(cuml + s0), ds = *(const LAS f32x4*)(dtl + s0);
#pragma unroll
                        for (int nt = 0; nt < 2; ++nt)
#pragma unroll
                            for (int j = 0; j < 4; ++j) { const float v = sacc[nt][mt][j] * __expf(cq[nt] - cs[j]) * ds[j]; sacc[nt][mt][j] = (s0 + j <= lq[nt]) ? v : 0.f; } }
                    bf16x8 pb[2][2];
#pragma unroll
                    for (int nt = 0; nt < 2; ++nt)
#pragma unroll
                        for (int kk = 0; kk < 2; ++kk) { u32x4 t; t.x = pk2(sacc[nt][2 * kk][0], sacc[nt][2 * kk][1]); t.y = pk2(sacc[nt][2 * kk][2], sacc[nt][2 * kk][3]);
                            t.z = pk2(sacc[nt][2 * kk + 1][0], sacc[nt][2 * kk + 1][1]); t.w = pk2(sacc[nt][2 * kk + 1][2], sacc[nt][2 * kk + 1][3]); pb[nt][kk] = __builtin_bit_cast(bf16x8, t); }
#pragma unroll
                    for (int pt = 0; pt < 4; ++pt)
#pragma unroll
                        for (int kk = 0; kk < 2; ++kk) { const int r0 = 64 * kt + 32 * kk + 4 * quad + qq;
                            const bf16x8 a = cat8(vtr(Xl + r0 * 160 + (16 * pt + 4 * pp) * 2), vtr(Xl + (r0 + 16) * 160 + (16 * pt + 4 * pp) * 2));
                            oacc[0][pt] = mfma16(a, pb[0][kk], oacc[0][pt]); oacc[1][pt] = mfma16(a, pb[1][kk], oacc[1][pt]); }
                }
            }
            const float Dh = P.ssd_d[h];
#pragma unroll
            for (int nt = 0; nt < 2; ++nt) { const size_t row = rowbase + lq[nt]; float ss = 0.f;
#pragma unroll
                for (int pt = 0; pt < 4; ++pt) { const int col = h * 64 + 16 * pt + 4 * quad; const u32x2 xs = *(const u32x2*)(X2 + row * 3072 + col); const u32x2 z = *(const u32x2*)(A0 + row * 4096 + col);
                    const float t0 = (oacc[nt][pt][0] + Dh * bf_lo(xs.x)) * silu_f(bf_lo(z.x)), t1 = (oacc[nt][pt][1] + Dh * bf_hi(xs.x)) * silu_f(bf_hi(z.x));
                    const float t2 = (oacc[nt][pt][2] + Dh * bf_lo(xs.y)) * silu_f(bf_lo(z.y)), t3 = (oacc[nt][pt][3] + Dh * bf_hi(xs.y)) * silu_f(bf_hi(z.y));
                    ss += (t0 * t0 + t1 * t1) + (t2 * t2 + t3 * t3); u32x2 o; o.x = pk2(t0, t1); o.y = pk2(t2, t3); *(u32x2*)(A0 + row * 4096 + col) = o; }
                ss += __shfl_xor(ss, 16); ss += __shfl_xor(ss, 32);
                if (quad == 0) SSQ[row * 32 + h] = ss; }
        }
    }
}

__device__ __forceinline__ void moba_phase(const Params& P, ldsp lds) {
    const int tid = threadIdx.x, wave = __builtin_amdgcn_readfirstlane(tid >> 6), lane = tid & 63, quad = lane >> 4, li = lane & 15, qq = li >> 2, pp = li & 3;
    bf16_t* A0 = (bf16_t*)P.out; const bf16_t* Kb = (const bf16_t*)(P.ws + OFF_K); const bf16_t* Vb = (const bf16_t*)(P.ws + OFF_V); const bf16_t* Gb = (const bf16_t*)(P.ws + OFF_G);
    const float* kmean = (const float*)(P.ws + OFF_KM);
    ldsp Kl = lds, Vl = lds + 34816; LAS float* gl = (LAS float*)(lds + 71680); LAS float* kml = (LAS float*)(lds + 89088); LAS unsigned* selm = (LAS unsigned*)(lds + 97280);
    const float c2 = 0.08838834764831845f * 1.4426950408889634f;
    const int G = gridDim.x, cb = blockIdx.x;
    const int sr = tid >> 4, sc = tid & 15;
    for (int kr = 0; kr * G < 1024; ++kr) {
        const int idx = (kr & 1) ? (kr * G + G - 1 - cb) : (kr * G + cb);
        if (idx >= 1024) continue;
        const int i = 15 - (idx >> 6), b = (idx & 63) >> 4, h = idx & 15;
        const size_t qrow0 = (size_t)b * 4096 + i * 256;
        __syncthreads();
        { f32x4 v = *(const f32x4*)(kmean + (size_t)((b * 16 + h) * 16) * 128 + tid * 4); v *= (1.f / 256.f); *(LAS f32x4*)(kml + tid * 4) = v; }
        __syncthreads();
        { const int r = tid >> 1, hf = tid & 1; const bf16_t* qp = A0 + (qrow0 + r) * 4096 + 2048 + h * 128; float gs[8];
#pragma unroll
          for (int jb = 0; jb < 8; ++jb) gs[jb] = 0.f;
#pragma unroll 2
          for (int dc = 0; dc < 16; ++dc) { const u32x4 qv = *(const u32x4*)(qp + dc * 8);
              const float q0 = bf_lo(qv.x), q1 = bf_hi(qv.x), q2 = bf_lo(qv.y), q3 = bf_hi(qv.y), q4 = bf_lo(qv.z), q5 = bf_hi(qv.z), q6 = bf_lo(qv.w), q7 = bf_hi(qv.w);
#pragma unroll
              for (int jb = 0; jb < 8; ++jb) { const LAS float* kp = kml + (hf * 8 + jb) * 128 + dc * 8; const f32x4 k0 = *(const LAS f32x4*)kp, k1 = *(const LAS f32x4*)(kp + 4);
                  gs[jb] += (q0 * k0[0] + q1 * k0[1]) + (q2 * k0[2] + q3 * k0[3]) + (q4 * k1[0] + q5 * k1[1]) + (q6 * k1[2] + q7 * k1[3]); } }
#pragma unroll
          for (int jb = 0; jb < 8; ++jb) gl[r * 17 + hf * 8 + jb] = gs[jb]; }
        __syncthreads();
        if (tid < 256) { unsigned mask = 0u; const int nsel = i < 3 ? i : 3;
            for (int s = 0; s < nsel; ++s) { float best = -INFINITY; int bj = -1;
                for (int j = 0; j < i; ++j) { const float v = gl[tid * 17 + j]; if (!((mask >> j) & 1u) && v > best) { best = v; bj = j; } }
                if (bj >= 0) mask |= 1u << bj; }
            selm[tid] = mask; }
        bf16x8 qf[2][4];
#pragma unroll
        for (int nt = 0; nt < 2; ++nt)
#pragma unroll
            for (int ks = 0; ks < 4; ++ks) qf[nt][ks] = *(const bf16x8*)(A0 + (qrow0 + 32 * wave + 16 * nt + li) * 4096 + 2048 + h * 128 + 32 * ks + 8 * quad);
        const int ntile = 4 * (i + 1);
        u32x4 kreg[2], vreg[2];
        { const size_t kr0 = (qrow0 + sr) * 2048 + h * 128 + sc * 8;
          kreg[0] = *(const u32x4*)(Kb + kr0); kreg[1] = *(const u32x4*)(Kb + kr0 + 32 * 2048); vreg[0] = *(const u32x4*)(Vb + kr0); vreg[1] = *(const u32x4*)(Vb + kr0 + 32 * 2048); }
        *(LAS u32x4*)(Kl + sr * 272 + sc * 16) = kreg[0]; *(LAS u32x4*)(Kl + (sr + 32) * 272 + sc * 16) = kreg[1];
        *(LAS u32x4*)(Vl + sr * 288 + sc * 16) = vreg[0]; *(LAS u32x4*)(Vl + (sr + 32) * 288 + sc * 16) = vreg[1];
        __syncthreads();
        unsigned sel[2]; float mrun[2], lrun[2]; f32x4 oacc[2][8];
#pragma unroll
        for (int nt = 0; nt < 2; ++nt) { sel[nt] = selm[32 * wave + 16 * nt + li]; mrun[nt] = -1e30f; lrun[nt] = 0.f;
#pragma unroll
            for (int dt = 0; dt < 8; ++dt) oacc[nt][dt] = (f32x4){0.f, 0.f, 0.f, 0.f}; }
        for (int tt = 0; tt < ntile; ++tt) {
            const int buf = tt & 1;
            if (tt + 1 < ntile) { const int t1 = tt + 1; const int jb = (t1 < 4) ? i : (t1 >> 2) - 1; const int kt1 = t1 & 3;
                const size_t kr0 = ((size_t)b * 4096 + jb * 256 + kt1 * 64 + sr) * 2048 + h * 128 + sc * 8;
                kreg[0] = *(const u32x4*)(Kb + kr0); kreg[1] = *(const u32x4*)(Kb + kr0 + 32 * 2048); vreg[0] = *(const u32x4*)(Vb + kr0); vreg[1] = *(const u32x4*)(Vb + kr0 + 32 * 2048); }
            const bool own = tt < 4; const int kt = tt & 3; const int jblk = own ? i : (tt >> 2) - 1;
            bool active;
            if (own) active = (64 * kt <= 32 * wave + 31); else active = __any((int)(((sel[0] | sel[1]) >> jblk) & 1u)) != 0;
            if (active) {
                ldsp Kt = Kl + buf * 17408; ldsp Vt = Vl + buf * 18432;
                f32x4 sacc[2][4];
#pragma unroll
                for (int nt = 0; nt < 2; ++nt)
#pragma unroll
                    for (int mt = 0; mt < 4; ++mt) sacc[nt][mt] = (f32x4){0.f, 0.f, 0.f, 0.f};
#pragma unroll
                for (int mt = 0; mt < 4; ++mt)
#pragma unroll
                    for (int ks = 0; ks < 4; ++ks) { const bf16x8 a = *(const LAS bf16x8*)(Kt + (16 * mt + li) * 272 + (32 * ks + 8 * quad) * 2);
                        sacc[0][mt] = mfma16(a, qf[0][ks], sacc[0][mt]); sacc[1][mt] = mfma16(a, qf[1][ks], sacc[1][mt]); }
                bf16x8 pb[2][2];
#pragma unroll
                for (int nt = 0; nt < 2; ++nt) { const int qpos = 32 * wave + 16 * nt + li; const bool selj = ((sel[nt] >> jblk) & 1u) != 0u; float mx = -1e30f;
#pragma unroll
                    for (int mt = 0; mt < 4; ++mt)
#pragma unroll
                        for (int j = 0; j < 4; ++j) { const int kpos = 64 * kt + 16 * mt + 4 * quad + j; const bool valid = own ? (kpos <= qpos) : selj;
                            const float s = valid ? sacc[nt][mt][j] * c2 : -1e30f; sacc[nt][mt][j] = s; mx = fmaxf(mx, s); }
                    mx = fmaxf(mx, __shfl_xor(mx, 16)); mx = fmaxf(mx, __shfl_xor(mx, 32));
                    const float mnew = fmaxf(mrun[nt], mx); const float alpha = __builtin_amdgcn_exp2f(mrun[nt] - mnew); mrun[nt] = mnew; float ps = 0.f;
#pragma unroll
                    for (int mt = 0; mt < 4; ++mt)
#pragma unroll
                        for (int j = 0; j < 4; ++j) { const float p = __builtin_amdgcn_exp2f(sacc[nt][mt][j] - mnew); sacc[nt][mt][j] = p; ps += p; }
                    lrun[nt] = lrun[nt] * alpha + ps;
#pragma unroll
                    for (int dt = 0; dt < 8; ++dt) oacc[nt][dt] *= alpha;
#pragma unroll
                    for (int kk = 0; kk < 2; ++kk) { u32x4 t; t.x = pk2(sacc[nt][2 * kk][0], sacc[nt][2 * kk][1]); t.y = pk2(sacc[nt][2 * kk][2], sacc[nt][2 * kk][3]);
                        t.z = pk2(sacc[nt][2 * kk + 1][0], sacc[nt][2 * kk + 1][1]); t.w = pk2(sacc[nt][2 * kk + 1][2], sacc[nt][2 * kk + 1][3]); pb[nt][kk] = __builtin_bit_cast(bf16x8, t); }
                }
#pragma unroll
                for (int dt = 0; dt < 8; ++dt)
#pragma unroll
                    for (int kk = 0; kk < 2; ++kk) { const int r0 = 32 * kk + 4 * quad + qq;
                        const bf16x8 a = cat8(vtr(Vt + r0 * 288 + (16 * dt + 4 * pp) * 2), vtr(Vt + (r0 + 16) * 288 + (16 * dt + 4 * pp) * 2));
                        oacc[0][dt] = mfma16(a, pb[0][kk], oacc[0][dt]); oacc[1][dt] = mfma16(a, pb[1][kk], oacc[1][dt]); }
            }
            if (tt + 1 < ntile) { ldsp Kn = Kl + (buf ^ 1) * 17408; ldsp Vn = Vl + (buf ^ 1) * 18432;
                *(LAS u32x4*)(Kn + sr * 272 + sc * 16) = kreg[0]; *(LAS u32x4*)(Kn + (sr + 32) * 272 + sc * 16) = kreg[1];
                *(LAS u32x4*)(Vn + sr * 288 + sc * 16) = vreg[0]; *(LAS u32x4*)(Vn + (sr + 32) * 288 + sc * 16) = vreg[1]; }
            __syncthreads();
        }
#pragma unroll
        for (int nt = 0; nt < 2; ++nt) { float l = lrun[nt]; l += __shfl_xor(l, 16); l += __shfl_xor(l, 32); const float inv = 1.f / l; const size_t row = qrow0 + 32 * wave + 16 * nt + li;
#pragma unroll
            for (int dt = 0; dt < 8; ++dt) { const int col = h * 128 + 16 * dt + 4 * quad; const u32x2 gv = *(const u32x2*)(Gb + row * 2048 + col);
                u32x2 o; o.x = pk2(oacc[nt][dt][0] * inv * bf_lo(gv.x), oacc[nt][dt][1] * inv * bf_hi(gv.x)); o.y = pk2(oacc[nt][dt][2] * inv * bf_lo(gv.y), oacc[nt][dt][3] * inv * bf_hi(gv.y));
                *(u32x2*)(A0 + row * 4096 + 2048 + col) = o; } }
    }
}

__device__ __forceinline__ void ln_phase(const float* Y, const float* g, const float* bta, float* outf, bf16_t* outb) {
    const int lane = threadIdx.x & 63; const int gw = blockIdx.x * 8 + __builtin_amdgcn_readfirstlane(threadIdx.x >> 6), NGW = gridDim.x * 8;
    f32x4 gv[8], bv[8];
#pragma unroll
    for (int k = 0; k < 8; ++k) { gv[k] = ((const f32x4*)g)[lane + 64 * k]; bv[k] = ((const f32x4*)bta)[lane + 64 * k]; }
    for (int row = gw; row < M; row += NGW) { const f32x4* yr = (const f32x4*)(Y + (size_t)row * 2048); f32x4 v[8]; float s = 0.f;
#pragma unroll
        for (int k = 0; k < 8; ++k) { v[k] = yr[lane + 64 * k]; s += (v[k][0] + v[k][1]) + (v[k][2] + v[k][3]); }
#pragma unroll
        for (int o = 1; o < 64; o <<= 1) s += __shfl_xor(s, o);
        const float mu = s * (1.f / 2048.f); float s2 = 0.f;
#pragma unroll
        for (int k = 0; k < 8; ++k) { v[k] = v[k] - mu; s2 += (v[k][0] * v[k][0] + v[k][1] * v[k][1]) + (v[k][2] * v[k][2] + v[k][3] * v[k][3]); }
#pragma unroll
        for (int o = 1; o < 64; o <<= 1) s2 += __shfl_xor(s2, o);
        const float rstd = rsqrtf(s2 * (1.f / 2048.f) + 1e-5f);
#pragma unroll
        for (int k = 0; k < 8; ++k) { const f32x4 o = v[k] * rstd * gv[k] + bv[k]; ((f32x4*)(outf + (size_t)row * 2048))[lane + 64 * k] = o;
            if (outb) { u32x2 ob; ob.x = pk2(o[0], o[1]); ob.y = pk2(o[2], o[3]); ((u32x2*)(outb + (size_t)row * 2048))[lane + 64 * k] = ob; } }
    }
}

__device__ __forceinline__ void s5_phase(const Params& P, ldsp lds) {
    const int tid = threadIdx.x, wave = __builtin_amdgcn_readfirstlane(tid >> 6), lane = tid & 63, quad = lane >> 4, li = lane & 15;
    const bf16_t* U = (const bf16_t*)(P.ws + OFF_K); bf16_t* YG = (bf16_t*)(P.ws + OFF_RB);
    LAS float* BUl = (LAS float*)(lds + wave * 12800); ldsp Hl = lds + wave * 12800 + 8448;
    for (int item = blockIdx.x * 8 + wave; item < 512; item += gridDim.x * 8) {
        const int b = item >> 7, g = item & 127;
        const float dtg = __expf(P.log_dt[g]);
        float lbr, lbi;
        { const float lr = P.lam_re[g * 64 + lane], lim = P.lam_im[g * 64 + lane]; const float e = __expf(lr * dtg); float s, c; sincos_d((double)(lim * dtg), s, c); lbr = e * c; lbi = e * s; }
        bf16x8 bbf[8], cmf[4];
#pragma unroll
        for (int tile = 0; tile < 8; ++tile) { const int n = (16 * tile + li) & 63; const bool isim = tile >= 4;
            const float lr = P.lam_re[g * 64 + n], lim = P.lam_im[g * 64 + n]; const float e = __expf(lr * dtg); float s, c; sincos_d((double)(lim * dtg), s, c);
            const float ar = e * c - 1.f, aim = e * s; const float den = 1.f / (lr * lr + lim * lim); const float cr = (ar * lr + aim * lim) * den, ci = (aim * lr - ar * lim) * den;
            u32x4 t = (u32x4){0u, 0u, 0u, 0u};
            if (quad < 2) { const float* br = P.b_re + ((size_t)(g * 64 + n)) * 16 + 8 * quad; const float* bi = P.b_im + ((size_t)(g * 64 + n)) * 16 + 8 * quad; float o[8];
#pragma unroll
                for (int e2 = 0; e2 < 8; ++e2) { const float xr = br[e2], xi = bi[e2]; o[e2] = isim ? (cr * xi + ci * xr) : (cr * xr - ci * xi); }
                t.x = pk2(o[0], o[1]); t.y = pk2(o[2], o[3]); t.z = pk2(o[4], o[5]); t.w = pk2(o[6], o[7]); }
            bbf[tile] = __builtin_bit_cast(bf16x8, t); }
#pragma unroll
        for (int ks = 0; ks < 4; ++ks) { const float* cp = (ks < 2 ? P.c_re : P.c_im) + ((size_t)(g * 16 + li)) * 64 + 32 * (ks & 1) + 8 * quad; const float sg = ks < 2 ? 1.f : -1.f;
            u32x4 t; t.x = pk2(sg * cp[0], sg * cp[1]); t.y = pk2(sg * cp[2], sg * cp[3]); t.z = pk2(sg * cp[4], sg * cp[5]); t.w = pk2(sg * cp[6], sg * cp[7]); cmf[ks] = __builtin_bit_cast(bf16x8, t); }
        const float dsk = P.s5_d[g * 16 + li];
        float hr = 0.f, hi = 0.f;
        const bf16_t* ub = U + ((size_t)b * 4096) * 2048 + g * 16;
        bf16_t* yb = YG + ((size_t)b * 4096) * 2048 + g * 16;
        u32x4 anext = (u32x4){0u, 0u, 0u, 0u};
        if (quad < 2) anext = *(const u32x4*)(ub + (size_t)li * 2048 + 8 * quad);
        for (int step = 0; step < 256; ++step) {
            const int t0 = step * 16;
            const bf16x8 a = __builtin_bit_cast(bf16x8, anext);
            if (step + 1 < 256 && quad < 2) anext = *(const u32x4*)(ub + (size_t)(t0 + 16 + li) * 2048 + 8 * quad);
#pragma unroll
            for (int tile = 0; tile < 8; ++tile) { const f32x4 bu = mfma16(a, bbf[tile], (f32x4){0.f, 0.f, 0.f, 0.f});
#pragma unroll
                for (int j = 0; j < 4; ++j) BUl[(4 * quad + j) * 132 + 16 * tile + li] = bu[j]; }
            LDS_WAIT();
#pragma unroll
            for (int t = 0; t < 16; ++t) { const float br = BUl[t * 132 + lane], bi = BUl[t * 132 + 64 + lane];
                const float nr = lbr * hr - lbi * hi + br, ni = lbr * hi + lbi * hr + bi; hr = nr; hi = ni;
                const unsigned pk = pk2(hr, hi); *(LAS bf16_t*)(Hl + t * 272 + lane * 2) = (bf16_t)(pk & 0xffffu); *(LAS bf16_t*)(Hl + t * 272 + 128 + lane * 2) = (bf16_t)(pk >> 16); }
            LDS_WAIT();
            f32x4 yacc = (f32x4){0.f, 0.f, 0.f, 0.f};
#pragma unroll
            for (int ks = 0; ks < 4; ++ks) { const bf16x8 a2 = *(const LAS bf16x8*)(Hl + li * 272 + (32 * ks + 8 * quad) * 2); yacc = mfma16(a2, cmf[ks], yacc); }
            LDS_WAIT();
#pragma unroll
            for (int j = 0; j < 4; ++j) { const size_t ro = (size_t)(t0 + 4 * quad + j) * 2048 + li; const float uu = bf1(ub[ro]); const float y = yacc[j] + dsk * uu; const float ge = gelu_tanh_f(y);
                yb[ro] = (bf16_t)(pk2(ge, ge) & 0xffffu); }
        }
    }
}

template <class Epi> __device__ __forceinline__ void run_gemm(ldsp lds, const bf16_t* A, const bf16_t* Bt, int N, int K, const Epi& E) {
    pg8::Gemm g; g.A = A; g.Bt = Bt; g.M = M; g.N = N; g.K = K;
    pg8::StaticOrder S; S.init(M, N, (int)gridDim.x, (int)blockIdx.x);
    pg8::gemm_phase<Epi, pg8::StaticOrder, false>(lds, g, S, E, nullptr);
}

#ifndef PHASE_MASK
#define PHASE_MASK 0x3fff
#endif
#if defined(__HIP_DEVICE_COMPILE__)
#define GETP() ({ const __attribute__((address_space(4))) Params* kp_ = (const __attribute__((address_space(4))) Params*)__builtin_amdgcn_kernarg_segment_ptr(); asm volatile("" : "+s"(kp_)); *kp_; })
#else
#define GETP() (P_unused)
#endif
__global__ void __launch_bounds__(512, 2) mega_fwd(Params P_unused) {
    constexpr int PM = PHASE_MASK;
    extern __shared__ __attribute__((aligned(16))) unsigned char shm[];
    ldsp lds = (ldsp)shm;
    cg::grid_group grid = cg::this_grid();
    if (PM & 1) { const Params P = GETP(); p0_phase(P, lds); }
    grid.sync();
    if (PM & 2) { const Params P = GETP(); unsigned char* ws = P.ws;
      EpiIn0 E; E.A0 = (bf16_t*)P.out; E.XBCraw = (bf16_t*)(ws + OFF_RB); E.Kb = (bf16_t*)(ws + OFF_K); E.Vb = (bf16_t*)(ws + OFF_V); E.Gb = (bf16_t*)(ws + OFF_G);
      E.DTf = (float*)(ws + OFF_DT); E.kmean = (float*)(ws + OFF_KM); E.ctab = (const float*)(ws + OFF_CT); E.stab = (const float*)(ws + OFF_STB); E.dt_bias = P.dt_bias;
      run_gemm(lds, (const bf16_t*)(ws + OFF_XB), (const bf16_t*)(ws + OFF_W0T), N0P, 2048, E); }
    grid.sync();
    if (PM & 4) { const Params P = GETP(); conv_phase(P); }
    grid.sync();
    if (PM & 8) { const Params P = GETP(); moba_phase(P, lds); }
    if (PM & 16) { const Params P = GETP(); ssd_a_phase(P, lds); }
    grid.sync();
    if (PM & 32) { const Params P = GETP(); ssd_b_phase(P); }
    grid.sync();
    if (PM & 64) { const Params P = GETP(); ssd_c_phase(P, lds); }
    grid.sync();
    if (PM & 128) { const Params P = GETP(); unsigned char* ws = P.ws;
      EpiOut<32> E; E.resid = P.x; E.Y = (float*)(ws + OFF_K); E.rsl = (const LAS float*)(lds + 131072);
      { pg8::StaticOrder S; S.init(M, 2048, (int)gridDim.x, (int)blockIdx.x); const float* ssq = (const float*)(ws + OFF_SSQ); LAS float* rw = (LAS float*)(lds + 131072);
        for (int q = threadIdx.x; q < 2048; q += 512) { const int ui = q >> 8; Unit u; if (S.next(ui, u)) { const f32x4* p = (const f32x4*)(ssq + (size_t)(u.pm * 256 + (q & 255)) * 32); float sm = 0.f;
#pragma unroll
            for (int k = 0; k < 8; ++k) { const f32x4 v = p[k]; sm += (v[0] + v[1]) + (v[2] + v[3]); }
            rw[q] = rsqrtf(sm * (1.f / 2048.f) + 1e-5f); } }
        __syncthreads(); }
      run_gemm(lds, (const bf16_t*)P.out, (const bf16_t*)(ws + OFF_WO0), 2048, 4096, E); }
    grid.sync();
    if (PM & 256) { const Params P = GETP(); unsigned char* ws = P.ws; ln_phase((const float*)(ws + OFF_K), P.ln_g, P.ln_b, P.out, (bf16_t*)(ws + OFF_G)); }
    grid.sync();
    if (PM & 512) { const Params P = GETP(); unsigned char* ws = P.ws;
      EpiIn1 E; E.U = (bf16_t*)(ws + OFF_K); E.SG = (bf16_t*)(ws + OFF_V);
      run_gemm(lds, (const bf16_t*)(ws + OFF_G), (const bf16_t*)(ws + OFF_W1), 4096, 2048, E); }
    grid.sync();
    if (PM & 1024) { const Params P = GETP(); s5_phase(P, lds); }
    grid.sync();
    if (PM & 2048) { const Params P = GETP(); unsigned char* ws = P.ws;
      EpiGlu E; E.A1 = (bf16_t*)(ws + OFF_XB); E.SG = (const bf16_t*)(ws + OFF_V);
      run_gemm(lds, (const bf16_t*)(ws + OFF_RB), (const bf16_t*)(ws + OFF_WG), 4096, 2048, E); }
    grid.sync();
    if (PM & 4096) { const Params P = GETP(); unsigned char* ws = P.ws;
      EpiOut<-1> E; E.resid = P.out; E.Y = (float*)(ws + OFF_K); E.rsl = nullptr;
      run_gemm(lds, (const bf16_t*)(ws + OFF_XB), (const bf16_t*)(ws + OFF_WO1), 2048, 2048, E); }
    grid.sync();
    if (PM & 8192) { const Params P = GETP(); unsigned char* ws = P.ws; ln_phase((const float*)(ws + OFF_K), P.ln_g + 2048, P.ln_b + 2048, P.out, nullptr); }
}

extern "C" void kernel_launch(void* const* d_in, const int* in_sizes, int n_in, void* d_out, int out_size, void* d_ws, size_t ws_size, hipStream_t stream) {
    static int grid_blocks = 0;
    if (grid_blocks == 0) {
        if (n_in != 22 || out_size != M * DM || ws_size < WS_END) { fprintf(stderr, "kernel_launch: unexpected shapes (n_in %d out %d ws %zu need %zu)\n", n_in, out_size, ws_size, (size_t)WS_END); grid_blocks = -1; return; }
        int dev = 0, cus = 0, per_cu = 0;
        hipGetDevice(&dev); hipDeviceGetAttribute(&cus, hipDeviceAttributeMultiprocessorCount, dev);
        if (hipFuncSetAttribute((const void*)mega_fwd, hipFuncAttributeMaxDynamicSharedMemorySize, LDS_BYTES) != hipSuccess) { fprintf(stderr, "kernel_launch: hipFuncSetAttribute failed\n"); grid_blocks = -1; return; }
        if (hipOccupancyMaxActiveBlocksPerMultiprocessor(&per_cu, (const void*)mega_fwd, 512, LDS_BYTES) != hipSuccess || per_cu < 1) { fprintf(stderr, "kernel_launch: occupancy query failed (%d)\n", per_cu); (void)hipGetLastError(); per_cu = 1; }
        grid_blocks = cus * 1;
        if (grid_blocks > 256) grid_blocks = 256;
    }
    if (grid_blocks < 0) return;
    Params p{};
    const float** pp = (const float**)&p;
    for (int i = 0; i < 22; ++i) pp[i] = (const float*)d_in[i];
    p.out = (float*)d_out; p.ws = (unsigned char*)d_ws;
    void* args[] = {&p};
    hipError_t e = hipLaunchCooperativeKernel((const void*)mega_fwd, dim3(grid_blocks), dim3(512), args, LDS_BYTES, stream);
    if (e != hipSuccess) fprintf(stderr, "cooperative launch failed: %s (grid %d)\n", hipGetErrorString(e), grid_blocks);
}
```

```cpp
#include <hip/hip_runtime.h>
#include <hip/hip_cooperative_groups.h>
#include <cstdio>
#include <cstdint>
namespace cg = cooperative_groups;
namespace pg8 {
#define PG8_LAS __attribute__((address_space(3)))
typedef unsigned short bf16_t;
typedef short bf16x8 __attribute__((ext_vector_type(8)));
typedef float f32x4 __attribute__((ext_vector_type(4)));
typedef unsigned u32x4 __attribute__((ext_vector_type(4)));
constexpr int BM = 256, BK = 64, HALF = 128, HTB = HALF * BK * 2  , STAGE_BYTES = 8 * HTB, NXCD = 8, WGM = 8;

__host__ __device__ __forceinline__ int lds_byte(int r, int c) { const int st = (r >> 4) * 2 + (c >> 5), rr = r & 15, cc = c & 31, ob = rr * 64 + cc * 2; return st * 1024 + (ob ^ (((ob >> 9) & 1) << 5)); }
__host__ __device__ __forceinline__ void stage_rc(int b, int& R, int& C) { const int st = b / 1024, sb = b % 1024, swz = sb ^ (((sb >> 9) & 1) << 5); R = (st >> 1) * 16 + swz / 64; C = (st & 1) * 32 + (swz % 64) / 2; }
__host__ __device__ __forceinline__ int perm32(int rho) { const int n = rho >> 4, i = rho & 15; return 8 * (i >> 2) + 4 * n + (i & 3); }

struct Unit { int pm, pn; };
struct Gemm { const bf16_t* A; const bf16_t* Bt; int M, N, K, lda, ldb, alias_a, mtiles; };

struct StaticOrder {
    int nM, nN, nwg, G, c;
    __host__ __device__ void init(int M, int N, int G_, int c_) { nM = M / BM; nN = N / BM; nwg = nM * nN; G = G_; c = c_; }
    __host__ __device__ bool next(int i, Unit& u) const {
        const long L = (long)i * G + c; if (L >= nwg) return false;
        int wgid = (int)L; { const int q = nwg / NXCD, r = nwg % NXCD, xcd = wgid % NXCD, off = wgid / NXCD; wgid = (xcd < r ? xcd * (q + 1) : r * (q + 1) + (xcd - r) * q) + off; }
        const int nig = WGM * nN, gid = wgid / nig, fm = gid * WGM, gsz = (nM - fm) < WGM ? (nM - fm) : WGM;
        u.pm = fm + ((wgid % nig) % gsz); u.pn = (wgid % nig) / gsz; return true;
    }
    __device__ __forceinline__ void a_ready(const Unit&) const {}
    __device__ __forceinline__ void done(const Unit&) const {}
};
__device__ __forceinline__ unsigned cvt_pk_bf16(float lo, float hi) { unsigned r; asm volatile("v_cvt_pk_bf16_f32 %0, %1, %2" : "=v"(r) : "v"(lo), "v"(hi)); return r; }
template <class Epi, class Sched, bool STAMP = false>
__device__ __forceinline__ void gemm_phase(PG8_LAS unsigned char* lds, const Gemm g, const Sched& S, const Epi& E, unsigned long long* stamps) {
    const int tid = threadIdx.x, wid = __builtin_amdgcn_readfirstlane(tid >> 6), lane = tid & 63, wr = wid >> 2, wc = wid & 3, fr = lane & 15, fq = lane >> 4;
    const int K = g.K, nt = K / BK;
    int ts_lo = 0, ts_hi = 0, nts = 0; const unsigned long long rt_entry = STAMP ? (unsigned long long)wall_clock64() : 0ull;
#define PG8_STAMP() do { if (STAMP && wid == 0 && nts < 64) { const unsigned long long _c = (unsigned long long)clock64(); \
        ts_lo = (lane == nts) ? (int)(unsigned)_c : ts_lo; ts_hi = (lane == nts) ? (int)(unsigned)(_c >> 32) : ts_hi; ++nts; } } while (0)
    PG8_STAMP();
    unsigned voffA[2], voffB[2];
#pragma unroll
    for (int i = 0; i < 2; ++i) { int R, C; stage_rc(tid * 16 + i * 8192, R, C); const int Rb = Epi::PERM ? ((R & ~31) + perm32(R & 31)) : R;
        voffA[i] = (unsigned)(R * g.lda + C) * 2u; voffB[i] = (unsigned)(Rb * g.ldb + C) * 2u; }
    const size_t kstep = (size_t)(BK * 2);
    const size_t hstepA = (size_t)HALF * g.lda * 2, hstepB = (size_t)HALF * g.ldb * 2;
    const size_t tstepA = g.alias_a ? (size_t)0 : 2 * hstepA, tstepB = 2 * hstepB;
    const unsigned ldsw = (unsigned)wid * 1024u;
    const int aoff = lds_byte(wr * 64 + fr, fq * 8), boff = lds_byte(wc * 32 + fr, fq * 8);
#define PG8_SA(b, h) (((b) * 2 + (h)) * HTB)
#define PG8_SB(b, h) ((4 + (b) * 2 + (h)) * HTB)
#define PG8_STAGE(bufoff, gbase, voff) do { _Pragma("unroll") for (int _i = 0; _i < 2; ++_i) \
        __builtin_amdgcn_global_load_lds((const unsigned*)((const char*)(gbase) + (voff)[_i]), (PG8_LAS unsigned*)(lds + (bufoff) + ldsw + _i * 8192), 16, 0, 0); } while (0)
#define PG8_LDA(dst, b, h) do { _Pragma("unroll") for (int m = 0; m < 4; ++m) _Pragma("unroll") for (int k = 0; k < 2; ++k) dst[m][k] = *(const PG8_LAS bf16x8*)(lds + PG8_SA(b, h) + aoff + m * 2048 + k * 1024); } while (0)
#define PG8_LDB(dst, b, h) do { _Pragma("unroll") for (int n = 0; n < 2; ++n) _Pragma("unroll") for (int k = 0; k < 2; ++k) dst[n][k] = *(const PG8_LAS bf16x8*)(lds + PG8_SB(b, h) + boff + n * 2048 + k * 1024); } while (0)
#define PG8_MMA(ai, bj, At, Bt) do { __builtin_amdgcn_s_setprio(1); _Pragma("unroll") for (int m = 0; m < 4; ++m) _Pragma("unroll") for (int n = 0; n < 2; ++n) _Pragma("unroll") for (int k = 0; k < 2; ++k) \
        acc[ai][bj][m][n] = __builtin_amdgcn_mfma_f32_16x16x32_bf16(Bt[n][k], At[m][k], acc[ai][bj][m][n], 0, 0, 0); __builtin_amdgcn_s_setprio(0); } while (0)
#define PG8_WAIT_V(n) asm volatile("s_waitcnt vmcnt(" #n ")" ::: "memory")
#define PG8_WAIT_L(n) asm volatile("s_waitcnt lgkmcnt(" #n ")" ::: "memory")
#define PG8_BAR __builtin_amdgcn_s_barrier()
#define PG8_SCHED __builtin_amdgcn_sched_barrier(0)
    Unit cur, nxt; int ui = 0;
    if (!S.next(0, cur)) return;
    f32x4 acc[2][2][4][2];
#pragma unroll
    for (int a = 0; a < 2; ++a)
#pragma unroll
        for (int b = 0; b < 2; ++b)
#pragma unroll
            for (int m = 0; m < 4; ++m)
#pragma unroll
                for (int n = 0; n < 2; ++n) acc[a][b][m][n] = (f32x4){0.f, 0.f, 0.f, 0.f};
    bf16x8 At[4][2], B0[2][2], B1[2][2];
    const char* cA = (const char*)g.A + (size_t)(cur.pm % g.mtiles) * tstepA + (size_t)(cur.pm / g.mtiles) * (size_t)(K * 2); const char* cB = (const char*)g.Bt + (size_t)cur.pn * tstepB + (size_t)(cur.pm / g.mtiles) * (size_t)(K * 2);
    S.a_ready(cur);
    PG8_STAGE(PG8_SB(0, 0), cB, voffB); PG8_STAGE(PG8_SA(0, 0), cA, voffA); PG8_STAGE(PG8_SB(0, 1), cB + hstepB, voffB); PG8_STAGE(PG8_SA(0, 1), cA + hstepA, voffA);
    if (wr == 1) PG8_BAR;
    PG8_WAIT_V(4); PG8_BAR;
    PG8_STAGE(PG8_SB(1, 0), cB + kstep, voffB); PG8_STAGE(PG8_SA(1, 0), cA + kstep, voffA); PG8_STAGE(PG8_SB(1, 1), cB + hstepB + kstep, voffB);
    PG8_WAIT_V(6); PG8_BAR;
    PG8_STAMP();
    for (;;) {
        const bool has_next = S.next(ui + 1, nxt);
        const char* nA = has_next ? (const char*)g.A + (size_t)(nxt.pm % g.mtiles) * tstepA + (size_t)(nxt.pm / g.mtiles) * (size_t)(K * 2) : cA; const char* nB = has_next ? (const char*)g.Bt + (size_t)nxt.pn * tstepB + (size_t)(nxt.pm / g.mtiles) * (size_t)(K * 2) : cB;
        for (int t = 0; t < nt; t += 2) {
            if constexpr (Epi::MID >= 0) { if (t == Epi::MID) E.mid(acc, cur, ui, wr, wc, fr, fq); }
            const bool last = (t == nt - 2);
            const char* a1 = cA + (size_t)(t + 1) * kstep;
            const char* a2 = last ? nA : cA + (size_t)(t + 2) * kstep; const char* b2 = last ? nB : cB + (size_t)(t + 2) * kstep;
            const char* a3 = a2 + kstep; const char* b3 = b2 + kstep;
            if (last && has_next) S.a_ready(nxt);
            PG8_LDB(B0, 0, 0); PG8_SCHED; PG8_LDA(At, 0, 0); PG8_STAGE(PG8_SA(1, 1), a1 + hstepA, voffA);
            PG8_WAIT_L(8); PG8_BAR; PG8_WAIT_L(0); PG8_MMA(0, 0, At, B0); PG8_BAR; PG8_SCHED;
            PG8_LDB(B1, 0, 1); PG8_STAGE(PG8_SB(0, 0), b2, voffB);
            PG8_BAR; PG8_WAIT_L(0); PG8_MMA(0, 1, At, B1); PG8_BAR;
            PG8_LDA(At, 0, 1); PG8_STAGE(PG8_SA(0, 0), a2, voffA);
            PG8_BAR; PG8_WAIT_L(0); PG8_MMA(1, 0, At, B0); PG8_BAR; PG8_SCHED;
            PG8_STAGE(PG8_SB(0, 1), b2 + hstepB, voffB);
            PG8_WAIT_V(6); PG8_BAR; PG8_MMA(1, 1, At, B1); PG8_BAR;
            PG8_LDB(B0, 1, 0); PG8_SCHED; PG8_LDA(At, 1, 0); PG8_STAGE(PG8_SA(0, 1), a2 + hstepA, voffA);
            PG8_WAIT_L(8); PG8_BAR; PG8_WAIT_L(0); PG8_MMA(0, 0, At, B0); PG8_BAR; PG8_SCHED;
            PG8_LDB(B1, 1, 1); PG8_STAGE(PG8_SB(1, 0), b3, voffB);
            PG8_BAR; PG8_WAIT_L(0); PG8_MMA(0, 1, At, B1); PG8_BAR;
            PG8_LDA(At, 1, 1); PG8_STAGE(PG8_SA(1, 0), a3, voffA);
            PG8_BAR; PG8_WAIT_L(0); PG8_MMA(1, 0, At, B0); PG8_BAR; PG8_SCHED;
            PG8_STAGE(PG8_SB(1, 1), b3 + hstepB, voffB);
            PG8_WAIT_V(6); PG8_BAR; PG8_MMA(1, 1, At, B1); PG8_BAR;
        }
        PG8_STAMP();
        if constexpr (!Epi::AFTER_DRAIN) { E(acc, cur, wr, wc, fr, fq); S.done(cur); }
        PG8_STAMP();
        if (!has_next) break;
#pragma unroll
        for (int a = 0; a < 2; ++a)
#pragma unroll
            for (int b = 0; b < 2; ++b)
#pragma unroll
                for (int m = 0; m < 4; ++m)
#pragma unroll
                    for (int n = 0; n < 2; ++n) acc[a][b][m][n] = (f32x4){0.f, 0.f, 0.f, 0.f};
        cur = nxt; cA = nA; cB = nB; ++ui;
    }
    PG8_WAIT_V(0);
    if (wr == 0) PG8_BAR;
    PG8_BAR;
    if constexpr (Epi::AFTER_DRAIN) { E.fused(acc, cur, wr, wc, fr, fq, lds, wid, lane); S.done(cur); }
    PG8_STAMP();
    if (STAMP && wid == 0) { stamps[lane] = lane < nts ? (((unsigned long long)(unsigned)ts_hi << 32) | (unsigned)ts_lo) : 0ull;
        if (lane == 62) stamps[62] = rt_entry; if (lane == 63) stamps[63] = (unsigned long long)wall_clock64(); }
#undef PG8_STAMP
#undef PG8_SA
#undef PG8_SB
#undef PG8_STAGE
#undef PG8_LDA
#undef PG8_LDB
#undef PG8_MMA
#undef PG8_WAIT_V
#undef PG8_WAIT_L
#undef PG8_BAR
#undef PG8_SCHED
}
}

using pg8::bf16_t; using pg8::bf16x8; using pg8::f32x4; using pg8::u32x4; using pg8::Unit;
#define LAS __attribute__((address_space(3)))
#ifndef GSYNC_WAVE_ACQ
#define GSYNC_WAVE_ACQ 1
#endif
#ifndef GEMM_SKEW_TICKS
#define GEMM_SKEW_TICKS 0
#endif
typedef short s16x4 __attribute__((ext_vector_type(4)));
typedef short v4i16_t __attribute__((ext_vector_type(4)));
typedef unsigned u32x2 __attribute__((ext_vector_type(2)));
typedef LAS unsigned char* ldsp;

constexpr int M = 16384, DM = 2048, SEQ = 4096;
constexpr int N0P = 13568;
constexpr float ALPHA = 1.41421356237309515f;
constexpr int LDS_BYTES = 131072 + 8192;

constexpr size_t OFF_XB = 0;
constexpr size_t OFF_W0T = 67108864;
constexpr size_t OFF_RB = 122683392;
constexpr size_t OFF_SIN = OFF_RB + 67108864;
constexpr size_t OFF_K = 223346688;
constexpr size_t OFF_V = 290455552;
constexpr size_t OFF_G = 357564416;
constexpr size_t OFF_WO0 = 424673280;
constexpr size_t OFF_W1 = 441450496;
constexpr size_t OFF_WG = 458227712;
constexpr size_t OFF_WO1 = 475004928;
constexpr size_t OFF_DT = 483393536;
constexpr size_t OFF_CUM = 485490688;
constexpr size_t OFF_SSQ = 487587840;
constexpr size_t OFF_KM = 490733568;
constexpr size_t OFF_CT = 490209280;
constexpr size_t OFF_STB = 490471424;
constexpr size_t OFF_DTP = 490733568 + 1048576;
constexpr size_t WS_END = 490733568 + 1048576 + 8388608;
#ifdef PITCH_EXP
constexpr size_t X1B_OFF = OFF_XB, W1_OFF = WS_END; constexpr int X1B_LD = 2112, W1_LD = 2112;
#else
constexpr size_t X1B_OFF = OFF_G, W1_OFF = OFF_W1; constexpr int X1B_LD = 2048, W1_LD = 2048;
#endif

struct Params {
    const float *x, *in0_w, *conv_w, *conv_b, *dt_bias, *a_log, *ssd_d, *ssd_norm_g, *out0_w, *in1_w,
                *lam_re, *lam_im, *log_dt, *b_re, *b_im, *c_re, *c_im, *s5_d, *glu_w, *out1_w, *ln_g, *ln_b;
    float* out; unsigned char* ws;
};

__constant__ float INVF[16] = {1.000000000e+00f, 4.403665960e-01f, 1.939227432e-01f, 8.539710194e-02f, 3.760603070e-02f, 1.656043902e-02f, 7.292664610e-03f, 3.211445874e-03f,
                               1.414213562e-03f, 6.227723788e-04f, 2.742481884e-04f, 1.207697351e-04f, 5.318296098e-05f, 2.341999971e-05f, 1.031338616e-05f, 4.541670478e-06f};

#define LDS_WAIT() asm volatile("s_waitcnt lgkmcnt(0)" ::: "memory")
__device__ __forceinline__ unsigned pk2(float lo, float hi) { return pg8::cvt_pk_bf16(lo, hi); }
__device__ __forceinline__ float bf_lo(unsigned u) { return __uint_as_float(u << 16); }
__device__ __forceinline__ float bf_hi(unsigned u) { return __uint_as_float(u & 0xffff0000u); }
__device__ __forceinline__ float bf1(bf16_t h) { return __uint_as_float(((unsigned)h) << 16); }
__device__ __forceinline__ float silu_f(float v) { return v * __builtin_amdgcn_rcpf(1.f + __expf(-v)); }
__device__ __forceinline__ float sigmoid_f(float v) { return __builtin_amdgcn_rcpf(1.f + __expf(-v)); }
__device__ __forceinline__ float softplus_f(float v) { return fmaxf(v, 0.f) + log1pf(__expf(-fabsf(v))); }
__device__ __forceinline__ float gelu_tanh_f(float v) { const float u = 0.7978845608028654f * (v + 0.044715f * v * v * v); const float t = 1.f - 2.f * __builtin_amdgcn_rcpf(1.f + __expf(2.f * u)); return 0.5f * v * (1.f + t); }
__device__ __forceinline__ s16x4 vtr(const LAS unsigned char* p) { return __builtin_bit_cast(s16x4, __builtin_amdgcn_ds_read_tr16_b64_v4i16((LAS v4i16_t*)p)); }
__device__ __forceinline__ bf16x8 cat8(s16x4 lo, s16x4 hi) { return __builtin_shufflevector(lo, hi, 0, 1, 2, 3, 4, 5, 6, 7); }
__device__ __forceinline__ f32x4 mfma16(bf16x8 a, bf16x8 b, f32x4 c) { return __builtin_amdgcn_mfma_f32_16x16x32_bf16(a, b, c, 0, 0, 0); }
__device__ __forceinline__ void sincos_d(double a, float& s, float& c) {
    const double k = rint(a * 0.63661977236758134308);
    double r = fma(-k, 1.57079632679489661923, a); r = fma(-k, 6.123233995736766e-17, r);
    const double r2 = r * r;
    const double sp = r * (1.0 + r2 * (-1.0 / 6.0 + r2 * (1.0 / 120.0 + r2 * (-1.0 / 5040.0 + r2 * (1.0 / 362880.0 + r2 * (-1.0 / 39916800.0 + r2 * (1.0 / 6227020800.0)))))));
    const double cp = 1.0 + r2 * (-0.5 + r2 * (1.0 / 24.0 + r2 * (-1.0 / 720.0 + r2 * (1.0 / 40320.0 + r2 * (-1.0 / 3628800.0 + r2 * (1.0 / 479001600.0 + r2 * (-1.0 / 87178291200.0)))))));
    const int q = ((int)k) & 3;
    const double ss = (q == 0) ? sp : (q == 1) ? cp : (q == 2) ? -sp : -cp;
    const double cc = (q == 0) ? cp : (q == 1) ? -sp : (q == 2) ? -cp : sp;
    s = (float)ss; c = (float)cc;
}

struct EpiIn0 {
    static constexpr bool PERM = false, AFTER_DRAIN = false; static constexpr int MID = -1;
    bf16_t *A0, *XBCraw, *Kb, *Vb, *Gb; float *DTf, *kmean; const float *ctab, *stab, *dt_bias;
    __device__ __forceinline__ void mid(f32x4 (&)[2][2][4][2], const Unit&, int, int, int, int, int) const {}
    __device__ __forceinline__ void operator()(const f32x4 (&acc)[2][2][4][2], const Unit& u, int wr, int wc, int fr, int fq) const {
        const int pn = u.pn, rowb = u.pm * 256 + wr * 64 + fr, colw = wc * 32 + 4 * fq;
        if (pn >= 52) {
            if (pn == 52 && wc == 0) {
#pragma unroll
                for (int ai = 0; ai < 2; ++ai)
#pragma unroll
                    for (int m = 0; m < 4; ++m) { const int row = rowb + ai * 128 + m * 16;
#pragma unroll
                        for (int n = 0; n < 2; ++n) { const f32x4 v = acc[ai][0][m][n]; const f32x4 bb = *(const f32x4*)(dt_bias + 16 * n + 4 * fq); f32x4 r;
                            r[0] = softplus_f(v[0] + bb[0]); r[1] = softplus_f(v[1] + bb[1]); r[2] = softplus_f(v[2] + bb[2]); r[3] = softplus_f(v[3] + bb[3]);
                            *(f32x4*)(DTf + (size_t)row * 32 + 16 * n + 4 * fq) = r; } }
            }
            return;
        }
        bf16_t* dst; int ld; int mode;
        if (pn < 8) { dst = A0 + 256 * pn; ld = 4096; mode = 0; }
        else if (pn < 20) { dst = XBCraw + 256 * (pn - 8); ld = 3072; mode = 0; }
        else if (pn < 28) { dst = A0 + 2048 + 256 * (pn - 20); ld = 4096; mode = 1; }
        else if (pn < 36) { dst = Kb + 256 * (pn - 28); ld = 2048; mode = 2; }
        else if (pn < 44) { dst = Vb + 256 * (pn - 36); ld = 2048; mode = 0; }
        else { dst = Gb + 256 * (pn - 44); ld = 2048; mode = 3; }
        const bool rot = (mode == 1 || mode == 2) && (wc == 0);
        f32x4 cs[2][2];
#pragma unroll
        for (int bj = 0; bj < 2; ++bj)
#pragma unroll
            for (int n = 0; n < 2; ++n) cs[bj][n] = (f32x4){0.f, 0.f, 0.f, 0.f};
#pragma unroll
        for (int ai = 0; ai < 2; ++ai)
#pragma unroll
            for (int m = 0; m < 4; ++m) { const int row = rowb + ai * 128 + m * 16; f32x4 v[2][2];
#pragma unroll
                for (int bj = 0; bj < 2; ++bj)
#pragma unroll
                    for (int n = 0; n < 2; ++n) v[bj][n] = acc[ai][bj][m][n];
                if (rot) { const int pos = row & (SEQ - 1); const f32x4 cv = *(const f32x4*)(ctab + pos * 16 + 4 * fq), sv = *(const f32x4*)(stab + pos * 16 + 4 * fq);
#pragma unroll
                    for (int bj = 0; bj < 2; ++bj) { const f32x4 x1 = v[bj][0], x2 = v[bj][1]; v[bj][0] = x1 * cv - x2 * sv; v[bj][1] = x1 * sv + x2 * cv; } }
                if (mode == 2) {
#pragma unroll
                    for (int bj = 0; bj < 2; ++bj)
#pragma unroll
                        for (int n = 0; n < 2; ++n) cs[bj][n] += v[bj][n]; }
                if (mode == 3) {
#pragma unroll
                    for (int bj = 0; bj < 2; ++bj)
#pragma unroll
                        for (int n = 0; n < 2; ++n)
#pragma unroll
                            for (int j = 0; j < 4; ++j) v[bj][n][j] = silu_f(v[bj][n][j]); }
                bf16_t* rp = dst + (size_t)row * ld + colw;
#pragma unroll
                for (int bj = 0; bj < 2; ++bj)
#pragma unroll
                    for (int n = 0; n < 2; ++n) { u32x2 o; o.x = pk2(v[bj][n][0], v[bj][n][1]); o.y = pk2(v[bj][n][2], v[bj][n][3]); *(u32x2*)(rp + bj * 128 + n * 16) = o; }
            }
        if (mode == 2) {
#pragma unroll
            for (int bj = 0; bj < 2; ++bj)
#pragma unroll
                for (int n = 0; n < 2; ++n)
#pragma unroll
                    for (int j = 0; j < 4; ++j) { float s = cs[bj][n][j]; s += __shfl_xor(s, 1); s += __shfl_xor(s, 2); s += __shfl_xor(s, 4); s += __shfl_xor(s, 8); cs[bj][n][j] = s; }
            if (fr == 0) { const int b = u.pm >> 4, blk = u.pm & 15;
#pragma unroll
                for (int bj = 0; bj < 2; ++bj) { const int head = 2 * (pn - 28) + bj; float* kp = kmean + ((size_t)((b * 16 + head) * 16 + blk)) * 128 + colw;
#pragma unroll
                    for (int n = 0; n < 2; ++n) *(f32x4*)(kp + wr * 131072 + n * 16) = cs[bj][n]; } }
        }
    }
};
struct EpiDT {
    static constexpr bool PERM = false, AFTER_DRAIN = false; static constexpr int MID = -1;
    float* DTP;
    __device__ __forceinline__ void mid(f32x4 (&)[2][2][4][2], const Unit&, int, int, int, int, int) const {}
    __device__ __forceinline__ void operator()(const f32x4 (&acc)[2][2][4][2], const Unit& u, int wr, int wc, int fr, int fq) const {
        if (wc != 0) return;
        const int part = u.pm >> 6, rowb = (u.pm & 63) * 256 + wr * 64 + fr; float* dp = DTP + (size_t)part * (M * 32);
#pragma unroll
        for (int ai = 0; ai < 2; ++ai)
#pragma unroll
            for (int m = 0; m < 4; ++m)
#pragma unroll
                for (int n = 0; n < 2; ++n) *(f32x4*)(dp + (size_t)(rowb + ai * 128 + m * 16) * 32 + 16 * n + 4 * fq) = acc[ai][0][m][n];
    }
};
struct EpiIn1 {
    static constexpr bool PERM = false, AFTER_DRAIN = false; static constexpr int MID = -1;
    bf16_t *U, *SG;
    __device__ __forceinline__ void mid(f32x4 (&)[2][2][4][2], const Unit&, int, int, int, int, int) const {}
    __device__ __forceinline__ void operator()(const f32x4 (&acc)[2][2][4][2], const Unit& u, int wr, int wc, int fr, int fq) const {
        const int pn = u.pn, rowb = u.pm * 256 + wr * 64 + fr, colw = wc * 32 + 4 * fq; const bool sg = pn >= 8;
        bf16_t* dst = sg ? SG + 256 * (pn - 8) : U + 256 * pn;
#pragma unroll
        for (int ai = 0; ai < 2; ++ai)
#pragma unroll
            for (int m = 0; m < 4; ++m) { bf16_t* rp = dst + (size_t)(rowb + ai * 128 + m * 16) * 2048 + colw;
#pragma unroll
                for (int bj = 0; bj < 2; ++bj)
#pragma unroll
                    for (int n = 0; n < 2; ++n) { f32x4 v = acc[ai][bj][m][n];
                        if (sg) { v[0] = silu_f(v[0]); v[1] = silu_f(v[1]); v[2] = silu_f(v[2]); v[3] = silu_f(v[3]); }
                        u32x2 o; o.x = pk2(v[0], v[1]); o.y = pk2(v[2], v[3]); *(u32x2*)(rp + bj * 128 + n * 16) = o; } }
    }
};
struct EpiGlu {
    static constexpr bool PERM = false, AFTER_DRAIN = false; static constexpr int MID = -1;
    bf16_t* __restrict__ A1; const bf16_t* __restrict__ SG;
    __device__ __forceinline__ void mid(f32x4 (&)[2][2][4][2], const Unit&, int, int, int, int, int) const {}
    __device__ __forceinline__ void operator()(const f32x4 (&acc)[2][2][4][2], const Unit& u, int wr, int wc, int fr, int fq) const {
        const int rowb = u.pm * 256 + wr * 64 + fr, colb = u.pn * 128 + wc * 32 + 4 * fq;
        u32x2 sgv[2][4][2];
#pragma unroll
        for (int ai = 0; ai < 2; ++ai)
#pragma unroll
            for (int m = 0; m < 4; ++m)
#pragma unroll
                for (int n = 0; n < 2; ++n) sgv[ai][m][n] = *(const u32x2*)(SG + (size_t)(rowb + ai * 128 + m * 16) * 2048 + colb + n * 16);
#pragma unroll
        for (int ai = 0; ai < 2; ++ai)
#pragma unroll
            for (int m = 0; m < 4; ++m) { const size_t ro = (size_t)(rowb + ai * 128 + m * 16) * 2048 + colb;
#pragma unroll
                for (int n = 0; n < 2; ++n) { const f32x4 ga = acc[ai][0][m][n], gb = acc[ai][1][m][n]; const u32x2 s = sgv[ai][m][n];
                    const float o0 = ga[0] * sigmoid_f(gb[0]) * bf_lo(s.x), o1 = ga[1] * sigmoid_f(gb[1]) * bf_hi(s.x), o2 = ga[2] * sigmoid_f(gb[2]) * bf_lo(s.y), o3 = ga[3] * sigmoid_f(gb[3]) * bf_hi(s.y);
                    u32x2 o; o.x = pk2(o0, o1); o.y = pk2(o2, o3); *(u32x2*)(A1 + ro + n * 16) = o; } }
    }
};
template <int MIDK> struct EpiOut {
    static constexpr bool PERM = false, AFTER_DRAIN = false; static constexpr int MID = MIDK;
    const float* __restrict__ resid; float* __restrict__ Y; const LAS float* rsl;
    __device__ __forceinline__ void mid(f32x4 (&acc)[2][2][4][2], const Unit& u, int ui, int wr, int wc, int fr, int fq) const {
        const LAS float* rp = rsl + ui * 256 + wr * 64 + fr;
#pragma unroll
        for (int ai = 0; ai < 2; ++ai)
#pragma unroll
            for (int m = 0; m < 4; ++m) { const float rs = rp[ai * 128 + m * 16];
#pragma unroll
                for (int bj = 0; bj < 2; ++bj)
#pragma unroll
                    for (int n = 0; n < 2; ++n) acc[ai][bj][m][n] *= rs; }
    }
    __device__ __forceinline__ void operator()(const f32x4 (&acc)[2][2][4][2], const Unit& u, int wr, int wc, int fr, int fq) const {
        const int rowb = u.pm * 256 + wr * 64 + fr, colb = u.pn * 256 + wc * 32 + 4 * fq;
#pragma unroll
        for (int ai = 0; ai < 2; ++ai)
#pragma unroll
            for (int mp = 0; mp < 2; ++mp) { f32x4 r[2][2][2];
#pragma unroll
                for (int mm = 0; mm < 2; ++mm) { const size_t ro = (size_t)(rowb + ai * 128 + (2 * mp + mm) * 16) * 2048 + colb;
#pragma unroll
                    for (int bj = 0; bj < 2; ++bj)
#pragma unroll
                        for (int n = 0; n < 2; ++n) r[mm][bj][n] = *(const f32x4*)(resid + ro + bj * 128 + n * 16); }
#pragma unroll
                for (int mm = 0; mm < 2; ++mm) { const size_t ro = (size_t)(rowb + ai * 128 + (2 * mp + mm) * 16) * 2048 + colb;
#pragma unroll
                    for (int bj = 0; bj < 2; ++bj)
#pragma unroll
                        for (int n = 0; n < 2; ++n) *(f32x4*)(Y + ro + bj * 128 + n * 16) = r[mm][bj][n] * ALPHA + acc[ai][bj][2 * mp + mm][n]; } }
    }
};

__device__ __forceinline__ void transpose_item(const float* W, int Nsrc, int nsrc0, bf16_t* WT, int Kdim, int k0, int ndst0, const float* kscale, LAS float* scr, int lane) {
    if (nsrc0 >= 0) {
#pragma unroll 8
        for (int i = 0; i < 32; ++i) { const int kk = 2 * i + (lane >> 5); float v = W[(size_t)(k0 + kk) * Nsrc + nsrc0 + (lane & 31)]; if (kscale) v *= kscale[k0 + kk]; scr[kk * 33 + (lane & 31)] = v; }
    } else {
#pragma unroll 8
        for (int i = 0; i < 32; ++i) { const int kk = 2 * i + (lane >> 5); scr[kk * 33 + (lane & 31)] = 0.f; }
    }
    LDS_WAIT();
    const int c = lane & 7;
#pragma unroll
    for (int j = 0; j < 4; ++j) { const int n = (lane >> 3) + 8 * j; const LAS float* s = scr + (8 * c) * 33 + n;
        u32x4 o; o.x = pk2(s[0 * 33], s[1 * 33]); o.y = pk2(s[2 * 33], s[3 * 33]); o.z = pk2(s[4 * 33], s[5 * 33]); o.w = pk2(s[6 * 33], s[7 * 33]);
        *(u32x4*)(WT + (size_t)(ndst0 + n) * Kdim + k0 + 8 * c) = o; }
    LDS_WAIT();
}
__device__ __forceinline__ void p0_phase(const Params& P, ldsp lds) {
    const int tid = threadIdx.x, wave = __builtin_amdgcn_readfirstlane(tid >> 6), lane = tid & 63;
    const int gw = blockIdx.x * 8 + wave, NGW = gridDim.x * 8;
    const size_t gtid = (size_t)blockIdx.x * 512 + tid, nth = (size_t)gridDim.x * 512;
    unsigned char* ws = P.ws;
    LAS float* scr = (LAS float*)(lds + wave * 8704);
    constexpr int I0 = 32 * 424, I1 = 64 * 64, I2 = 32 * 128, I3 = 32 * 128, I4 = 32 * 64;
    for (int it = gw; it < I0 + I1 + I2 + I3 + I4; it += NGW) {
        int r = it;
        if (r < I0) { const int kb = r / 424, nb = r % 424, nd = 32 * nb; const int ns = nd < 5120 ? nd : (nd < 13312 ? nd + 32 : (nd == 13312 ? 5120 : -1));
            transpose_item(P.in0_w, 13344, ns, (bf16_t*)(ws + OFF_W0T), 2048, 64 * kb, nd, nullptr, scr, lane); continue; } r -= I0;
        if (r < I1) { const int kb = r / 64, nb = r % 64; transpose_item(P.out0_w, 2048, 32 * nb, (bf16_t*)(ws + OFF_WO0), 4096, 64 * kb, 32 * nb, kb < 32 ? P.ssd_norm_g : nullptr, scr, lane); continue; } r -= I1;
        if (r < I2) { const int kb = r / 128, nb = r % 128; transpose_item(P.in1_w, 4096, 32 * nb, (bf16_t*)(ws + W1_OFF), W1_LD, 64 * kb, 32 * nb, nullptr, scr, lane); continue; } r -= I2;
        if (r < I3) { const int kb = r / 128, nb = r % 128, nd = 32 * nb; const int ns = ((nd >> 7) & 1) * 2048 + 128 * (nd >> 8) + (nd & 127);
            transpose_item(P.glu_w, 4096, ns, (bf16_t*)(ws + OFF_WG), 2048, 64 * kb, nd, nullptr, scr, lane); continue; } r -= I3;
        { const int kb = r / 64, nb = r % 64; transpose_item(P.out1_w, 2048, 32 * nb, (bf16_t*)(ws + OFF_WO1), 2048, 64 * kb, 32 * nb, nullptr, scr, lane); }
    }
    { const f32x4* xs = (const f32x4*)P.x; u32x2* xd = (u32x2*)(ws + OFF_XB);
      for (size_t i = gtid; i < (size_t)M * DM / 4; i += nth) { const f32x4 v = xs[i]; u32x2 o; o.x = pk2(v[0], v[1]); o.y = pk2(v[2], v[3]); xd[i] = o; } }
    { float* ct = (float*)(ws + OFF_CT); float* st = (float*)(ws + OFF_STB);
      for (size_t i = gtid; i < 4096 * 16; i += nth) { const int pos = (int)(i >> 4), k = (int)(i & 15); const float ang = (float)pos * INVF[k]; float s, c; sincos_d((double)ang, s, c); ct[i] = c; st[i] = s; } }

}

__device__ __forceinline__ void conv_phase(const Params& P) {
    const int tid = threadIdx.x, wave = __builtin_amdgcn_readfirstlane(tid >> 6), lane = tid & 63;
    const size_t gtid = (size_t)blockIdx.x * 512 + tid, nth = (size_t)gridDim.x * 512;
    const bf16_t* XR = (const bf16_t*)(P.ws + OFF_RB); bf16_t* X2 = (bf16_t*)(P.ws + OFF_XB);
    for (size_t it = gtid; it < (size_t)1024 * 384; it += nth) {
        const int tb = (int)(it / 384), cc = (int)(it % 384), t0 = tb * 16, ch = cc * 8;
        float w[4][8], bb[8];
#pragma unroll
        for (int j = 0; j < 4; ++j) { const f32x4 a = *(const f32x4*)(P.conv_w + j * 3072 + ch), b = *(const f32x4*)(P.conv_w + j * 3072 + ch + 4);
            w[j][0] = a[0]; w[j][1] = a[1]; w[j][2] = a[2]; w[j][3] = a[3]; w[j][4] = b[0]; w[j][5] = b[1]; w[j][6] = b[2]; w[j][7] = b[3]; }
        { const f32x4 a = *(const f32x4*)(P.conv_b + ch), b = *(const f32x4*)(P.conv_b + ch + 4); bb[0] = a[0]; bb[1] = a[1]; bb[2] = a[2]; bb[3] = a[3]; bb[4] = b[0]; bb[5] = b[1]; bb[6] = b[2]; bb[7] = b[3]; }
        const bool first = (t0 & (SEQ - 1)) == 0;
        u32x4 raw[19];
#pragma unroll
        for (int r = 0; r < 19; ++r) { if (r < 3 && first) raw[r] = (u32x4){0u, 0u, 0u, 0u}; else raw[r] = *(const u32x4*)(XR + (size_t)(t0 - 3 + r) * 3072 + ch); }
#pragma unroll
        for (int r = 0; r < 16; ++r) { float o[8];
#pragma unroll
            for (int e = 0; e < 8; ++e) o[e] = bb[e];
#pragma unroll
            for (int j = 0; j < 4; ++j) { const u32x4 q = raw[r + j];
                o[0] += w[j][0] * bf_lo(q.x); o[1] += w[j][1] * bf_hi(q.x); o[2] += w[j][2] * bf_lo(q.y); o[3] += w[j][3] * bf_hi(q.y);
                o[4] += w[j][4] * bf_lo(q.z); o[5] += w[j][5] * bf_hi(q.z); o[6] += w[j][6] * bf_lo(q.w); o[7] += w[j][7] * bf_hi(q.w); }
#pragma unroll
            for (int e = 0; e < 8; ++e) o[e] = silu_f(o[e]);
            u32x4 ov; ov.x = pk2(o[0], o[1]); ov.y = pk2(o[2], o[3]); ov.z = pk2(o[4], o[5]); ov.w = pk2(o[6], o[7]);
            *(u32x4*)(X2 + (size_t)(t0 + r) * 3072 + ch) = ov; }
    }
    float* DTw = (float*)(P.ws + OFF_DT); float* CUM = (float*)(P.ws + OFF_CUM);
    for (int it = blockIdx.x * 8 + wave; it < 2048; it += gridDim.x * 8) {
        const int b = it >> 9, c = (it >> 5) & 15, h = it & 31; const size_t rowbase = (size_t)b * 4096 + c * 256 + 4 * lane;
        const float Ah = -__expf(P.a_log[h]); const float bh = P.dt_bias[h]; const float* DTP = (const float*)(P.ws + OFF_DTP); float dtv[4];
#pragma unroll
        for (int k = 0; k < 4; ++k) { const size_t o = (rowbase + k) * 32 + h; const float sp = ((DTP[o] + DTP[o + (size_t)M * 32]) + (DTP[o + (size_t)2 * M * 32] + DTP[o + (size_t)3 * M * 32])) + bh; dtv[k] = softplus_f(sp); DTw[o] = dtv[k]; }
        const float a0 = dtv[0] * Ah, a1 = dtv[1] * Ah, a2 = dtv[2] * Ah, a3 = dtv[3] * Ah;
        const float s0 = a0, s1 = s0 + a1, s2 = s1 + a2, s3 = s2 + a3;
        float x = s3;
#pragma unroll
        for (int o = 1; o < 64; o <<= 1) { const float t = __shfl_up(x, o); if (lane >= o) x += t; }
        const float off = x - s3;
        CUM[(rowbase + 0) * 32 + h] = off + s0; CUM[(rowbase + 1) * 32 + h] = off + s1; CUM[(rowbase + 2) * 32 + h] = off + s2; CUM[(rowbase + 3) * 32 + h] = off + s3;
    }
}

__device__ __forceinline__ void ssd_a_phase(const Params& P, ldsp lds) {
    const int tid = threadIdx.x, wave = __builtin_amdgcn_readfirstlane(tid >> 6), lane = tid & 63, quad = lane >> 4, li = lane & 15, qq = li >> 2, pp = li & 3;
    const bf16_t* X2 = (const bf16_t*)(P.ws + OFF_XB); const float* DTf = (const float*)(P.ws + OFF_DT); const float* CUM = (const float*)(P.ws + OFF_CUM); float* ST = (float*)(P.ws + OFF_RB);
    ldsp Bl = lds, Xl = lds + 69632;
    for (int item = blockIdx.x; item < 256; item += gridDim.x) {
        const int b = item >> 6, c = (item >> 2) & 15, g = item & 3; const size_t rowbase = (size_t)b * 4096 + c * 256;
        __syncthreads();
#pragma unroll
        for (int k = 0; k < 8; ++k) { const int idx = tid + 512 * k, r = idx >> 4, ch = idx & 15; *(LAS u32x4*)(Bl + r * 272 + ch * 16) = *(const u32x4*)(X2 + (rowbase + r) * 3072 + 2048 + g * 128 + ch * 8); }
        for (int hh = 0; hh < 8; ++hh) { const int h = g * 8 + hh;
            __syncthreads();
            const float cl = CUM[(rowbase + 255) * 32 + h];
#pragma unroll
            for (int k = 0; k < 4; ++k) { const int idx = tid + 512 * k, r = idx >> 3, ch = idx & 7; const size_t row = rowbase + r;
                const float w = __expf(cl - CUM[row * 32 + h]) * DTf[row * 32 + h]; const u32x4 v = *(const u32x4*)(X2 + row * 3072 + h * 64 + ch * 8); u32x4 o;
                o.x = pk2(bf_lo(v.x) * w, bf_hi(v.x) * w); o.y = pk2(bf_lo(v.y) * w, bf_hi(v.y) * w); o.z = pk2(bf_lo(v.z) * w, bf_hi(v.z) * w); o.w = pk2(bf_lo(v.w) * w, bf_hi(v.w) * w);
                *(LAS u32x4*)(Xl + r * 160 + ch * 16) = o; }
            __syncthreads();
            f32x4 acc[4];
#pragma unroll
            for (int pt = 0; pt < 4; ++pt) acc[pt] = (f32x4){0.f, 0.f, 0.f, 0.f};
#pragma unroll
            for (int ks = 0; ks < 8; ++ks) { const int l0 = 32 * ks + 8 * quad + qq;
                const bf16x8 bop = cat8(vtr(Bl + l0 * 272 + (16 * wave + 4 * pp) * 2), vtr(Bl + (l0 + 4) * 272 + (16 * wave + 4 * pp) * 2));
#pragma unroll
                for (int pt = 0; pt < 4; ++pt) { const bf16x8 aop = cat8(vtr(Xl + l0 * 160 + (16 * pt + 4 * pp) * 2), vtr(Xl + (l0 + 4) * 160 + (16 * pt + 4 * pp) * 2)); acc[pt] = mfma16(aop, bop, acc[pt]); } }
            float* sp = ST + ((size_t)((b * 16 + c) * 32 + h) * 64) * 128 + 16 * wave + li;
#pragma unroll
            for (int pt = 0; pt < 4; ++pt)
#pragma unroll
                for (int j = 0; j < 4; ++j) sp[(size_t)(16 * pt + 4 * quad + j) * 128] = acc[pt][j];
        }
    }
}
__device__ __forceinline__ void ssd_b_phase(const Params& P) {
    const size_t gtid = (size_t)blockIdx.x * 512 + threadIdx.x, nth = (size_t)gridDim.x * 512;
    const float* ST = (const float*)(P.ws + OFF_RB); bf16_t* SIN = (bf16_t*)(P.ws + OFF_SIN); const float* CUM = (const float*)(P.ws + OFF_CUM);
    for (size_t it = gtid; it < (size_t)4 * 32 * 64 * 32; it += nth) {
        const int n4 = (int)(it & 31), p = (int)((it >> 5) & 63), h = (int)((it >> 11) & 31), b = (int)(it >> 16);
        f32x4 cur = (f32x4){0.f, 0.f, 0.f, 0.f};
#pragma unroll 4
        for (int c = 0; c < 16; ++c) { const size_t base = ((size_t)((b * 16 + c) * 32 + h) * 64 + p) * 128 + 4 * n4;
            u32x2 o; o.x = pk2(cur[0], cur[1]); o.y = pk2(cur[2], cur[3]); *(u32x2*)(SIN + base) = o;
            const float dec = __expf(CUM[((size_t)b * 4096 + c * 256 + 255) * 32 + h]); const f32x4 st = *(const f32x4*)(ST + base); cur = cur * dec + st; }
    }
}
__device__ __forceinline__ void ssd_c_phase(const Params& P, ldsp lds) {
    const int tid = threadIdx.x, wave = __builtin_amdgcn_readfirstlane(tid >> 6), lane = tid & 63, quad = lane >> 4, li = lane & 15, qq = li >> 2, pp = li & 3;
    const bf16_t* X2 = (const bf16_t*)(P.ws + OFF_XB); const float* DTf = (const float*)(P.ws + OFF_DT); const float* CUM = (const float*)(P.ws + OFF_CUM);
    const bf16_t* SIN = (const bf16_t*)(P.ws + OFF_SIN); float* SSQ = (float*)(P.ws + OFF_SSQ); bf16_t* A0 = (bf16_t*)P.out;
    ldsp Bl = lds, Xl = lds + 69632, Sl = lds + 110592; LAS float* cuml = (LAS float*)(lds + 128000); LAS float* dtl = cuml + 256;
    for (int item = blockIdx.x; item < 256; item += gridDim.x) {
        const int b = item >> 6, c = (item >> 2) & 15, g = item & 3; const size_t rowbase = (size_t)b * 4096 + c * 256;
        __syncthreads();
#pragma unroll
        for (int k = 0; k < 8; ++k) { const int idx = tid + 512 * k, r = idx >> 4, ch = idx & 15; *(LAS u32x4*)(Bl + r * 272 + ch * 16) = *(const u32x4*)(X2 + (rowbase + r) * 3072 + 2048 + g * 128 + ch * 8); }
        bf16x8 qf[2][4];
#pragma unroll
        for (int nt = 0; nt < 2; ++nt)
#pragma unroll
            for (int ks = 0; ks < 4; ++ks) qf[nt][ks] = *(const bf16x8*)(X2 + (rowbase + 32 * wave + 16 * nt + li) * 3072 + 2560 + g * 128 + 32 * ks + 8 * quad);
        for (int hh = 0; hh < 8; ++hh) { const int h = g * 8 + hh;
            __syncthreads();
#pragma unroll
            for (int k = 0; k < 4; ++k) { const int idx = tid + 512 * k, r = idx >> 3, ch = idx & 7; *(LAS u32x4*)(Xl + r * 160 + ch * 16) = *(const u32x4*)(X2 + (rowbase + r) * 3072 + h * 64 + ch * 8); }
#pragma unroll
            for (int k = 0; k < 2; ++k) { const int idx = tid + 512 * k, r = idx >> 4, ch = idx & 15; *(LAS u32x4*)(Sl + r * 272 + ch * 16) = *(const u32x4*)(SIN + ((size_t)((b * 16 + c) * 32 + h) * 64 + r) * 128 + ch * 8); }
            if (tid < 256) { cuml[tid] = CUM[(rowbase + tid) * 32 + h]; dtl[tid] = DTf[(rowbase + tid) * 32 + h]; }
            __syncthreads();
            f32x4 oacc[2][4];
#pragma unroll
            for (int nt = 0; nt < 2; ++nt)
#pragma unroll
                for (int pt = 0; pt < 4; ++pt) oacc[nt][pt] = (f32x4){0.f, 0.f, 0.f, 0.f};
#pragma unroll
            for (int pt = 0; pt < 4; ++pt)
#pragma unroll
                for (int ks = 0; ks < 4; ++ks) { const bf16x8 a = *(const LAS bf16x8*)(Sl + (16 * pt + li) * 272 + (32 * ks + 8 * quad) * 2);
                    oacc[0][pt] = mfma16(a, qf[0][ks], oacc[0][pt]); oacc[1][pt] = mfma16(a, qf[1][ks], oacc[1][pt]); }
            int lq[2]; float cq[2];
#pragma unroll
            for (int nt = 0; nt < 2; ++nt) { lq[nt] = 32 * wave + 16 * nt + li; cq[nt] = cuml[lq[nt]]; const float e = __expf(cq[nt]);
#pragma unroll
                for (int pt = 0; pt < 4; ++pt) oacc[nt][pt] *= e; }
            const int nkt = (32 * wave + 31) / 64 + 1;
#pragma unroll 1
            for (int kt = 0; kt < nkt; ++kt) {
                {
                    f32x4 sacc[2][4];
#pragma unroll
                    for (int nt = 0; nt < 2; ++nt)
#pragma unroll
                        for (int mt = 0; mt < 4; ++mt) sacc[nt][mt] = (f32x4){0.f, 0.f, 0.f, 0.f};
#pragma unroll
                    for (int mt = 0; mt < 4; ++mt)
#pragma unroll
                        for (int ks = 0; ks < 4; ++ks) { const bf16x8 a = *(const LAS bf16x8*)(Bl + (64 * kt + 16 * mt + li) * 272 + (32 * ks + 8 * quad) * 2);
                            sacc[0][mt] = mfma16(a, qf[0][ks], sacc[0][mt]); sacc[1][mt] = mfma16(a, qf[1][ks], sacc[1][mt]); }
#pragma unroll
                    for (int mt = 0; mt < 4; ++mt) { const int s0 = 64 * kt + 16 * mt + 4 * quad; const f32x4 cs = *(const LAS f32x4*)(cuml + s0), ds = *(const LAS f32x4*)(dtl + s0);
#pragma unroll
                        for (int nt = 0; nt < 2; ++nt)
#pragma unroll
                            for (int j = 0; j < 4; ++j) { const float v = sacc[nt][mt][j] * __expf(cq[nt] - cs[j]) * ds[j]; sacc[nt][mt][j] = (s0 + j <= lq[nt]) ? v : 0.f; } }
                    bf16x8 pb[2][2];
#pragma unroll
                    for (int nt = 0; nt < 2; ++nt)
#pragma unroll
                        for (int kk = 0; kk < 2; ++kk) { u32x4 t; t.x = pk2(sacc[nt][2 * kk][0], sacc[nt][2 * kk][1]); t.y = pk2(sacc[nt][2 * kk][2], sacc[nt][2 * kk][3]);
                            t.z = pk2(sacc[nt][2 * kk + 1][0], sacc[nt][2 * kk + 1][1]); t.w = pk2(sacc[nt][2 * kk + 1][2], sacc[nt][2 * kk + 1][3]); pb[nt][kk] = __builtin_bit_cast(bf16x8, t); }
#pragma unroll
                    for (int pt = 0; pt < 4; ++pt)
#pragma unroll
                        for (int kk = 0; kk < 2; ++kk) { const int r0 = 64 * kt + 32 * kk + 4 * quad + qq;
                            const bf16x8 a = cat8(vtr(Xl + r0 * 160 + (16 * pt + 4 * pp) * 2), vtr(Xl + (r0 + 16) * 160 + (16 * pt + 4 * pp) * 2));
                            oacc[0][pt] = mfma16(a, pb[0][kk], oacc[0][pt]); oacc[1][pt] = mfma16(a, pb[1][kk], oacc[1][pt]); }
                }
            }
            const float Dh = P.ssd_d[h];
#pragma unroll
            for (int nt = 0; nt < 2; ++nt) { const size_t row = rowbase + lq[nt]; float ss = 0.f;
#pragma unroll
                for (int pt = 0; pt < 4; ++pt) { const int col = h * 64 + 16 * pt + 4 * quad; const u32x2 xs = *(const u32x2*)(X2 + row * 3072 + col); const u32x2 z = *(const u32x2*)(A0 + row * 4096 + col);
                    const float t0 = (oacc[nt][pt][0] + Dh * bf_lo(xs.x)) * silu_f(bf_lo(z.x)), t1 = (oacc[nt][pt][1] + Dh * bf_hi(xs.x)) * silu_f(bf_hi(z.x));
                    const float t2 = (oacc[nt][pt][2] + Dh * bf_lo(xs.y)) * silu_f(bf_lo(z.y)), t3 = (oacc[nt][pt][3] + Dh * bf_hi(xs.y)) * silu_f(bf_hi(z.y));
                    ss += (t0 * t0 + t1 * t1) + (t2 * t2 + t3 * t3); u32x2 o; o.x = pk2(t0, t1); o.y = pk2(t2, t3); *(u32x2*)(A0 + row * 4096 + col) = o; }
                ss += __shfl_xor(ss, 16); ss += __shfl_xor(ss, 32);
                if (quad == 0) SSQ[row * 32 + h] = ss; }
        }
    }
}

__device__ __forceinline__ void moba_phase(const Params& P, ldsp lds, bf16_t* obase, int old_, unsigned rmask) {
    const int tid = threadIdx.x, wave = __builtin_amdgcn_readfirstlane(tid >> 6), lane = tid & 63, quad = lane >> 4, li = lane & 15, qq = li >> 2, pp = li & 3;
    bf16_t* A0 = (bf16_t*)P.out; const bf16_t* Kb = (const bf16_t*)(P.ws + OFF_K); const bf16_t* Vb = (const bf16_t*)(P.ws + OFF_V); const bf16_t* Gb = (const bf16_t*)(P.ws + OFF_G);
    const float* kmean = (const float*)(P.ws + OFF_KM);
    ldsp Kl = lds, Vl = lds + 34816; LAS float* gl = (LAS float*)(lds + 71680); LAS float* kml = (LAS float*)(lds + 89088); LAS unsigned* selm = (LAS unsigned*)(lds + 97280);
    const float c2 = 0.08838834764831845f * 1.4426950408889634f;
    const int G = gridDim.x, cb = blockIdx.x;
    const int sr = tid >> 4, sc = tid & 15;
    for (int kr = 0; kr * G < 1024; ++kr) {
        const int idx = (kr & 1) ? (kr * G + G - 1 - cb) : (kr * G + cb);
        if (idx >= 1024) continue;
        const int i = 15 - (idx >> 6), b = (idx & 63) >> 4, h = idx & 15;
        const size_t qrow0 = (size_t)b * 4096 + i * 256;
        __syncthreads();
        { const float* kq = kmean + (size_t)((b * 16 + h) * 16) * 128 + tid * 4; f32x4 v = *(const f32x4*)kq + *(const f32x4*)(kq + 131072); v *= (1.f / 256.f); *(LAS f32x4*)(kml + tid * 4) = v; }
        __syncthreads();
        { const int r = tid >> 1, hf = tid & 1; const bf16_t* qp = A0 + (qrow0 + r) * 4096 + 2048 + h * 128; float gs[8];
#pragma unroll
          for (int jb = 0; jb < 8; ++jb) gs[jb] = 0.f;
#pragma unroll 2
          for (int dc = 0; dc < 16; ++dc) { const u32x4 qv = *(const u32x4*)(qp + dc * 8);
              const float q0 = bf_lo(qv.x), q1 = bf_hi(qv.x), q2 = bf_lo(qv.y), q3 = bf_hi(qv.y), q4 = bf_lo(qv.z), q5 = bf_hi(qv.z), q6 = bf_lo(qv.w), q7 = bf_hi(qv.w);
#pragma unroll
              for (int jb = 0; jb < 8; ++jb) { const LAS float* kp = kml + (hf * 8 + jb) * 128 + dc * 8; const f32x4 k0 = *(const LAS f32x4*)kp, k1 = *(const LAS f32x4*)(kp + 4);
                  gs[jb] += (q0 * k0[0] + q1 * k0[1]) + (q2 * k0[2] + q3 * k0[3]) + (q4 * k1[0] + q5 * k1[1]) + (q6 * k1[2] + q7 * k1[3]); } }
#pragma unroll
          for (int jb = 0; jb < 8; ++jb) gl[r * 17 + hf * 8 + jb] = gs[jb]; }
        __syncthreads();
        if (tid < 256) { unsigned mask = 0u; const int nsel = i < 3 ? i : 3;
            for (int s = 0; s < nsel; ++s) { float best = -INFINITY; int bj = -1;
                for (int j = 0; j < i; ++j) { const float v = gl[tid * 17 + j]; if (!((mask >> j) & 1u) && v > best) { best = v; bj = j; } }
                if (bj >= 0) mask |= 1u << bj; }
            selm[tid] = mask; }
        bf16x8 qf[2][4];
#pragma unroll
        for (int nt = 0; nt < 2; ++nt)
#pragma unroll
            for (int ks = 0; ks < 4; ++ks) qf[nt][ks] = *(const bf16x8*)(A0 + (qrow0 + 32 * wave + 16 * nt + li) * 4096 + 2048 + h * 128 + 32 * ks + 8 * quad);
        const int ntile = 4 * (i + 1);
        u32x4 kreg[2], vreg[2];
        { const size_t kr0 = (qrow0 + sr) * 2048 + h * 128 + sc * 8;
          kreg[0] = *(const u32x4*)(Kb + kr0); kreg[1] = *(const u32x4*)(Kb + kr0 + 32 * 2048); vreg[0] = *(const u32x4*)(Vb + kr0); vreg[1] = *(const u32x4*)(Vb + kr0 + 32 * 2048); }
        *(LAS u32x4*)(Kl + sr * 272 + sc * 16) = kreg[0]; *(LAS u32x4*)(Kl + (sr + 32) * 272 + sc * 16) = kreg[1];
        *(LAS u32x4*)(Vl + sr * 288 + sc * 16) = vreg[0]; *(LAS u32x4*)(Vl + (sr + 32) * 288 + sc * 16) = vreg[1];
        __syncthreads();
        unsigned sel[2]; float mrun[2], lrun[2]; f32x4 oacc[2][8];
#pragma unroll
        for (int nt = 0; nt < 2; ++nt) { sel[nt] = selm[32 * wave + 16 * nt + li]; mrun[nt] = -1e30f; lrun[nt] = 0.f;
#pragma unroll
            for (int dt = 0; dt < 8; ++dt) oacc[nt][dt] = (f32x4){0.f, 0.f, 0.f, 0.f}; }
        for (int tt = 0; tt < ntile; ++tt) {
            const int buf = tt & 1;
            u32x4 kn0, kn1, vn0, vn1;
            { const int t1 = (tt + 1 < ntile) ? tt + 1 : tt; const int jb = (t1 < 4) ? i : (t1 >> 2) - 1; const int kt1 = t1 & 3;
                const size_t kr0 = ((size_t)b * 4096 + jb * 256 + kt1 * 64 + sr) * 2048 + h * 128 + sc * 8;
                kn0 = *(const u32x4*)(Kb + kr0); kn1 = *(const u32x4*)(Kb + kr0 + 32 * 2048); vn0 = *(const u32x4*)(Vb + kr0); vn1 = *(const u32x4*)(Vb + kr0 + 32 * 2048); }
            const bool own = tt < 4; const int kt = tt & 3; const int jblk = own ? i : (tt >> 2) - 1;
            bool active;
            if (own) active = (64 * kt <= 32 * wave + 31); else active = __any((int)(((sel[0] | sel[1]) >> jblk) & 1u)) != 0;
            if (active) {
                ldsp Kt = Kl + buf * 17408; ldsp Vt = Vl + buf * 18432;
                f32x4 sacc[2][4];
#pragma unroll
                for (int nt = 0; nt < 2; ++nt)
#pragma unroll
                    for (int mt = 0; mt < 4; ++mt) sacc[nt][mt] = (f32x4){0.f, 0.f, 0.f, 0.f};
                { bf16x8 kf[2][4];
#pragma unroll
                  for (int ks = 0; ks < 4; ++ks) kf[0][ks] = *(const LAS bf16x8*)(Kt + li * 272 + (32 * ks + 8 * quad) * 2);
#pragma unroll
                  for (int mt = 0; mt < 4; ++mt) {
                      if (mt < 3) {
#pragma unroll
                          for (int ks = 0; ks < 4; ++ks) kf[(mt + 1) & 1][ks] = *(const LAS bf16x8*)(Kt + (16 * (mt + 1) + li) * 272 + (32 * ks + 8 * quad) * 2); }
                      __builtin_amdgcn_sched_barrier(0);
#pragma unroll
                      for (int ks = 0; ks < 4; ++ks) { sacc[0][mt] = mfma16(kf[mt & 1][ks], qf[0][ks], sacc[0][mt]); sacc[1][mt] = mfma16(kf[mt & 1][ks], qf[1][ks], sacc[1][mt]); }
                      __builtin_amdgcn_sched_barrier(0);
                  } }
                bf16x8 pb[2][2];
#pragma unroll
                for (int nt = 0; nt < 2; ++nt) { const int qpos = 32 * wave + 16 * nt + li; const bool selj = ((sel[nt] >> jblk) & 1u) != 0u; float alpha, ps = 0.f;
                    if (own) {
                        float mx = -1e30f;
#pragma unroll
                        for (int mt = 0; mt < 4; ++mt)
#pragma unroll
                            for (int j = 0; j < 4; ++j) { const int kpos = 64 * kt + 16 * mt + 4 * quad + j;
                                const float s = (kpos <= qpos) ? sacc[nt][mt][j] * c2 : -1e30f; sacc[nt][mt][j] = s; mx = fmaxf(mx, s); }
                        mx = fmaxf(mx, __shfl_xor(mx, 16)); mx = fmaxf(mx, __shfl_xor(mx, 32));
                        const float mnew = fmaxf(mrun[nt], mx); alpha = __builtin_amdgcn_exp2f(mrun[nt] - mnew); mrun[nt] = mnew;
#pragma unroll
                        for (int mt = 0; mt < 4; ++mt)
#pragma unroll
                            for (int j = 0; j < 4; ++j) { const float p = __builtin_amdgcn_exp2f(sacc[nt][mt][j] - mnew); sacc[nt][mt][j] = p; ps += p; }
                    } else {
                        const float bias = selj ? 0.f : -1e30f; float mx = sacc[nt][0][0];
#pragma unroll
                        for (int mt = 0; mt < 4; ++mt)
#pragma unroll
                            for (int j = 0; j < 4; ++j) mx = fmaxf(mx, sacc[nt][mt][j]);
                        mx = fmaxf(mx, __shfl_xor(mx, 16)); mx = fmaxf(mx, __shfl_xor(mx, 32));
                        const float mnew = fmaxf(mrun[nt], fmaf(mx, c2, bias)); alpha = __builtin_amdgcn_exp2f(mrun[nt] - mnew); mrun[nt] = mnew; const float nb = bias - mnew;
#pragma unroll
                        for (int mt = 0; mt < 4; ++mt)
#pragma unroll
                            for (int j = 0; j < 4; ++j) { const float p = __builtin_amdgcn_exp2f(fmaf(sacc[nt][mt][j], c2, nb)); sacc[nt][mt][j] = p; ps += p; }
                    }
                    lrun[nt] = lrun[nt] * alpha + ps;
#pragma unroll
                    for (int dt = 0; dt < 8; ++dt) oacc[nt][dt] *= alpha;
#pragma unroll
                    for (int kk = 0; kk < 2; ++kk) { u32x4 t; t.x = pk2(sacc[nt][2 * kk][0], sacc[nt][2 * kk][1]); t.y = pk2(sacc[nt][2 * kk][2], sacc[nt][2 * kk][3]);
                        t.z = pk2(sacc[nt][2 * kk + 1][0], sacc[nt][2 * kk + 1][1]); t.w = pk2(sacc[nt][2 * kk + 1][2], sacc[nt][2 * kk + 1][3]); pb[nt][kk] = __builtin_bit_cast(bf16x8, t); }
                }
                { bf16x8 vf[2][2]; const ldsp vbase = Vt + (4 * quad + qq) * 288 + 8 * pp;
#pragma unroll
                  for (int kk = 0; kk < 2; ++kk) vf[0][kk] = cat8(vtr(vbase + (32 * kk) * 288), vtr(vbase + (32 * kk + 16) * 288));
#pragma unroll
                  for (int dt = 0; dt < 8; ++dt) {
                      if (dt < 7) {
#pragma unroll
                          for (int kk = 0; kk < 2; ++kk) vf[(dt + 1) & 1][kk] = cat8(vtr(vbase + (32 * kk) * 288 + 32 * (dt + 1)), vtr(vbase + (32 * kk + 16) * 288 + 32 * (dt + 1))); }
                      __builtin_amdgcn_sched_barrier(0);
#pragma unroll
                      for (int kk = 0; kk < 2; ++kk) { oacc[0][dt] = mfma16(vf[dt & 1][kk], pb[0][kk], oacc[0][dt]); oacc[1][dt] = mfma16(vf[dt & 1][kk], pb[1][kk], oacc[1][dt]); }
                      __builtin_amdgcn_sched_barrier(0);
                  } }
            }
            { ldsp Kn = Kl + (buf ^ 1) * 17408; ldsp Vn = Vl + (buf ^ 1) * 18432;
                *(LAS u32x4*)(Kn + sr * 272 + sc * 16) = kn0; *(LAS u32x4*)(Kn + (sr + 32) * 272 + sc * 16) = kn1;
                *(LAS u32x4*)(Vn + sr * 288 + sc * 16) = vn0; *(LAS u32x4*)(Vn + (sr + 32) * 288 + sc * 16) = vn1; }
            __syncthreads();
        }
#pragma unroll
        for (int nt = 0; nt < 2; ++nt) { float l = lrun[nt]; l += __shfl_xor(l, 16); l += __shfl_xor(l, 32); const float inv = 1.f / l; const size_t row = qrow0 + 32 * wave + 16 * nt + li;
#pragma unroll
            for (int dt = 0; dt < 8; ++dt) { const int col = h * 128 + 16 * dt + 4 * quad; const u32x2 gv = *(const u32x2*)(Gb + row * 2048 + col);
                u32x2 o; o.x = pk2(oacc[nt][dt][0] * inv * bf_lo(gv.x), oacc[nt][dt][1] * inv * bf_hi(gv.x)); o.y = pk2(oacc[nt][dt][2] * inv * bf_lo(gv.y), oacc[nt][dt][3] * inv * bf_hi(gv.y));
                *(u32x2*)(obase + (size_t)((unsigned)row & rmask) * old_ + col) = o; } }
    }
}

__device__ __forceinline__ void ln_phase(const float* Y, const float* g, const float* bta, float* outf, bf16_t* outb, int ldb_) {
    const int lane = threadIdx.x & 63; const int gw = blockIdx.x * 8 + __builtin_amdgcn_readfirstlane(threadIdx.x >> 6), NGW = gridDim.x * 8;
    f32x4 gv[8], bv[8];
#pragma unroll
    for (int k = 0; k < 8; ++k) { gv[k] = ((const f32x4*)g)[lane + 64 * k]; bv[k] = ((const f32x4*)bta)[lane + 64 * k]; }
    for (int row = gw; row < M; row += NGW) { const f32x4* yr = (const f32x4*)(Y + (size_t)row * 2048); f32x4 v[8]; float s = 0.f;
#pragma unroll
        for (int k = 0; k < 8; ++k) { v[k] = yr[lane + 64 * k]; s += (v[k][0] + v[k][1]) + (v[k][2] + v[k][3]); }
#pragma unroll
        for (int o = 1; o < 64; o <<= 1) s += __shfl_xor(s, o);
        const float mu = s * (1.f / 2048.f); float s2 = 0.f;
#pragma unroll
        for (int k = 0; k < 8; ++k) { v[k] = v[k] - mu; s2 += (v[k][0] * v[k][0] + v[k][1] * v[k][1]) + (v[k][2] * v[k][2] + v[k][3] * v[k][3]); }
#pragma unroll
        for (int o = 1; o < 64; o <<= 1) s2 += __shfl_xor(s2, o);
        const float rstd = rsqrtf(s2 * (1.f / 2048.f) + 1e-5f);
#pragma unroll
        for (int k = 0; k < 8; ++k) { const f32x4 o = v[k] * rstd * gv[k] + bv[k]; ((f32x4*)(outf + (size_t)row * 2048))[lane + 64 * k] = o;
            if (outb) { u32x2 ob; ob.x = pk2(o[0], o[1]); ob.y = pk2(o[2], o[3]); ((u32x2*)(outb + (size_t)row * ldb_))[lane + 64 * k] = ob; } }
    }
}

__device__ __forceinline__ void s5_phase(const Params& P, ldsp lds) {
    const int tid = threadIdx.x, wave = __builtin_amdgcn_readfirstlane(tid >> 6), lane = tid & 63, quad = lane >> 4, li = lane & 15, qq = li >> 2, pp = li & 3;
    const bf16_t* U = (const bf16_t*)(P.ws + OFF_K); bf16_t* YG = (bf16_t*)(P.ws + OFF_RB);
    const int sq = wave >> 2, role = (wave + 2 * sq) & 3;
    ldsp BUl = lds + sq * 32768; ldsp Hl = lds + sq * 32768 + 20480; ldsp Rl = lds + 65536 + sq * 8192;
    for (int it0 = blockIdx.x; it0 < 256; it0 += gridDim.x) {
        const int item = it0 + 256 * sq;
        const int b = item >> 7, g = item & 127;
        const float dtg = expf(P.log_dt[g]);
        float lbr, lbi;
        { const float lr = P.lam_re[g * 64 + lane], lim = P.lam_im[g * 64 + lane]; const float e = expf(lr * dtg); float s, c; sincos_d((double)(lim * dtg), s, c); lbr = e * c; lbi = e * s; }
        bf16x8 bbf[8], cmf[4];
#pragma unroll
        for (int tile = 0; tile < 8; ++tile) { const int n = (16 * tile + li) & 63; const bool isim = tile >= 4;
            const float lr = P.lam_re[g * 64 + n], lim = P.lam_im[g * 64 + n]; const float e = expf(lr * dtg); float s, c; sincos_d((double)(lim * dtg), s, c);
            const float ar = e * c - 1.f, aim = e * s; const float den = 1.f / (lr * lr + lim * lim); const float cr = (ar * lr + aim * lim) * den, ci = (aim * lr - ar * lim) * den;
            u32x4 t = (u32x4){0u, 0u, 0u, 0u};
            if (quad < 2) { const float* br = P.b_re + ((size_t)(g * 64 + n)) * 16 + 8 * quad; const float* bi = P.b_im + ((size_t)(g * 64 + n)) * 16 + 8 * quad; float o[8];
#pragma unroll
                for (int e2 = 0; e2 < 8; ++e2) { const float xr = br[e2], xi = bi[e2]; o[e2] = isim ? (cr * xi + ci * xr) : (cr * xr - ci * xi); }
                t.x = pk2(o[0], o[1]); t.y = pk2(o[2], o[3]); t.z = pk2(o[4], o[5]); t.w = pk2(o[6], o[7]); }
            bbf[tile] = __builtin_bit_cast(bf16x8, t); }
#pragma unroll
        for (int ks = 0; ks < 4; ++ks) { const float* cp = (ks < 2 ? P.c_re : P.c_im) + ((size_t)(g * 16 + li)) * 64 + 32 * (ks & 1) + 8 * quad; const float sg = ks < 2 ? 1.f : -1.f;
            u32x4 t; t.x = pk2(sg * cp[0], sg * cp[1]); t.y = pk2(sg * cp[2], sg * cp[3]); t.z = pk2(sg * cp[4], sg * cp[5]); t.w = pk2(sg * cp[6], sg * cp[7]); cmf[ks] = __builtin_bit_cast(bf16x8, t); }
        const f32x4 dsk = *(const f32x4*)(P.s5_d + g * 16 + 4 * quad);
        const bf16_t* ub = U + ((size_t)b * 4096) * 2048 + g * 16;
        bf16_t* yb = YG + ((size_t)b * 4096) * 2048 + g * 16;
        float hr = 0.f, hi = 0.f;
#define S5_BAR() do { asm volatile("s_waitcnt lgkmcnt(0)" ::: "memory"); __builtin_amdgcn_s_barrier(); asm volatile("" ::: "memory"); } while (0)
#define S5_DMA(st) __builtin_amdgcn_global_load_lds((const unsigned*)(ub + (size_t)((st) * 16 + li) * 2048 + 8 * (quad & 1)), (LAS unsigned*)(Rl + ((st) & 7) * 1024), 16, 0, 0)
        if (role == 3) {
            S5_DMA(0); S5_DMA(1); S5_DMA(2); S5_DMA(3);
            asm volatile("s_waitcnt vmcnt(0)" ::: "memory"); S5_BAR();
            for (int s = -1; s <= 256; ++s) { if (s + 5 < 256) S5_DMA(s + 5); asm volatile("s_waitcnt vmcnt(2)" ::: "memory"); S5_BAR(); }
        } else if (role == 0) {
            S5_BAR();
            for (int s = -1; s <= 256; ++s) {
                if (s + 1 < 256) { u32x4 areg = *(const LAS u32x4*)(Rl + ((s + 1) & 7) * 1024 + lane * 16); if (quad >= 2) areg = (u32x4){0u, 0u, 0u, 0u};
                    const bf16x8 a_ = __builtin_bit_cast(bf16x8, areg); ldsp bw_ = BUl + ((s + 1) & 1) * 10240;
#pragma unroll
                    for (int tile = 0; tile < 8; ++tile) { const f32x4 bu = mfma16(a_, bbf[tile], (f32x4){0.f, 0.f, 0.f, 0.f}); *(LAS f32x4*)(bw_ + (16 * tile + li) * 80 + 16 * quad) = bu; } }
                S5_BAR(); }
        } else if (role == 1) {
            S5_BAR();
            for (int s = -1; s <= 256; ++s) {
                if (s >= 0 && s < 256) { f32x4 br[4], bi[4]; ldsp br_ = BUl + (s & 1) * 10240;
#pragma unroll
                    for (int q = 0; q < 4; ++q) { br[q] = *(const LAS f32x4*)(br_ + lane * 80 + 16 * q); bi[q] = *(const LAS f32x4*)(br_ + (64 + lane) * 80 + 16 * q); }
                    float hrs[16], his[16];
#pragma unroll
                    for (int t = 0; t < 16; ++t) { const float nr = lbr * hr - lbi * hi + br[t >> 2][t & 3], ni = lbr * hi + lbi * hr + bi[t >> 2][t & 3]; hr = nr; hi = ni; hrs[t] = hr; his[t] = hi; }
                    ldsp hw_ = Hl + (s & 1) * 6144;
#pragma unroll
                    for (int q = 0; q < 2; ++q) { u32x4 wr_, wi_;
                        wr_.x = pk2(hrs[8 * q + 0], hrs[8 * q + 1]); wr_.y = pk2(hrs[8 * q + 2], hrs[8 * q + 3]); wr_.z = pk2(hrs[8 * q + 4], hrs[8 * q + 5]); wr_.w = pk2(hrs[8 * q + 6], hrs[8 * q + 7]);
                        wi_.x = pk2(his[8 * q + 0], his[8 * q + 1]); wi_.y = pk2(his[8 * q + 2], his[8 * q + 3]); wi_.z = pk2(his[8 * q + 4], his[8 * q + 5]); wi_.w = pk2(his[8 * q + 6], his[8 * q + 7]);
                        *(LAS u32x4*)(hw_ + lane * 48 + 16 * q) = wr_; *(LAS u32x4*)(hw_ + (64 + lane) * 48 + 16 * q) = wi_; } }
                S5_BAR(); }
        } else {
            S5_BAR();
            for (int s = -1; s <= 256; ++s) {
                if (s >= 1) { const u32x2 uu = *(const LAS u32x2*)(Rl + ((s - 1) & 7) * 1024 + (li + 16 * (quad >> 1)) * 16 + 8 * (quad & 1));
                    ldsp hp_ = Hl + ((s - 1) & 1) * 6144; f32x4 yacc = (f32x4){0.f, 0.f, 0.f, 0.f};
#pragma unroll
                    for (int ks = 0; ks < 4; ++ks) { const int r0 = 32 * ks + 8 * quad + qq; const bf16x8 bop = cat8(vtr(hp_ + r0 * 48 + 8 * pp), vtr(hp_ + (r0 + 4) * 48 + 8 * pp)); yacc = mfma16(cmf[ks], bop, yacc); }
                    const float y0 = yacc[0] + dsk[0] * bf_lo(uu.x), y1 = yacc[1] + dsk[1] * bf_hi(uu.x), y2 = yacc[2] + dsk[2] * bf_lo(uu.y), y3 = yacc[3] + dsk[3] * bf_hi(uu.y);
                    u32x2 o; o.x = pk2(gelu_tanh_f(y0), gelu_tanh_f(y1)); o.y = pk2(gelu_tanh_f(y2), gelu_tanh_f(y3)); *(u32x2*)(yb + (size_t)((s - 1) * 16 + li) * 2048 + 4 * quad) = o; }
                S5_BAR(); }
        }
#undef S5_BAR
#undef S5_DMA
        asm volatile("s_waitcnt vmcnt(0) lgkmcnt(0)" ::: "memory"); __syncthreads();
    }
}

template <class Epi> __device__ __forceinline__ void run_gemm(ldsp lds, const bf16_t* A, int lda, const bf16_t* Bt, int ldb, int N, int K, const Epi& E) {
    pg8::Gemm g; g.A = A; g.Bt = Bt; g.M = M; g.N = N; g.K = K; g.lda = lda; g.ldb = ldb; g.alias_a = 0; g.mtiles = 1 << 20;
    pg8::StaticOrder S; S.init(M, N, (int)gridDim.x, (int)blockIdx.x);
#if GEMM_SKEW_TICKS > 0
    {
      const unsigned sk = (unsigned)GEMM_SKEW_TICKS * (((blockIdx.x >> 3) & 7u) + ((blockIdx.x >> 6) & 3u));
      if (threadIdx.x == 0) { const unsigned long long t0 = __builtin_amdgcn_s_memrealtime(); while (__builtin_amdgcn_s_memrealtime() - t0 < sk) __builtin_amdgcn_s_sleep(8); }
      __syncthreads(); }
#endif
    pg8::gemm_phase<Epi, pg8::StaticOrder, false>(lds, g, S, E, nullptr);
}

__device__ __forceinline__ void gsync(cg::grid_group& grid) {
    asm volatile("s_waitcnt vmcnt(0) lgkmcnt(0)" ::: "memory");
    __syncthreads();
    if (threadIdx.x < 64) { __builtin_amdgcn_fence(__ATOMIC_RELEASE, "agent"); asm volatile("s_waitcnt vmcnt(0)" ::: "memory"); }
    grid.sync();
#if GSYNC_WAVE_ACQ
    __builtin_amdgcn_fence(__ATOMIC_ACQUIRE, ""); asm volatile("s_waitcnt vmcnt(0)" ::: "memory");
#else
    if (threadIdx.x < 64) { __builtin_amdgcn_fence(__ATOMIC_ACQUIRE, "agent"); asm volatile("s_waitcnt vmcnt(0)" ::: "memory"); }
#endif
    __syncthreads();
}
#ifndef REP_P0
#define REP_P0 1
#endif
#ifndef REP_IN0
#define REP_IN0 1
#endif
#ifndef REP_CONV
#define REP_CONV 1
#endif
#ifndef REP_MOBA_DUMMY
#define REP_MOBA_DUMMY 0
#endif
#ifndef REP_SSDA
#define REP_SSDA 1
#endif
#ifndef REP_SSDB
#define REP_SSDB 1
#endif
#ifndef REP_LN0
#define REP_LN0 1
#endif
#ifndef REP_IN1
#define REP_IN1 1
#endif
#ifndef REP_S5
#define REP_S5 1
#endif
#ifndef PHASE_MASK
#define PHASE_MASK 0x3fff
#endif
#if defined(__HIP_DEVICE_COMPILE__)
#define GETP() ({ const __attribute__((address_space(4))) Params* kp_ = (const __attribute__((address_space(4))) Params*)__builtin_amdgcn_kernarg_segment_ptr(); asm volatile("" : "+s"(kp_)); *kp_; })
#else
#define GETP() (P_unused)
#endif
__global__ void __launch_bounds__(512, 2) mega_fwd(Params P_unused) {
    constexpr int PM = PHASE_MASK;
    extern __shared__ __attribute__((aligned(16))) unsigned char shm[];
    ldsp lds = (ldsp)shm;
    cg::grid_group grid = cg::this_grid();
    for (int rep = 0; rep < REP_P0; ++rep) { const Params P = GETP(); p0_phase(P, lds); }
    gsync(grid);
    for (int rep = 0; rep < REP_IN0; ++rep) { const Params P = GETP(); unsigned char* ws = P.ws;
      EpiIn0 E; E.A0 = (bf16_t*)P.out; E.XBCraw = (bf16_t*)(ws + OFF_RB); E.Kb = (bf16_t*)(ws + OFF_K); E.Vb = (bf16_t*)(ws + OFF_V); E.Gb = (bf16_t*)(ws + OFF_G);
      E.DTf = (float*)(ws + OFF_DT); E.kmean = (float*)(ws + OFF_KM); E.ctab = (const float*)(ws + OFF_CT); E.stab = (const float*)(ws + OFF_STB); E.dt_bias = P.dt_bias;
      run_gemm(lds, (const bf16_t*)(ws + OFF_XB), 2048, (const bf16_t*)(ws + OFF_W0T), 2048, 13312, 2048, E);
      { EpiDT ED; ED.DTP = (float*)(ws + OFF_DTP);
        pg8::Gemm g; g.A = (const bf16_t*)(ws + OFF_XB); g.Bt = (const bf16_t*)(ws + OFF_W0T) + (size_t)13312 * 2048; g.M = 4 * M; g.N = 256; g.K = 512; g.lda = 2048; g.ldb = 2048; g.alias_a = 0; g.mtiles = 64;
        pg8::StaticOrder S; S.init(4 * M, 256, (int)gridDim.x, (int)blockIdx.x); pg8::gemm_phase<EpiDT, pg8::StaticOrder, false>(lds, g, S, ED, nullptr); } }
    gsync(grid);
    for (int rep = 0; rep < REP_CONV; ++rep) { const Params P = GETP(); conv_phase(P); }
    gsync(grid);
    for (int rep = 0; rep < REP_MOBA_DUMMY; ++rep) { const Params P = GETP(); moba_phase(P, lds, (bf16_t*)(P.ws + WS_END), 2048, 4095u); }
    if (PM & 8) { const Params P = GETP(); moba_phase(P, lds, (bf16_t*)P.out + 2048, 4096, 0xffffffffu); }
    for (int rep = 0; rep < REP_SSDA; ++rep) { const Params P = GETP(); ssd_a_phase(P, lds); }
    gsync(grid);
    for (int rep = 0; rep < REP_SSDB; ++rep) { const Params P = GETP(); ssd_b_phase(P); }
    gsync(grid);
    if (PM & 64) { const Params P = GETP(); ssd_c_phase(P, lds); }
    gsync(grid);
    if (PM & 128) { const Params P = GETP(); unsigned char* ws = P.ws;
      EpiOut<32> E; E.resid = P.x; E.Y = (float*)(ws + OFF_K); E.rsl = (const LAS float*)(lds + 131072);
      { pg8::StaticOrder S; S.init(M, 2048, (int)gridDim.x, (int)blockIdx.x); const float* ssq = (const float*)(ws + OFF_SSQ); LAS float* rw = (LAS float*)(lds + 131072);
        for (int q = threadIdx.x; q < 2048; q += 512) { const int ui = q >> 8; Unit u; if (S.next(ui, u)) { const f32x4* p = (const f32x4*)(ssq + (size_t)(u.pm * 256 + (q & 255)) * 32); float sm = 0.f;
#pragma unroll
            for (int k = 0; k < 8; ++k) { const f32x4 v = p[k]; sm += (v[0] + v[1]) + (v[2] + v[3]); }
            rw[q] = rsqrtf(sm * (1.f / 2048.f) + 1e-5f); } }
        __syncthreads(); }
      run_gemm(lds, (const bf16_t*)P.out, 4096, (const bf16_t*)(ws + OFF_WO0), 4096, 2048, 4096, E); }
    gsync(grid);
    for (int rep = 0; rep < REP_LN0; ++rep) { const Params P = GETP(); unsigned char* ws = P.ws; ln_phase((const float*)(ws + OFF_K), P.ln_g, P.ln_b, P.out, (bf16_t*)(ws + X1B_OFF), X1B_LD); }
    gsync(grid);
#ifdef PROBE_L2GEMM
    { const Params P = GETP(); unsigned char* ws = P.ws; EpiIn1 E; E.U = (bf16_t*)(ws + OFF_XB); E.SG = (bf16_t*)(ws + OFF_RB);
      pg8::Gemm g; g.A = (const bf16_t*)(ws + X1B_OFF); g.Bt = (const bf16_t*)(ws + W1_OFF); g.M = M; g.N = 4096; g.K = 2048; g.lda = X1B_LD; g.ldb = W1_LD; g.alias_a = 1; g.mtiles = 1 << 20;
      pg8::StaticOrder S; S.init(M, 4096, (int)gridDim.x, (int)blockIdx.x); pg8::gemm_phase<EpiIn1, pg8::StaticOrder, false>(lds, g, S, E, nullptr); }
#endif
    for (int rep = 0; rep < REP_IN1; ++rep) { const Params P = GETP(); unsigned char* ws = P.ws;
      EpiIn1 E; E.U = (bf16_t*)(ws + OFF_K); E.SG = (bf16_t*)(ws + OFF_V);
      run_gemm(lds, (const bf16_t*)(ws + X1B_OFF), X1B_LD, (const bf16_t*)(ws + W1_OFF), W1_LD, 4096, 2048, E); }
    gsync(grid);
    for (int rep = 0; rep < REP_S5; ++rep) { const Params P = GETP(); s5_phase(P, lds); }
    gsync(grid);
    if (PM & 2048) { const Params P = GETP(); unsigned char* ws = P.ws;
      EpiGlu E; E.A1 = (bf16_t*)(ws + OFF_XB); E.SG = (const bf16_t*)(ws + OFF_V);
      run_gemm(lds, (const bf16_t*)(ws + OFF_RB), 2048, (const bf16_t*)(ws + OFF_WG), 2048, 4096, 2048, E); }
    gsync(grid);
    if (PM & 4096) { const Params P = GETP(); unsigned char* ws = P.ws;
      EpiOut<-1> E; E.resid = P.out; E.Y = (float*)(ws + OFF_K); E.rsl = nullptr;
      run_gemm(lds, (const bf16_t*)(ws + OFF_XB), 2048, (const bf16_t*)(ws + OFF_WO1), 2048, 2048, 2048, E); }
    gsync(grid);
    if (PM & 8192) { const Params P = GETP(); unsigned char* ws = P.ws; ln_phase((const float*)(ws + OFF_K), P.ln_g + 2048, P.ln_b + 2048, P.out, nullptr, 0); }
}

extern "C" void kernel_launch(void* const* d_in, const int* in_sizes, int n_in, void* d_out, int out_size, void* d_ws, size_t ws_size, hipStream_t stream) {
    static int grid_blocks = 0;
    if (grid_blocks == 0) {
        if (n_in != 22 || out_size != M * DM || ws_size < WS_END) { fprintf(stderr, "kernel_launch: unexpected shapes (n_in %d out %d ws %zu need %zu)\n", n_in, out_size, ws_size, (size_t)WS_END); grid_blocks = -1; return; }
        int dev = 0, cus = 0, per_cu = 0;
        hipGetDevice(&dev); hipDeviceGetAttribute(&cus, hipDeviceAttributeMultiprocessorCount, dev);
        if (hipFuncSetAttribute((const void*)mega_fwd, hipFuncAttributeMaxDynamicSharedMemorySize, LDS_BYTES) != hipSuccess) { fprintf(stderr, "kernel_launch: hipFuncSetAttribute failed\n"); grid_blocks = -1; return; }
        if (hipOccupancyMaxActiveBlocksPerMultiprocessor(&per_cu, (const void*)mega_fwd, 512, LDS_BYTES) != hipSuccess || per_cu < 1) { fprintf(stderr, "kernel_launch: occupancy query failed (%d)\n", per_cu); (void)hipGetLastError(); per_cu = 1; }
        grid_blocks = cus * 1;
        if (grid_blocks > 256) grid_blocks = 256;
    }
    if (grid_blocks < 0) return;
    Params p{};
    const float** pp = (const float**)&p;
    for (int i = 0; i < 22; ++i) pp[i] = (const float*)d_in[i];
    p.out = (float*)d_out; p.ws = (unsigned char*)d_ws;
    void* args[] = {&p};
    hipError_t e = hipLaunchCooperativeKernel((const void*)mega_fwd, dim3(grid_blocks), dim3(512), args, LDS_BYTES, stream);
    if (e != hipSuccess) fprintf(stderr, "cooperative launch failed: %s (grid %d)\n", hipGetErrorString(e), grid_blocks);
}
```

```cpp
#include <hip/hip_runtime.h>
#include <hip/hip_cooperative_groups.h>
#include <cstdio>
#include <cstdint>
namespace cg = cooperative_groups;
namespace pg8 {
#define PG8_LAS __attribute__((address_space(3)))
typedef unsigned short bf16_t;
typedef short bf16x8 __attribute__((ext_vector_type(8)));
typedef float f32x4 __attribute__((ext_vector_type(4)));
typedef unsigned u32x4 __attribute__((ext_vector_type(4)));
constexpr int BM = 256, BK = 64, HALF = 128, HTB = HALF * BK * 2  , STAGE_BYTES = 8 * HTB, NXCD = 8, WGM = 8;

__host__ __device__ __forceinline__ int lds_byte(int r, int c) { const int st = (r >> 4) * 2 + (c >> 5), rr = r & 15, cc = c & 31, ob = rr * 64 + cc * 2; return st * 1024 + (ob ^ (((ob >> 9) & 1) << 5)); }
__host__ __device__ __forceinline__ void stage_rc(int b, int& R, int& C) { const int st = b / 1024, sb = b % 1024, swz = sb ^ (((sb >> 9) & 1) << 5); R = (st >> 1) * 16 + swz / 64; C = (st & 1) * 32 + (swz % 64) / 2; }
__host__ __device__ __forceinline__ int perm32(int rho) { const int n = rho >> 4, i = rho & 15; return 8 * (i >> 2) + 4 * n + (i & 3); }

struct Unit { int pm, pn; };
struct Gemm { const bf16_t* A; const bf16_t* Bt; int M, N, K, lda, ldb, alias_a; };

struct StaticOrder {
    int nM, nN, nwg, G, c;
    __host__ __device__ void init(int M, int N, int G_, int c_) { nM = M / BM; nN = N / BM; nwg = nM * nN; G = G_; c = c_; }
    __host__ __device__ bool next(int i, Unit& u) const {
        const long L = (long)i * G + c; if (L >= nwg) return false;
        int wgid = (int)L; { const int q = nwg / NXCD, r = nwg % NXCD, xcd = wgid % NXCD, off = wgid / NXCD; wgid = (xcd < r ? xcd * (q + 1) : r * (q + 1) + (xcd - r) * q) + off; }
        const int nig = WGM * nN, gid = wgid / nig, fm = gid * WGM, gsz = (nM - fm) < WGM ? (nM - fm) : WGM;
        u.pm = fm + ((wgid % nig) % gsz); u.pn = (wgid % nig) / gsz; return true;
    }
    __device__ __forceinline__ void a_ready(const Unit&) const {}
    __device__ __forceinline__ void done(const Unit&) const {}
};
__device__ __forceinline__ unsigned cvt_pk_bf16(float lo, float hi) { unsigned r; asm volatile("v_cvt_pk_bf16_f32 %0, %1, %2" : "=v"(r) : "v"(lo), "v"(hi)); return r; }
template <class Epi, class Sched, bool STAMP = false>
__device__ __forceinline__ void gemm_phase(PG8_LAS unsigned char* lds, const Gemm g, const Sched& S, const Epi& E, unsigned long long* stamps) {
    const int tid = threadIdx.x, wid = __builtin_amdgcn_readfirstlane(tid >> 6), lane = tid & 63, wr = wid >> 2, wc = wid & 3, fr = lane & 15, fq = lane >> 4;
    const int K = g.K, nt = K / BK;
    int ts_lo = 0, ts_hi = 0, nts = 0; const unsigned long long rt_entry = STAMP ? (unsigned long long)wall_clock64() : 0ull;
#define PG8_STAMP() do { if (STAMP && wid == 0 && nts < 64) { const unsigned long long _c = (unsigned long long)clock64(); \
        ts_lo = (lane == nts) ? (int)(unsigned)_c : ts_lo; ts_hi = (lane == nts) ? (int)(unsigned)(_c >> 32) : ts_hi; ++nts; } } while (0)
    PG8_STAMP();
    unsigned voffA[2], voffB[2];
#pragma unroll
    for (int i = 0; i < 2; ++i) { int R, C; stage_rc(tid * 16 + i * 8192, R, C); const int Rb = Epi::PERM ? ((R & ~31) + perm32(R & 31)) : R;
        voffA[i] = (unsigned)(R * g.lda + C) * 2u; voffB[i] = (unsigned)(Rb * g.ldb + C) * 2u; }
    const size_t kstep = (size_t)(BK * 2);
    const size_t hstepA = (size_t)HALF * g.lda * 2, hstepB = (size_t)HALF * g.ldb * 2;
    const size_t tstepA = g.alias_a ? (size_t)0 : 2 * hstepA, tstepB = 2 * hstepB;
    const unsigned ldsw = (unsigned)wid * 1024u;
    const int aoff = lds_byte(wr * 64 + fr, fq * 8), boff = lds_byte(wc * 32 + fr, fq * 8);
#define PG8_SA(b, h) (((b) * 2 + (h)) * HTB)
#define PG8_SB(b, h) ((4 + (b) * 2 + (h)) * HTB)
#define PG8_STAGE(bufoff, gbase, voff) do { _Pragma("unroll") for (int _i = 0; _i < 2; ++_i) \
        __builtin_amdgcn_global_load_lds((const unsigned*)((const char*)(gbase) + (voff)[_i]), (PG8_LAS unsigned*)(lds + (bufoff) + ldsw + _i * 8192), 16, 0, 0); } while (0)
#define PG8_LDA(dst, b, h) do { _Pragma("unroll") for (int m = 0; m < 4; ++m) _Pragma("unroll") for (int k = 0; k < 2; ++k) dst[m][k] = *(const PG8_LAS bf16x8*)(lds + PG8_SA(b, h) + aoff + m * 2048 + k * 1024); } while (0)
#define PG8_LDB(dst, b, h) do { _Pragma("unroll") for (int n = 0; n < 2; ++n) _Pragma("unroll") for (int k = 0; k < 2; ++k) dst[n][k] = *(const PG8_LAS bf16x8*)(lds + PG8_SB(b, h) + boff + n * 2048 + k * 1024); } while (0)
#define PG8_MMA(ai, bj, At, Bt) do { __builtin_amdgcn_s_setprio(1); _Pragma("unroll") for (int m = 0; m < 4; ++m) _Pragma("unroll") for (int n = 0; n < 2; ++n) _Pragma("unroll") for (int k = 0; k < 2; ++k) \
        acc[ai][bj][m][n] = __builtin_amdgcn_mfma_f32_16x16x32_bf16(Bt[n][k], At[m][k], acc[ai][bj][m][n], 0, 0, 0); __builtin_amdgcn_s_setprio(0); } while (0)
#define PG8_WAIT_V(n) asm volatile("s_waitcnt vmcnt(" #n ")" ::: "memory")
#define PG8_WAIT_L(n) asm volatile("s_waitcnt lgkmcnt(" #n ")" ::: "memory")
#define PG8_BAR __builtin_amdgcn_s_barrier()
#define PG8_SCHED __builtin_amdgcn_sched_barrier(0)
    Unit cur, nxt; int ui = 0;
    if (!S.next(0, cur)) return;
    f32x4 acc[2][2][4][2];
#pragma unroll
    for (int a = 0; a < 2; ++a)
#pragma unroll
        for (int b = 0; b < 2; ++b)
#pragma unroll
            for (int m = 0; m < 4; ++m)
#pragma unroll
                for (int n = 0; n < 2; ++n) acc[a][b][m][n] = (f32x4){0.f, 0.f, 0.f, 0.f};
    bf16x8 At[4][2], B0[2][2], B1[2][2];
    const char* cA = (const char*)g.A + (size_t)cur.pm * tstepA; const char* cB = (const char*)g.Bt + (size_t)cur.pn * tstepB;
    S.a_ready(cur);
    PG8_STAGE(PG8_SB(0, 0), cB, voffB); PG8_STAGE(PG8_SA(0, 0), cA, voffA); PG8_STAGE(PG8_SB(0, 1), cB + hstepB, voffB); PG8_STAGE(PG8_SA(0, 1), cA + hstepA, voffA);
    if (wr == 1) PG8_BAR;
    PG8_WAIT_V(4); PG8_BAR;
    PG8_STAGE(PG8_SB(1, 0), cB + kstep, voffB); PG8_STAGE(PG8_SA(1, 0), cA + kstep, voffA); PG8_STAGE(PG8_SB(1, 1), cB + hstepB + kstep, voffB);
    PG8_WAIT_V(6); PG8_BAR;
    PG8_STAMP();
    for (;;) {
        const bool has_next = S.next(ui + 1, nxt);
        const char* nA = has_next ? (const char*)g.A + (size_t)nxt.pm * tstepA : cA; const char* nB = has_next ? (const char*)g.Bt + (size_t)nxt.pn * tstepB : cB;
        for (int t = 0; t < nt; t += 2) {
            if constexpr (Epi::MID >= 0) { if (t == Epi::MID) E.mid(acc, cur, ui, wr, wc, fr, fq); }
            const bool last = (t == nt - 2);
            const char* a1 = cA + (size_t)(t + 1) * kstep;
            const char* a2 = last ? nA : cA + (size_t)(t + 2) * kstep; const char* b2 = last ? nB : cB + (size_t)(t + 2) * kstep;
            const char* a3 = a2 + kstep; const char* b3 = b2 + kstep;
            if (last && has_next) S.a_ready(nxt);
            PG8_LDB(B0, 0, 0); PG8_SCHED; PG8_LDA(At, 0, 0); PG8_STAGE(PG8_SA(1, 1), a1 + hstepA, voffA);
            PG8_WAIT_L(8); PG8_BAR; PG8_WAIT_L(0); PG8_MMA(0, 0, At, B0); PG8_BAR; PG8_SCHED;
            PG8_LDB(B1, 0, 1); PG8_STAGE(PG8_SB(0, 0), b2, voffB);
            PG8_BAR; PG8_WAIT_L(0); PG8_MMA(0, 1, At, B1); PG8_BAR;
            PG8_LDA(At, 0, 1); PG8_STAGE(PG8_SA(0, 0), a2, voffA);
            PG8_BAR; PG8_WAIT_L(0); PG8_MMA(1, 0, At, B0); PG8_BAR; PG8_SCHED;
            PG8_STAGE(PG8_SB(0, 1), b2 + hstepB, voffB);
            PG8_WAIT_V(6); PG8_BAR; PG8_MMA(1, 1, At, B1); PG8_BAR;
            PG8_LDB(B0, 1, 0); PG8_SCHED; PG8_LDA(At, 1, 0); PG8_STAGE(PG8_SA(0, 1), a2 + hstepA, voffA);
            PG8_WAIT_L(8); PG8_BAR; PG8_WAIT_L(0); PG8_MMA(0, 0, At, B0); PG8_BAR; PG8_SCHED;
            PG8_LDB(B1, 1, 1); PG8_STAGE(PG8_SB(1, 0), b3, voffB);
            PG8_BAR; PG8_WAIT_L(0); PG8_MMA(0, 1, At, B1); PG8_BAR;
            PG8_LDA(At, 1, 1); PG8_STAGE(PG8_SA(1, 0), a3, voffA);
            PG8_BAR; PG8_WAIT_L(0); PG8_MMA(1, 0, At, B0); PG8_BAR; PG8_SCHED;
            PG8_STAGE(PG8_SB(1, 1), b3 + hstepB, voffB);
            PG8_WAIT_V(6); PG8_BAR; PG8_MMA(1, 1, At, B1); PG8_BAR;
        }
        PG8_STAMP();
        if constexpr (!Epi::AFTER_DRAIN) { E(acc, cur, wr, wc, fr, fq); S.done(cur); }
        PG8_STAMP();
        if (!has_next) break;
#pragma unroll
        for (int a = 0; a < 2; ++a)
#pragma unroll
            for (int b = 0; b < 2; ++b)
#pragma unroll
                for (int m = 0; m < 4; ++m)
#pragma unroll
                    for (int n = 0; n < 2; ++n) acc[a][b][m][n] = (f32x4){0.f, 0.f, 0.f, 0.f};
        cur = nxt; cA = nA; cB = nB; ++ui;
    }
    PG8_WAIT_V(0);
    if (wr == 0) PG8_BAR;
    PG8_BAR;
    if constexpr (Epi::AFTER_DRAIN) { E.fused(acc, cur, wr, wc, fr, fq, lds, wid, lane); S.done(cur); }
    PG8_STAMP();
    if (STAMP && wid == 0) { stamps[lane] = lane < nts ? (((unsigned long long)(unsigned)ts_hi << 32) | (unsigned)ts_lo) : 0ull;
        if (lane == 62) stamps[62] = rt_entry; if (lane == 63) stamps[63] = (unsigned long long)wall_clock64(); }
#undef PG8_STAMP
#undef PG8_SA
#undef PG8_SB
#undef PG8_STAGE
#undef PG8_LDA
#undef PG8_LDB
#undef PG8_MMA
#undef PG8_WAIT_V
#undef PG8_WAIT_L
#undef PG8_BAR
#undef PG8_SCHED
}
}

using pg8::bf16_t; using pg8::bf16x8; using pg8::f32x4; using pg8::u32x4; using pg8::Unit;
#define LAS __attribute__((address_space(3)))
#ifndef GSYNC_WAVE_ACQ
#define GSYNC_WAVE_ACQ 0
#endif
#ifndef GEMM_SKEW_TICKS
#define GEMM_SKEW_TICKS 0
#endif
typedef short s16x4 __attribute__((ext_vector_type(4)));
typedef short v4i16_t __attribute__((ext_vector_type(4)));
typedef unsigned u32x2 __attribute__((ext_vector_type(2)));
typedef LAS unsigned char* ldsp;

constexpr int M = 16384, DM = 2048, SEQ = 4096;
constexpr int N0P = 13568;
constexpr float ALPHA = 1.41421356237309515f;
constexpr int LDS_BYTES = 131072 + 8192;

constexpr size_t OFF_XB = 0;
constexpr size_t OFF_W0T = 67108864;
constexpr size_t OFF_RB = 122683392;
constexpr size_t OFF_SIN = OFF_RB + 67108864;
constexpr size_t OFF_K = 223346688;
constexpr size_t OFF_V = 290455552;
constexpr size_t OFF_G = 357564416;
constexpr size_t OFF_WO0 = 424673280;
constexpr size_t OFF_W1 = 441450496;
constexpr size_t OFF_WG = 458227712;
constexpr size_t OFF_WO1 = 475004928;
constexpr size_t OFF_DT = 483393536;
constexpr size_t OFF_CUM = 485490688;
constexpr size_t OFF_SSQ = 487587840;
constexpr size_t OFF_KM = 490733568;
constexpr size_t OFF_CT = 490209280;
constexpr size_t OFF_STB = 490471424;
constexpr size_t WS_END = 490733568 + 1048576;
#ifdef PITCH_EXP
constexpr size_t X1B_OFF = OFF_XB, W1_OFF = WS_END; constexpr int X1B_LD = 2112, W1_LD = 2112;
#else
constexpr size_t X1B_OFF = OFF_G, W1_OFF = OFF_W1; constexpr int X1B_LD = 2048, W1_LD = 2048;
#endif

struct Params {
    const float *x, *in0_w, *conv_w, *conv_b, *dt_bias, *a_log, *ssd_d, *ssd_norm_g, *out0_w, *in1_w,
                *lam_re, *lam_im, *log_dt, *b_re, *b_im, *c_re, *c_im, *s5_d, *glu_w, *out1_w, *ln_g, *ln_b;
    float* out; unsigned char* ws;
};

__constant__ float INVF[16] = {1.000000000e+00f, 4.403665960e-01f, 1.939227432e-01f, 8.539710194e-02f, 3.760603070e-02f, 1.656043902e-02f, 7.292664610e-03f, 3.211445874e-03f,
                               1.414213562e-03f, 6.227723788e-04f, 2.742481884e-04f, 1.207697351e-04f, 5.318296098e-05f, 2.341999971e-05f, 1.031338616e-05f, 4.541670478e-06f};

#define LDS_WAIT() asm volatile("s_waitcnt lgkmcnt(0)" ::: "memory")
__device__ __forceinline__ unsigned pk2(float lo, float hi) { return pg8::cvt_pk_bf16(lo, hi); }
__device__ __forceinline__ float bf_lo(unsigned u) { return __uint_as_float(u << 16); }
__device__ __forceinline__ float bf_hi(unsigned u) { return __uint_as_float(u & 0xffff0000u); }
__device__ __forceinline__ float bf1(bf16_t h) { return __uint_as_float(((unsigned)h) << 16); }
__device__ __forceinline__ float silu_f(float v) { return v * __builtin_amdgcn_rcpf(1.f + __expf(-v)); }
__device__ __forceinline__ float sigmoid_f(float v) { return __builtin_amdgcn_rcpf(1.f + __expf(-v)); }
__device__ __forceinline__ float softplus_f(float v) { return fmaxf(v, 0.f) + log1pf(__expf(-fabsf(v))); }
__device__ __forceinline__ float gelu_tanh_f(float v) { const float u = 0.7978845608028654f * (v + 0.044715f * v * v * v); const float t = 1.f - 2.f * __builtin_amdgcn_rcpf(1.f + __expf(2.f * u)); return 0.5f * v * (1.f + t); }
__device__ __forceinline__ s16x4 vtr(const LAS unsigned char* p) { return __builtin_bit_cast(s16x4, __builtin_amdgcn_ds_read_tr16_b64_v4i16((LAS v4i16_t*)p)); }
__device__ __forceinline__ bf16x8 cat8(s16x4 lo, s16x4 hi) { return __builtin_shufflevector(lo, hi, 0, 1, 2, 3, 4, 5, 6, 7); }
__device__ __forceinline__ f32x4 mfma16(bf16x8 a, bf16x8 b, f32x4 c) { return __builtin_amdgcn_mfma_f32_16x16x32_bf16(a, b, c, 0, 0, 0); }
__device__ __forceinline__ void sincos_d(double a, float& s, float& c) {
    const double k = rint(a * 0.63661977236758134308);
    double r = fma(-k, 1.57079632679489661923, a); r = fma(-k, 6.123233995736766e-17, r);
    const double r2 = r * r;
    const double sp = r * (1.0 + r2 * (-1.0 / 6.0 + r2 * (1.0 / 120.0 + r2 * (-1.0 / 5040.0 + r2 * (1.0 / 362880.0 + r2 * (-1.0 / 39916800.0 + r2 * (1.0 / 6227020800.0)))))));
    const double cp = 1.0 + r2 * (-0.5 + r2 * (1.0 / 24.0 + r2 * (-1.0 / 720.0 + r2 * (1.0 / 40320.0 + r2 * (-1.0 / 3628800.0 + r2 * (1.0 / 479001600.0 + r2 * (-1.0 / 87178291200.0)))))));
    const int q = ((int)k) & 3;
    const double ss = (q == 0) ? sp : (q == 1) ? cp : (q == 2) ? -sp : -cp;
    const double cc = (q == 0) ? cp : (q == 1) ? -sp : (q == 2) ? -cp : sp;
    s = (float)ss; c = (float)cc;
}

struct EpiIn0 {
    static constexpr bool PERM = false, AFTER_DRAIN = false; static constexpr int MID = -1;
    bf16_t *A0, *XBCraw, *Kb, *Vb, *Gb; float *DTf, *kmean; const float *ctab, *stab, *dt_bias;
    __device__ __forceinline__ void mid(f32x4 (&)[2][2][4][2], const Unit&, int, int, int, int, int) const {}
    __device__ __forceinline__ void operator()(const f32x4 (&acc)[2][2][4][2], const Unit& u, int wr, int wc, int fr, int fq) const {
        const int pn = u.pn, rowb = u.pm * 256 + wr * 64 + fr, colw = wc * 32 + 4 * fq;
        if (pn >= 52) {
            if (pn == 52 && wc == 0) {
#pragma unroll
                for (int ai = 0; ai < 2; ++ai)
#pragma unroll
                    for (int m = 0; m < 4; ++m) { const int row = rowb + ai * 128 + m * 16;
#pragma unroll
                        for (int n = 0; n < 2; ++n) { const f32x4 v = acc[ai][0][m][n]; const f32x4 bb = *(const f32x4*)(dt_bias + 16 * n + 4 * fq); f32x4 r;
                            r[0] = softplus_f(v[0] + bb[0]); r[1] = softplus_f(v[1] + bb[1]); r[2] = softplus_f(v[2] + bb[2]); r[3] = softplus_f(v[3] + bb[3]);
                            *(f32x4*)(DTf + (size_t)row * 32 + 16 * n + 4 * fq) = r; } }
            }
            return;
        }
        bf16_t* dst; int ld; int mode;
        if (pn < 8) { dst = A0 + 256 * pn; ld = 4096; mode = 0; }
        else if (pn < 20) { dst = XBCraw + 256 * (pn - 8); ld = 3072; mode = 0; }
        else if (pn < 28) { dst = A0 + 2048 + 256 * (pn - 20); ld = 4096; mode = 1; }
        else if (pn < 36) { dst = Kb + 256 * (pn - 28); ld = 2048; mode = 2; }
        else if (pn < 44) { dst = Vb + 256 * (pn - 36); ld = 2048; mode = 0; }
        else { dst = Gb + 256 * (pn - 44); ld = 2048; mode = 3; }
        const bool rot = (mode == 1 || mode == 2) && (wc == 0);
        f32x4 cs[2][2];
#pragma unroll
        for (int bj = 0; bj < 2; ++bj)
#pragma unroll
            for (int n = 0; n < 2; ++n) cs[bj][n] = (f32x4){0.f, 0.f, 0.f, 0.f};
#pragma unroll
        for (int ai = 0; ai < 2; ++ai)
#pragma unroll
            for (int m = 0; m < 4; ++m) { const int row = rowb + ai * 128 + m * 16; f32x4 v[2][2];
#pragma unroll
                for (int bj = 0; bj < 2; ++bj)
#pragma unroll
                    for (int n = 0; n < 2; ++n) v[bj][n] = acc[ai][bj][m][n];
                if (rot) { const int pos = row & (SEQ - 1); const f32x4 cv = *(const f32x4*)(ctab + pos * 16 + 4 * fq), sv = *(const f32x4*)(stab + pos * 16 + 4 * fq);
#pragma unroll
                    for (int bj = 0; bj < 2; ++bj) { const f32x4 x1 = v[bj][0], x2 = v[bj][1]; v[bj][0] = x1 * cv - x2 * sv; v[bj][1] = x1 * sv + x2 * cv; } }
                if (mode == 2) {
#pragma unroll
                    for (int bj = 0; bj < 2; ++bj)
#pragma unroll
                        for (int n = 0; n < 2; ++n) cs[bj][n] += v[bj][n]; }
                if (mode == 3) {
#pragma unroll
                    for (int bj = 0; bj < 2; ++bj)
#pragma unroll
                        for (int n = 0; n < 2; ++n)
#pragma unroll
                            for (int j = 0; j < 4; ++j) v[bj][n][j] = silu_f(v[bj][n][j]); }
                bf16_t* rp = dst + (size_t)row * ld + colw;
#pragma unroll
                for (int bj = 0; bj < 2; ++bj)
#pragma unroll
                    for (int n = 0; n < 2; ++n) { u32x2 o; o.x = pk2(v[bj][n][0], v[bj][n][1]); o.y = pk2(v[bj][n][2], v[bj][n][3]); *(u32x2*)(rp + bj * 128 + n * 16) = o; }
            }
        if (mode == 2) {
#pragma unroll
            for (int bj = 0; bj < 2; ++bj)
#pragma unroll
                for (int n = 0; n < 2; ++n)
#pragma unroll
                    for (int j = 0; j < 4; ++j) { float s = cs[bj][n][j]; s += __shfl_xor(s, 1); s += __shfl_xor(s, 2); s += __shfl_xor(s, 4); s += __shfl_xor(s, 8); cs[bj][n][j] = s; }
            if (fr == 0) { const int b = u.pm >> 4, blk = u.pm & 15;
#pragma unroll
                for (int bj = 0; bj < 2; ++bj) { const int head = 2 * (pn - 28) + bj; float* kp = kmean + ((size_t)((b * 16 + head) * 16 + blk)) * 128 + colw;
#pragma unroll
                    for (int n = 0; n < 2; ++n) *(f32x4*)(kp + wr * 131072 + n * 16) = cs[bj][n]; } }
        }
    }
};
struct EpiIn1 {
    static constexpr bool PERM = false, AFTER_DRAIN = false; static constexpr int MID = -1;
    bf16_t *U, *SG;
    __device__ __forceinline__ void mid(f32x4 (&)[2][2][4][2], const Unit&, int, int, int, int, int) const {}
    __device__ __forceinline__ void operator()(const f32x4 (&acc)[2][2][4][2], const Unit& u, int wr, int wc, int fr, int fq) const {
        const int pn = u.pn, rowb = u.pm * 256 + wr * 64 + fr, colw = wc * 32 + 4 * fq; const bool sg = pn >= 8;
        bf16_t* dst = sg ? SG + 256 * (pn - 8) : U + 256 * pn;
#pragma unroll
        for (int ai = 0; ai < 2; ++ai)
#pragma unroll
            for (int m = 0; m < 4; ++m) { bf16_t* rp = dst + (size_t)(rowb + ai * 128 + m * 16) * 2048 + colw;
#pragma unroll
                for (int bj = 0; bj < 2; ++bj)
#pragma unroll
                    for (int n = 0; n < 2; ++n) { f32x4 v = acc[ai][bj][m][n];
                        if (sg) { v[0] = silu_f(v[0]); v[1] = silu_f(v[1]); v[2] = silu_f(v[2]); v[3] = silu_f(v[3]); }
                        u32x2 o; o.x = pk2(v[0], v[1]); o.y = pk2(v[2], v[3]); *(u32x2*)(rp + bj * 128 + n * 16) = o; } }
    }
};
struct EpiGlu {
    static constexpr bool PERM = false, AFTER_DRAIN = false; static constexpr int MID = -1;
    bf16_t* __restrict__ A1; const bf16_t* __restrict__ SG;
    __device__ __forceinline__ void mid(f32x4 (&)[2][2][4][2], const Unit&, int, int, int, int, int) const {}
    __device__ __forceinline__ void operator()(const f32x4 (&acc)[2][2][4][2], const Unit& u, int wr, int wc, int fr, int fq) const {
        const int rowb = u.pm * 256 + wr * 64 + fr, colb = u.pn * 128 + wc * 32 + 4 * fq;
        u32x2 sgv[2][4][2];
#pragma unroll
        for (int ai = 0; ai < 2; ++ai)
#pragma unroll
            for (int m = 0; m < 4; ++m)
#pragma unroll
                for (int n = 0; n < 2; ++n) sgv[ai][m][n] = *(const u32x2*)(SG + (size_t)(rowb + ai * 128 + m * 16) * 2048 + colb + n * 16);
#pragma unroll
        for (int ai = 0; ai < 2; ++ai)
#pragma unroll
            for (int m = 0; m < 4; ++m) { const size_t ro = (size_t)(rowb + ai * 128 + m * 16) * 2048 + colb;
#pragma unroll
                for (int n = 0; n < 2; ++n) { const f32x4 ga = acc[ai][0][m][n], gb = acc[ai][1][m][n]; const u32x2 s = sgv[ai][m][n];
                    const float o0 = ga[0] * sigmoid_f(gb[0]) * bf_lo(s.x), o1 = ga[1] * sigmoid_f(gb[1]) * bf_hi(s.x), o2 = ga[2] * sigmoid_f(gb[2]) * bf_lo(s.y), o3 = ga[3] * sigmoid_f(gb[3]) * bf_hi(s.y);
                    u32x2 o; o.x = pk2(o0, o1); o.y = pk2(o2, o3); *(u32x2*)(A1 + ro + n * 16) = o; } }
    }
};
template <int MIDK> struct EpiOut {
    static constexpr bool PERM = false, AFTER_DRAIN = false; static constexpr int MID = MIDK;
    const float* __restrict__ resid; float* __restrict__ Y; const LAS float* rsl;
    __device__ __forceinline__ void mid(f32x4 (&acc)[2][2][4][2], const Unit& u, int ui, int wr, int wc, int fr, int fq) const {
        const LAS float* rp = rsl + ui * 256 + wr * 64 + fr;
#pragma unroll
        for (int ai = 0; ai < 2; ++ai)
#pragma unroll
            for (int m = 0; m < 4; ++m) { const float rs = rp[ai * 128 + m * 16];
#pragma unroll
                for (int bj = 0; bj < 2; ++bj)
#pragma unroll
                    for (int n = 0; n < 2; ++n) acc[ai][bj][m][n] *= rs; }
    }
    __device__ __forceinline__ void operator()(const f32x4 (&acc)[2][2][4][2], const Unit& u, int wr, int wc, int fr, int fq) const {
        const int rowb = u.pm * 256 + wr * 64 + fr, colb = u.pn * 256 + wc * 32 + 4 * fq;
#pragma unroll
        for (int ai = 0; ai < 2; ++ai)
#pragma unroll
            for (int mp = 0; mp < 2; ++mp) { f32x4 r[2][2][2];
#pragma unroll
                for (int mm = 0; mm < 2; ++mm) { const size_t ro = (size_t)(rowb + ai * 128 + (2 * mp + mm) * 16) * 2048 + colb;
#pragma unroll
                    for (int bj = 0; bj < 2; ++bj)
#pragma unroll
                        for (int n = 0; n < 2; ++n) r[mm][bj][n] = *(const f32x4*)(resid + ro + bj * 128 + n * 16); }
#pragma unroll
                for (int mm = 0; mm < 2; ++mm) { const size_t ro = (size_t)(rowb + ai * 128 + (2 * mp + mm) * 16) * 2048 + colb;
#pragma unroll
                    for (int bj = 0; bj < 2; ++bj)
#pragma unroll
                        for (int n = 0; n < 2; ++n) *(f32x4*)(Y + ro + bj * 128 + n * 16) = r[mm][bj][n] * ALPHA + acc[ai][bj][2 * mp + mm][n]; } }
    }
};

__device__ __forceinline__ void transpose_item(const float* W, int Nsrc, int nsrc0, bf16_t* WT, int Kdim, int k0, int ndst0, const float* kscale, LAS float* scr, int lane) {
    if (nsrc0 >= 0) {
#pragma unroll 8
        for (int i = 0; i < 32; ++i) { const int kk = 2 * i + (lane >> 5); float v = W[(size_t)(k0 + kk) * Nsrc + nsrc0 + (lane & 31)]; if (kscale) v *= kscale[k0 + kk]; scr[kk * 33 + (lane & 31)] = v; }
    } else {
#pragma unroll 8
        for (int i = 0; i < 32; ++i) { const int kk = 2 * i + (lane >> 5); scr[kk * 33 + (lane & 31)] = 0.f; }
    }
    LDS_WAIT();
    const int c = lane & 7;
#pragma unroll
    for (int j = 0; j < 4; ++j) { const int n = (lane >> 3) + 8 * j; const LAS float* s = scr + (8 * c) * 33 + n;
        u32x4 o; o.x = pk2(s[0 * 33], s[1 * 33]); o.y = pk2(s[2 * 33], s[3 * 33]); o.z = pk2(s[4 * 33], s[5 * 33]); o.w = pk2(s[6 * 33], s[7 * 33]);
        *(u32x4*)(WT + (size_t)(ndst0 + n) * Kdim + k0 + 8 * c) = o; }
    LDS_WAIT();
}
__device__ __forceinline__ void p0_phase(const Params& P, ldsp lds) {
    const int tid = threadIdx.x, wave = __builtin_amdgcn_readfirstlane(tid >> 6), lane = tid & 63;
    const int gw = blockIdx.x * 8 + wave, NGW = gridDim.x * 8;
    const size_t gtid = (size_t)blockIdx.x * 512 + tid, nth = (size_t)gridDim.x * 512;
    unsigned char* ws = P.ws;
    LAS float* scr = (LAS float*)(lds + wave * 8704);
    constexpr int I0 = 32 * 424, I1 = 64 * 64, I2 = 32 * 128, I3 = 32 * 128, I4 = 32 * 64;
    for (int it = gw; it < I0 + I1 + I2 + I3 + I4; it += NGW) {
        int r = it;
        if (r < I0) { const int kb = r / 424, nb = r % 424, nd = 32 * nb; const int ns = nd < 5120 ? nd : (nd < 13312 ? nd + 32 : (nd == 13312 ? 5120 : -1));
            transpose_item(P.in0_w, 13344, ns, (bf16_t*)(ws + OFF_W0T), 2048, 64 * kb, nd, nullptr, scr, lane); continue; } r -= I0;
        if (r < I1) { const int kb = r / 64, nb = r % 64; transpose_item(P.out0_w, 2048, 32 * nb, (bf16_t*)(ws + OFF_WO0), 4096, 64 * kb, 32 * nb, kb < 32 ? P.ssd_norm_g : nullptr, scr, lane); continue; } r -= I1;
        if (r < I2) { const int kb = r / 128, nb = r % 128; transpose_item(P.in1_w, 4096, 32 * nb, (bf16_t*)(ws + W1_OFF), W1_LD, 64 * kb, 32 * nb, nullptr, scr, lane); continue; } r -= I2;
        if (r < I3) { const int kb = r / 128, nb = r % 128, nd = 32 * nb; const int ns = ((nd >> 7) & 1) * 2048 + 128 * (nd >> 8) + (nd & 127);
            transpose_item(P.glu_w, 4096, ns, (bf16_t*)(ws + OFF_WG), 2048, 64 * kb, nd, nullptr, scr, lane); continue; } r -= I3;
        { const int kb = r / 64, nb = r % 64; transpose_item(P.out1_w, 2048, 32 * nb, (bf16_t*)(ws + OFF_WO1), 2048, 64 * kb, 32 * nb, nullptr, scr, lane); }
    }
    { const f32x4* xs = (const f32x4*)P.x; u32x2* xd = (u32x2*)(ws + OFF_XB);
      for (size_t i = gtid; i < (size_t)M * DM / 4; i += nth) { const f32x4 v = xs[i]; u32x2 o; o.x = pk2(v[0], v[1]); o.y = pk2(v[2], v[3]); xd[i] = o; } }
    { float* ct = (float*)(ws + OFF_CT); float* st = (float*)(ws + OFF_STB);
      for (size_t i = gtid; i < 4096 * 16; i += nth) { const int pos = (int)(i >> 4), k = (int)(i & 15); const float ang = (float)pos * INVF[k]; float s, c; sincos_d((double)ang, s, c); ct[i] = c; st[i] = s; } }

}

__device__ __forceinline__ void conv_phase(const Params& P) {
    const int tid = threadIdx.x, wave = __builtin_amdgcn_readfirstlane(tid >> 6), lane = tid & 63;
    const size_t gtid = (size_t)blockIdx.x * 512 + tid, nth = (size_t)gridDim.x * 512;
    const bf16_t* XR = (const bf16_t*)(P.ws + OFF_RB); bf16_t* X2 = (bf16_t*)(P.ws + OFF_XB);
    for (size_t it = gtid; it < (size_t)1024 * 384; it += nth) {
        const int tb = (int)(it / 384), cc = (int)(it % 384), t0 = tb * 16, ch = cc * 8;
        float w[4][8], bb[8];
#pragma unroll
        for (int j = 0; j < 4; ++j) { const f32x4 a = *(const f32x4*)(P.conv_w + j * 3072 + ch), b = *(const f32x4*)(P.conv_w + j * 3072 + ch + 4);
            w[j][0] = a[0]; w[j][1] = a[1]; w[j][2] = a[2]; w[j][3] = a[3]; w[j][4] = b[0]; w[j][5] = b[1]; w[j][6] = b[2]; w[j][7] = b[3]; }
        { const f32x4 a = *(const f32x4*)(P.conv_b + ch), b = *(const f32x4*)(P.conv_b + ch + 4); bb[0] = a[0]; bb[1] = a[1]; bb[2] = a[2]; bb[3] = a[3]; bb[4] = b[0]; bb[5] = b[1]; bb[6] = b[2]; bb[7] = b[3]; }
        const bool first = (t0 & (SEQ - 1)) == 0;
        u32x4 raw[19];
#pragma unroll
        for (int r = 0; r < 19; ++r) { if (r < 3 && first) raw[r] = (u32x4){0u, 0u, 0u, 0u}; else raw[r] = *(const u32x4*)(XR + (size_t)(t0 - 3 + r) * 3072 + ch); }
#pragma unroll
        for (int r = 0; r < 16; ++r) { float o[8];
#pragma unroll
            for (int e = 0; e < 8; ++e) o[e] = bb[e];
#pragma unroll
            for (int j = 0; j < 4; ++j) { const u32x4 q = raw[r + j];
                o[0] += w[j][0] * bf_lo(q.x); o[1] += w[j][1] * bf_hi(q.x); o[2] += w[j][2] * bf_lo(q.y); o[3] += w[j][3] * bf_hi(q.y);
                o[4] += w[j][4] * bf_lo(q.z); o[5] += w[j][5] * bf_hi(q.z); o[6] += w[j][6] * bf_lo(q.w); o[7] += w[j][7] * bf_hi(q.w); }
#pragma unroll
            for (int e = 0; e < 8; ++e) o[e] = silu_f(o[e]);
            u32x4 ov; ov.x = pk2(o[0], o[1]); ov.y = pk2(o[2], o[3]); ov.z = pk2(o[4], o[5]); ov.w = pk2(o[6], o[7]);
            *(u32x4*)(X2 + (size_t)(t0 + r) * 3072 + ch) = ov; }
    }
    const float* DTf = (const float*)(P.ws + OFF_DT); float* CUM = (float*)(P.ws + OFF_CUM);
    for (int it = blockIdx.x * 8 + wave; it < 2048; it += gridDim.x * 8) {
        const int b = it >> 9, c = (it >> 5) & 15, h = it & 31; const size_t rowbase = (size_t)b * 4096 + c * 256 + 4 * lane;
        const float Ah = -__expf(P.a_log[h]);
        const float a0 = DTf[(rowbase + 0) * 32 + h] * Ah, a1 = DTf[(rowbase + 1) * 32 + h] * Ah, a2 = DTf[(rowbase + 2) * 32 + h] * Ah, a3 = DTf[(rowbase + 3) * 32 + h] * Ah;
        const float s0 = a0, s1 = s0 + a1, s2 = s1 + a2, s3 = s2 + a3;
        float x = s3;
#pragma unroll
        for (int o = 1; o < 64; o <<= 1) { const float t = __shfl_up(x, o); if (lane >= o) x += t; }
        const float off = x - s3;
        CUM[(rowbase + 0) * 32 + h] = off + s0; CUM[(rowbase + 1) * 32 + h] = off + s1; CUM[(rowbase + 2) * 32 + h] = off + s2; CUM[(rowbase + 3) * 32 + h] = off + s3;
    }
}

__device__ __forceinline__ void ssd_a_phase(const Params& P, ldsp lds) {
    const int tid = threadIdx.x, wave = __builtin_amdgcn_readfirstlane(tid >> 6), lane = tid & 63, quad = lane >> 4, li = lane & 15, qq = li >> 2, pp = li & 3;
    const bf16_t* X2 = (const bf16_t*)(P.ws + OFF_XB); const float* DTf = (const float*)(P.ws + OFF_DT); const float* CUM = (const float*)(P.ws + OFF_CUM); float* ST = (float*)(P.ws + OFF_RB);
    ldsp Bl = lds, Xl = lds + 69632;
    for (int item = blockIdx.x; item < 256; item += gridDim.x) {
        const int b = item >> 6, c = (item >> 2) & 15, g = item & 3; const size_t rowbase = (size_t)b * 4096 + c * 256;
        __syncthreads();
#pragma unroll
        for (int k = 0; k < 8; ++k) { const int idx = tid + 512 * k, r = idx >> 4, ch = idx & 15; *(LAS u32x4*)(Bl + r * 272 + ch * 16) = *(const u32x4*)(X2 + (rowbase + r) * 3072 + 2048 + g * 128 + ch * 8); }
        for (int hh = 0; hh < 8; ++hh) { const int h = g * 8 + hh;
            __syncthreads();
            const float cl = CUM[(rowbase + 255) * 32 + h];
#pragma unroll
            for (int k = 0; k < 4; ++k) { const int idx = tid + 512 * k, r = idx >> 3, ch = idx & 7; const size_t row = rowbase + r;
                const float w = __expf(cl - CUM[row * 32 + h]) * DTf[row * 32 + h]; const u32x4 v = *(const u32x4*)(X2 + row * 3072 + h * 64 + ch * 8); u32x4 o;
                o.x = pk2(bf_lo(v.x) * w, bf_hi(v.x) * w); o.y = pk2(bf_lo(v.y) * w, bf_hi(v.y) * w); o.z = pk2(bf_lo(v.z) * w, bf_hi(v.z) * w); o.w = pk2(bf_lo(v.w) * w, bf_hi(v.w) * w);
                *(LAS u32x4*)(Xl + r * 160 + ch * 16) = o; }
            __syncthreads();
            f32x4 acc[4];
#pragma unroll
            for (int pt = 0; pt < 4; ++pt) acc[pt] = (f32x4){0.f, 0.f, 0.f, 0.f};
#pragma unroll
            for (int ks = 0; ks < 8; ++ks) { const int l0 = 32 * ks + 8 * quad + qq;
                const bf16x8 bop = cat8(vtr(Bl + l0 * 272 + (16 * wave + 4 * pp) * 2), vtr(Bl + (l0 + 4) * 272 + (16 * wave + 4 * pp) * 2));
#pragma unroll
                for (int pt = 0; pt < 4; ++pt) { const bf16x8 aop = cat8(vtr(Xl + l0 * 160 + (16 * pt + 4 * pp) * 2), vtr(Xl + (l0 + 4) * 160 + (16 * pt + 4 * pp) * 2)); acc[pt] = mfma16(aop, bop, acc[pt]); } }
            float* sp = ST + ((size_t)((b * 16 + c) * 32 + h) * 64) * 128 + 16 * wave + li;
#pragma unroll
            for (int pt = 0; pt < 4; ++pt)
#pragma unroll
                for (int j = 0; j < 4; ++j) sp[(size_t)(16 * pt + 4 * quad + j) * 128] = acc[pt][j];
        }
    }
}
__device__ __forceinline__ void ssd_b_phase(const Params& P) {
    const size_t gtid = (size_t)blockIdx.x * 512 + threadIdx.x, nth = (size_t)gridDim.x * 512;
    const float* ST = (const float*)(P.ws + OFF_RB); bf16_t* SIN = (bf16_t*)(P.ws + OFF_SIN); const float* CUM = (const float*)(P.ws + OFF_CUM);
    for (size_t it = gtid; it < (size_t)4 * 32 * 64 * 32; it += nth) {
        const int n4 = (int)(it & 31), p = (int)((it >> 5) & 63), h = (int)((it >> 11) & 31), b = (int)(it >> 16);
        f32x4 cur = (f32x4){0.f, 0.f, 0.f, 0.f};
#pragma unroll 4
        for (int c = 0; c < 16; ++c) { const size_t base = ((size_t)((b * 16 + c) * 32 + h) * 64 + p) * 128 + 4 * n4;
            u32x2 o; o.x = pk2(cur[0], cur[1]); o.y = pk2(cur[2], cur[3]); *(u32x2*)(SIN + base) = o;
            const float dec = __expf(CUM[((size_t)b * 4096 + c * 256 + 255) * 32 + h]); const f32x4 st = *(const f32x4*)(ST + base); cur = cur * dec + st; }
    }
}
__device__ __forceinline__ void ssd_c_phase(const Params& P, ldsp lds) {
    const int tid = threadIdx.x, wave = __builtin_amdgcn_readfirstlane(tid >> 6), lane = tid & 63, quad = lane >> 4, li = lane & 15, qq = li >> 2, pp = li & 3;
    const bf16_t* X2 = (const bf16_t*)(P.ws + OFF_XB); const float* DTf = (const float*)(P.ws + OFF_DT); const float* CUM = (const float*)(P.ws + OFF_CUM);
    const bf16_t* SIN = (const bf16_t*)(P.ws + OFF_SIN); float* SSQ = (float*)(P.ws + OFF_SSQ); bf16_t* A0 = (bf16_t*)P.out;
    ldsp Bl = lds, Xl = lds + 69632, Sl = lds + 110592; LAS float* cuml = (LAS float*)(lds + 128000); LAS float* dtl = cuml + 256;
    for (int item = blockIdx.x; item < 256; item += gridDim.x) {
        const int b = item >> 6, c = (item >> 2) & 15, g = item & 3; const size_t rowbase = (size_t)b * 4096 + c * 256;
        __syncthreads();
#pragma unroll
        for (int k = 0; k < 8; ++k) { const int idx = tid + 512 * k, r = idx >> 4, ch = idx & 15; *(LAS u32x4*)(Bl + r * 272 + ch * 16) = *(const u32x4*)(X2 + (rowbase + r) * 3072 + 2048 + g * 128 + ch * 8); }
        bf16x8 qf[2][4];
#pragma unroll
        for (int nt = 0; nt < 2; ++nt)
#pragma unroll
            for (int ks = 0; ks < 4; ++ks) qf[nt][ks] = *(const bf16x8*)(X2 + (rowbase + 32 * wave + 16 * nt + li) * 3072 + 2560 + g * 128 + 32 * ks + 8 * quad);
        for (int hh = 0; hh < 8; ++hh) { const int h = g * 8 + hh;
            __syncthreads();
#pragma unroll
            for (int k = 0; k < 4; ++k) { const int idx = tid + 512 * k, r = idx >> 3, ch = idx & 7; *(LAS u32x4*)(Xl + r * 160 + ch * 16) = *(const u32x4*)(X2 + (rowbase + r) * 3072 + h * 64 + ch * 8); }
#pragma unroll
            for (int k = 0; k < 2; ++k) { const int idx = tid + 512 * k, r = idx >> 4, ch = idx & 15; *(LAS u32x4*)(Sl + r * 272 + ch * 16) = *(const u32x4*)(SIN + ((size_t)((b * 16 + c) * 32 + h) * 64 + r) * 128 + ch * 8); }
            if (tid < 256) { cuml[tid] = CUM[(rowbase + tid) * 32 + h]; dtl[tid] = DTf[(rowbase + tid) * 32 + h]; }
            __syncthreads();
            f32x4 oacc[2][4];
#pragma unroll
            for (int nt = 0; nt < 2; ++nt)
#pragma unroll
                for (int pt = 0; pt < 4; ++pt) oacc[nt][pt] = (f32x4){0.f, 0.f, 0.f, 0.f};
#pragma unroll
            for (int pt = 0; pt < 4; ++pt)
#pragma unroll
                for (int ks = 0; ks < 4; ++ks) { const bf16x8 a = *(const LAS bf16x8*)(Sl + (16 * pt + li) * 272 + (32 * ks + 8 * quad) * 2);
                    oacc[0][pt] = mfma16(a, qf[0][ks], oacc[0][pt]); oacc[1][pt] = mfma16(a, qf[1][ks], oacc[1][pt]); }
            int lq[2]; float cq[2];
#pragma unroll
            for (int nt = 0; nt < 2; ++nt) { lq[nt] = 32 * wave + 16 * nt + li; cq[nt] = cuml[lq[nt]]; const float e = __expf(cq[nt]);
#pragma unroll
                for (int pt = 0; pt < 4; ++pt) oacc[nt][pt] *= e; }
            const int nkt = (32 * wave + 31) / 64 + 1;
#pragma unroll 1
            for (int kt = 0; kt < nkt; ++kt) {
                {
                    f32x4 sacc[2][4];
#pragma unroll
                    for (int nt = 0; nt < 2; ++nt)
#pragma unroll
                        for (int mt = 0; mt < 4; ++mt) sacc[nt][mt] = (f32x4){0.f, 0.f, 0.f, 0.f};
#pragma unroll
                    for (int mt = 0; mt < 4; ++mt)
#pragma unroll
                        for (int ks = 0; ks < 4; ++ks) { const bf16x8 a = *(const LAS bf16x8*)(Bl + (64 * kt + 16 * mt + li) * 272 + (32 * ks + 8 * quad) * 2);
                            sacc[0][mt] = mfma16(a, qf[0][ks], sacc[0][mt]); sacc[1][mt] = mfma16(a, qf[1][ks], sacc[1][mt]); }
#pragma unroll
                    for (int mt = 0; mt < 4; ++mt) { const int s0 = 64 * kt + 16 * mt + 4 * quad; const f32x4 cs = *(const LAS f32x4*)(cuml + s0), ds = *(const LAS f32x4*)(dtl + s0);
#pragma unroll
                        for (int nt = 0; nt < 2; ++nt)
#pragma unroll
                            for (int j = 0; j < 4; ++j) { const float v = sacc[nt][mt][j] * __expf(cq[nt] - cs[j]) * ds[j]; sacc[nt][mt][j] = (s0 + j <= lq[nt]) ? v : 0.f; } }
                    bf16x8 pb[2][2];
#pragma unroll
                    for (int nt = 0; nt < 2; ++nt)
#pragma unroll
                        for (int kk = 0; kk < 2; ++kk) { u32x4 t; t.x = pk2(sacc[nt][2 * kk][0], sacc[nt][2 * kk][1]); t.y = pk2(sacc[nt][2 * kk][2], sacc[nt][2 * kk][3]);
                            t.z = pk2(sacc[nt][2 * kk + 1][0], sacc[nt][2 * kk + 1][1]); t.w = pk2(sacc[nt][2 * kk + 1][2], sacc[nt][2 * kk + 1][3]); pb[nt][kk] = __builtin_bit_cast(bf16x8, t); }
#pragma unroll
                    for (int pt = 0; pt < 4; ++pt)
#pragma unroll
                        for (int kk = 0; kk < 2; ++kk) { const int r0 = 64 * kt + 32 * kk + 4 * quad + qq;
                            const bf16x8 a = cat8(vtr(Xl + r0 * 160 + (16 * pt + 4 * pp) * 2), vtr(Xl + (r0 + 16) * 160 + (16 * pt + 4 * pp) * 2));
                            oacc[0][pt] = mfma16(a, pb[0][kk], oacc[0][pt]); oacc[1][pt] = mfma16(a, pb[1][kk], oacc[1][pt]); }
                }
            }
            const float Dh = P.ssd_d[h];
#pragma unroll
            for (int nt = 0; nt < 2; ++nt) { const size_t row = rowbase + lq[nt]; float ss = 0.f;
#pragma unroll
                for (int pt = 0; pt < 4; ++pt) { const int col = h * 64 + 16 * pt + 4 * quad; const u32x2 xs = *(const u32x2*)(X2 + row * 3072 + col); const u32x2 z = *(const u32x2*)(A0 + row * 4096 + col);
                    const float t0 = (oacc[nt][pt][0] + Dh * bf_lo(xs.x)) * silu_f(bf_lo(z.x)), t1 = (oacc[nt][pt][1] + Dh * bf_hi(xs.x)) * silu_f(bf_hi(z.x));
                    const float t2 = (oacc[nt][pt][2] + Dh * bf_lo(xs.y)) * silu_f(bf_lo(z.y)), t3 = (oacc[nt][pt][3] + Dh * bf_hi(xs.y)) * silu_f(bf_hi(z.y));
                    ss += (t0 * t0 + t1 * t1) + (t2 * t2 + t3 * t3); u32x2 o; o.x = pk2(t0, t1); o.y = pk2(t2, t3); *(u32x2*)(A0 + row * 4096 + col) = o; }
                ss += __shfl_xor(ss, 16); ss += __shfl_xor(ss, 32);
                if (quad == 0) SSQ[row * 32 + h] = ss; }
        }
    }
}

__device__ __forceinline__ void moba_phase(const Params& P, ldsp lds, bf16_t* obase, int old_, unsigned rmask) {
    const int tid = threadIdx.x, wave = __builtin_amdgcn_readfirstlane(tid >> 6), lane = tid & 63, quad = lane >> 4, li = lane & 15, qq = li >> 2, pp = li & 3;
    bf16_t* A0 = (bf16_t*)P.out; const bf16_t* Kb = (const bf16_t*)(P.ws + OFF_K); const bf16_t* Vb = (const bf16_t*)(P.ws + OFF_V); const bf16_t* Gb = (const bf16_t*)(P.ws + OFF_G);
    const float* kmean = (const float*)(P.ws + OFF_KM);
    ldsp Kl = lds, Vl = lds + 34816; LAS float* gl = (LAS float*)(lds + 71680); LAS float* kml = (LAS float*)(lds + 89088); LAS unsigned* selm = (LAS unsigned*)(lds + 97280);
    const float c2 = 0.08838834764831845f * 1.4426950408889634f;
    const int G = gridDim.x, cb = blockIdx.x;
    const int sr = tid >> 4, sc = tid & 15;
    for (int kr = 0; kr * G < 1024; ++kr) {
        const int idx = (kr & 1) ? (kr * G + G - 1 - cb) : (kr * G + cb);
        if (idx >= 1024) continue;
        const int i = 15 - (idx >> 6), b = (idx & 63) >> 4, h = idx & 15;
        const size_t qrow0 = (size_t)b * 4096 + i * 256;
        __syncthreads();
        { const float* kq = kmean + (size_t)((b * 16 + h) * 16) * 128 + tid * 4; f32x4 v = *(const f32x4*)kq + *(const f32x4*)(kq + 131072); v *= (1.f / 256.f); *(LAS f32x4*)(kml + tid * 4) = v; }
        __syncthreads();
        { const int r = tid >> 1, hf = tid & 1; const bf16_t* qp = A0 + (qrow0 + r) * 4096 + 2048 + h * 128; float gs[8];
#pragma unroll
          for (int jb = 0; jb < 8; ++jb) gs[jb] = 0.f;
#pragma unroll 2
          for (int dc = 0; dc < 16; ++dc) { const u32x4 qv = *(const u32x4*)(qp + dc * 8);
              const float q0 = bf_lo(qv.x), q1 = bf_hi(qv.x), q2 = bf_lo(qv.y), q3 = bf_hi(qv.y), q4 = bf_lo(qv.z), q5 = bf_hi(qv.z), q6 = bf_lo(qv.w), q7 = bf_hi(qv.w);
#pragma unroll
              for (int jb = 0; jb < 8; ++jb) { const LAS float* kp = kml + (hf * 8 + jb) * 128 + dc * 8; const f32x4 k0 = *(const LAS f32x4*)kp, k1 = *(const LAS f32x4*)(kp + 4);
                  gs[jb] += (q0 * k0[0] + q1 * k0[1]) + (q2 * k0[2] + q3 * k0[3]) + (q4 * k1[0] + q5 * k1[1]) + (q6 * k1[2] + q7 * k1[3]); } }
#pragma unroll
          for (int jb = 0; jb < 8; ++jb) gl[r * 17 + hf * 8 + jb] = gs[jb]; }
        __syncthreads();
        if (tid < 256) { unsigned mask = 0u; const int nsel = i < 3 ? i : 3;
            for (int s = 0; s < nsel; ++s) { float best = -INFINITY; int bj = -1;
                for (int j = 0; j < i; ++j) { const float v = gl[tid * 17 + j]; if (!((mask >> j) & 1u) && v > best) { best = v; bj = j; } }
                if (bj >= 0) mask |= 1u << bj; }
            selm[tid] = mask; }
        bf16x8 qf[2][4];
#pragma unroll
        for (int nt = 0; nt < 2; ++nt)
#pragma unroll
            for (int ks = 0; ks < 4; ++ks) qf[nt][ks] = *(const bf16x8*)(A0 + (qrow0 + 32 * wave + 16 * nt + li) * 4096 + 2048 + h * 128 + 32 * ks + 8 * quad);
        const int ntile = 4 * (i + 1);
        u32x4 kreg[2], vreg[2];
        { const size_t kr0 = (qrow0 + sr) * 2048 + h * 128 + sc * 8;
          kreg[0] = *(const u32x4*)(Kb + kr0); kreg[1] = *(const u32x4*)(Kb + kr0 + 32 * 2048); vreg[0] = *(const u32x4*)(Vb + kr0); vreg[1] = *(const u32x4*)(Vb + kr0 + 32 * 2048); }
        *(LAS u32x4*)(Kl + sr * 272 + sc * 16) = kreg[0]; *(LAS u32x4*)(Kl + (sr + 32) * 272 + sc * 16) = kreg[1];
        *(LAS u32x4*)(Vl + sr * 288 + sc * 16) = vreg[0]; *(LAS u32x4*)(Vl + (sr + 32) * 288 + sc * 16) = vreg[1];
        __syncthreads();
        unsigned sel[2]; float mrun[2], lrun[2]; f32x4 oacc[2][8];
#pragma unroll
        for (int nt = 0; nt < 2; ++nt) { sel[nt] = selm[32 * wave + 16 * nt + li]; mrun[nt] = -1e30f; lrun[nt] = 0.f;
#pragma unroll
            for (int dt = 0; dt < 8; ++dt) oacc[nt][dt] = (f32x4){0.f, 0.f, 0.f, 0.f}; }
        for (int tt = 0; tt < ntile; ++tt) {
            const int buf = tt & 1;
            u32x4 kn0, kn1, vn0, vn1;
            { const int t1 = (tt + 1 < ntile) ? tt + 1 : tt; const int jb = (t1 < 4) ? i : (t1 >> 2) - 1; const int kt1 = t1 & 3;
                const size_t kr0 = ((size_t)b * 4096 + jb * 256 + kt1 * 64 + sr) * 2048 + h * 128 + sc * 8;
                kn0 = *(const u32x4*)(Kb + kr0); kn1 = *(const u32x4*)(Kb + kr0 + 32 * 2048); vn0 = *(const u32x4*)(Vb + kr0); vn1 = *(const u32x4*)(Vb + kr0 + 32 * 2048); }
            const bool own = tt < 4; const int kt = tt & 3; const int jblk = own ? i : (tt >> 2) - 1;
            bool active;
            if (own) active = (64 * kt <= 32 * wave + 31); else active = __any((int)(((sel[0] | sel[1]) >> jblk) & 1u)) != 0;
            if (active) {
                ldsp Kt = Kl + buf * 17408; ldsp Vt = Vl + buf * 18432;
                f32x4 sacc[2][4];
#pragma unroll
                for (int nt = 0; nt < 2; ++nt)
#pragma unroll
                    for (int mt = 0; mt < 4; ++mt) sacc[nt][mt] = (f32x4){0.f, 0.f, 0.f, 0.f};
                { bf16x8 kf[2][4];
#pragma unroll
                  for (int ks = 0; ks < 4; ++ks) kf[0][ks] = *(const LAS bf16x8*)(Kt + li * 272 + (32 * ks + 8 * quad) * 2);
#pragma unroll
                  for (int mt = 0; mt < 4; ++mt) {
                      if (mt < 3) {
#pragma unroll
                          for (int ks = 0; ks < 4; ++ks) kf[(mt + 1) & 1][ks] = *(const LAS bf16x8*)(Kt + (16 * (mt + 1) + li) * 272 + (32 * ks + 8 * quad) * 2); }
                      __builtin_amdgcn_sched_barrier(0);
#pragma unroll
                      for (int ks = 0; ks < 4; ++ks) { sacc[0][mt] = mfma16(kf[mt & 1][ks], qf[0][ks], sacc[0][mt]); sacc[1][mt] = mfma16(kf[mt & 1][ks], qf[1][ks], sacc[1][mt]); }
                      __builtin_amdgcn_sched_barrier(0);
                  } }
                bf16x8 pb[2][2];
#pragma unroll
                for (int nt = 0; nt < 2; ++nt) { const int qpos = 32 * wave + 16 * nt + li; const bool selj = ((sel[nt] >> jblk) & 1u) != 0u; float alpha, ps = 0.f;
                    if (own) {
                        float mx = -1e30f;
#pragma unroll
                        for (int mt = 0; mt < 4; ++mt)
#pragma unroll
                            for (int j = 0; j < 4; ++j) { const int kpos = 64 * kt + 16 * mt + 4 * quad + j;
                                const float s = (kpos <= qpos) ? sacc[nt][mt][j] * c2 : -1e30f; sacc[nt][mt][j] = s; mx = fmaxf(mx, s); }
                        mx = fmaxf(mx, __shfl_xor(mx, 16)); mx = fmaxf(mx, __shfl_xor(mx, 32));
                        const float mnew = fmaxf(mrun[nt], mx); alpha = __builtin_amdgcn_exp2f(mrun[nt] - mnew); mrun[nt] = mnew;
#pragma unroll
                        for (int mt = 0; mt < 4; ++mt)
#pragma unroll
                            for (int j = 0; j < 4; ++j) { const float p = __builtin_amdgcn_exp2f(sacc[nt][mt][j] - mnew); sacc[nt][mt][j] = p; ps += p; }
                    } else {
                        const float bias = selj ? 0.f : -1e30f; float mx = sacc[nt][0][0];
#pragma unroll
                        for (int mt = 0; mt < 4; ++mt)
#pragma unroll
                            for (int j = 0; j < 4; ++j) mx = fmaxf(mx, sacc[nt][mt][j]);
                        mx = fmaxf(mx, __shfl_xor(mx, 16)); mx = fmaxf(mx, __shfl_xor(mx, 32));
                        const float mnew = fmaxf(mrun[nt], fmaf(mx, c2, bias)); alpha = __builtin_amdgcn_exp2f(mrun[nt] - mnew); mrun[nt] = mnew; const float nb = bias - mnew;
#pragma unroll
                        for (int mt = 0; mt < 4; ++mt)
#pragma unroll
                            for (int j = 0; j < 4; ++j) { const float p = __builtin_amdgcn_exp2f(fmaf(sacc[nt][mt][j], c2, nb)); sacc[nt][mt][j] = p; ps += p; }
                    }
                    lrun[nt] = lrun[nt] * alpha + ps;
#pragma unroll
                    for (int dt = 0; dt < 8; ++dt) oacc[nt][dt] *= alpha;
#pragma unroll
                    for (int kk = 0; kk < 2; ++kk) { u32x4 t; t.x = pk2(sacc[nt][2 * kk][0], sacc[nt][2 * kk][1]); t.y = pk2(sacc[nt][2 * kk][2], sacc[nt][2 * kk][3]);
                        t.z = pk2(sacc[nt][2 * kk + 1][0], sacc[nt][2 * kk + 1][1]); t.w = pk2(sacc[nt][2 * kk + 1][2], sacc[nt][2 * kk + 1][3]); pb[nt][kk] = __builtin_bit_cast(bf16x8, t); }
                }
                { bf16x8 vf[2][2]; const ldsp vbase = Vt + (4 * quad + qq) * 288 + 8 * pp;
#pragma unroll
                  for (int kk = 0; kk < 2; ++kk) vf[0][kk] = cat8(vtr(vbase + (32 * kk) * 288), vtr(vbase + (32 * kk + 16) * 288));
#pragma unroll
                  for (int dt = 0; dt < 8; ++dt) {
                      if (dt < 7) {
#pragma unroll
                          for (int kk = 0; kk < 2; ++kk) vf[(dt + 1) & 1][kk] = cat8(vtr(vbase + (32 * kk) * 288 + 32 * (dt + 1)), vtr(vbase + (32 * kk + 16) * 288 + 32 * (dt + 1))); }
                      __builtin_amdgcn_sched_barrier(0);
#pragma unroll
                      for (int kk = 0; kk < 2; ++kk) { oacc[0][dt] = mfma16(vf[dt & 1][kk], pb[0][kk], oacc[0][dt]); oacc[1][dt] = mfma16(vf[dt & 1][kk], pb[1][kk], oacc[1][dt]); }
                      __builtin_amdgcn_sched_barrier(0);
                  } }
            }
            { ldsp Kn = Kl + (buf ^ 1) * 17408; ldsp Vn = Vl + (buf ^ 1) * 18432;
                *(LAS u32x4*)(Kn + sr * 272 + sc * 16) = kn0; *(LAS u32x4*)(Kn + (sr + 32) * 272 + sc * 16) = kn1;
                *(LAS u32x4*)(Vn + sr * 288 + sc * 16) = vn0; *(LAS u32x4*)(Vn + (sr + 32) * 288 + sc * 16) = vn1; }
            __syncthreads();
        }
#pragma unroll
        for (int nt = 0; nt < 2; ++nt) { float l = lrun[nt]; l += __shfl_xor(l, 16); l += __shfl_xor(l, 32); const float inv = 1.f / l; const size_t row = qrow0 + 32 * wave + 16 * nt + li;
#pragma unroll
            for (int dt = 0; dt < 8; ++dt) { const int col = h * 128 + 16 * dt + 4 * quad; const u32x2 gv = *(const u32x2*)(Gb + row * 2048 + col);
                u32x2 o; o.x = pk2(oacc[nt][dt][0] * inv * bf_lo(gv.x), oacc[nt][dt][1] * inv * bf_hi(gv.x)); o.y = pk2(oacc[nt][dt][2] * inv * bf_lo(gv.y), oacc[nt][dt][3] * inv * bf_hi(gv.y));
                *(u32x2*)(obase + (size_t)((unsigned)row & rmask) * old_ + col) = o; } }
    }
}

__device__ __forceinline__ void ln_phase(const float* Y, const float* g, const float* bta, float* outf, bf16_t* outb, int ldb_) {
    const int lane = threadIdx.x & 63; const int gw = blockIdx.x * 8 + __builtin_amdgcn_readfirstlane(threadIdx.x >> 6), NGW = gridDim.x * 8;
    f32x4 gv[8], bv[8];
#pragma unroll
    for (int k = 0; k < 8; ++k) { gv[k] = ((const f32x4*)g)[lane + 64 * k]; bv[k] = ((const f32x4*)bta)[lane + 64 * k]; }
    for (int row = gw; row < M; row += NGW) { const f32x4* yr = (const f32x4*)(Y + (size_t)row * 2048); f32x4 v[8]; float s = 0.f;
#pragma unroll
        for (int k = 0; k < 8; ++k) { v[k] = yr[lane + 64 * k]; s += (v[k][0] + v[k][1]) + (v[k][2] + v[k][3]); }
#pragma unroll
        for (int o = 1; o < 64; o <<= 1) s += __shfl_xor(s, o);
        const float mu = s * (1.f / 2048.f); float s2 = 0.f;
#pragma unroll
        for (int k = 0; k < 8; ++k) { v[k] = v[k] - mu; s2 += (v[k][0] * v[k][0] + v[k][1] * v[k][1]) + (v[k][2] * v[k][2] + v[k][3] * v[k][3]); }
#pragma unroll
        for (int o = 1; o < 64; o <<= 1) s2 += __shfl_xor(s2, o);
        const float rstd = rsqrtf(s2 * (1.f / 2048.f) + 1e-5f);
#pragma unroll
        for (int k = 0; k < 8; ++k) { const f32x4 o = v[k] * rstd * gv[k] + bv[k]; ((f32x4*)(outf + (size_t)row * 2048))[lane + 64 * k] = o;
            if (outb) { u32x2 ob; ob.x = pk2(o[0], o[1]); ob.y = pk2(o[2], o[3]); ((u32x2*)(outb + (size_t)row * ldb_))[lane + 64 * k] = ob; } }
    }
}

__device__ __forceinline__ void s5_phase(const Params& P, ldsp lds) {
    const int tid = threadIdx.x, wave = __builtin_amdgcn_readfirstlane(tid >> 6), lane = tid & 63, quad = lane >> 4, li = lane & 15, qq = li >> 2, pp = li & 3;
    const bf16_t* U = (const bf16_t*)(P.ws + OFF_K); bf16_t* YG = (bf16_t*)(P.ws + OFF_RB);
    const int sq = wave >> 2, role = (wave + 2 * sq) & 3;
    ldsp BUl = lds + sq * 32768; ldsp Hl = lds + sq * 32768 + 20480; ldsp Rl = lds + 65536 + sq * 8192;
    for (int it0 = blockIdx.x; it0 < 256; it0 += gridDim.x) {
        const int item = it0 + 256 * sq;
        const int b = item >> 7, g = item & 127;
        const float dtg = expf(P.log_dt[g]);
        float lbr, lbi;
        { const float lr = P.lam_re[g * 64 + lane], lim = P.lam_im[g * 64 + lane]; const float e = expf(lr * dtg); float s, c; sincos_d((double)(lim * dtg), s, c); lbr = e * c; lbi = e * s; }
        bf16x8 bbf[8], cmf[4];
#pragma unroll
        for (int tile = 0; tile < 8; ++tile) { const int n = (16 * tile + li) & 63; const bool isim = tile >= 4;
            const float lr = P.lam_re[g * 64 + n], lim = P.lam_im[g * 64 + n]; const float e = expf(lr * dtg); float s, c; sincos_d((double)(lim * dtg), s, c);
            const float ar = e * c - 1.f, aim = e * s; const float den = 1.f / (lr * lr + lim * lim); const float cr = (ar * lr + aim * lim) * den, ci = (aim * lr - ar * lim) * den;
            u32x4 t = (u32x4){0u, 0u, 0u, 0u};
            if (quad < 2) { const float* br = P.b_re + ((size_t)(g * 64 + n)) * 16 + 8 * quad; const float* bi = P.b_im + ((size_t)(g * 64 + n)) * 16 + 8 * quad; float o[8];
#pragma unroll
                for (int e2 = 0; e2 < 8; ++e2) { const float xr = br[e2], xi = bi[e2]; o[e2] = isim ? (cr * xi + ci * xr) : (cr * xr - ci * xi); }
                t.x = pk2(o[0], o[1]); t.y = pk2(o[2], o[3]); t.z = pk2(o[4], o[5]); t.w = pk2(o[6], o[7]); }
            bbf[tile] = __builtin_bit_cast(bf16x8, t); }
#pragma unroll
        for (int ks = 0; ks < 4; ++ks) { const float* cp = (ks < 2 ? P.c_re : P.c_im) + ((size_t)(g * 16 + li)) * 64 + 32 * (ks & 1) + 8 * quad; const float sg = ks < 2 ? 1.f : -1.f;
            u32x4 t; t.x = pk2(sg * cp[0], sg * cp[1]); t.y = pk2(sg * cp[2], sg * cp[3]); t.z = pk2(sg * cp[4], sg * cp[5]); t.w = pk2(sg * cp[6], sg * cp[7]); cmf[ks] = __builtin_bit_cast(bf16x8, t); }
        const f32x4 dsk = *(const f32x4*)(P.s5_d + g * 16 + 4 * quad);
        const bf16_t* ub = U + ((size_t)b * 4096) * 2048 + g * 16;
        bf16_t* yb = YG + ((size_t)b * 4096) * 2048 + g * 16;
        float hr = 0.f, hi = 0.f;
#define S5_BAR() do { asm volatile("s_waitcnt lgkmcnt(0)" ::: "memory"); __builtin_amdgcn_s_barrier(); asm volatile("" ::: "memory"); } while (0)
#define S5_DMA(st) __builtin_amdgcn_global_load_lds((const unsigned*)(ub + (size_t)((st) * 16 + li) * 2048 + 8 * (quad & 1)), (LAS unsigned*)(Rl + ((st) & 7) * 1024), 16, 0, 0)
        if (role == 3) {
            S5_DMA(0); S5_DMA(1); S5_DMA(2); S5_DMA(3);
            asm volatile("s_waitcnt vmcnt(0)" ::: "memory"); S5_BAR();
            for (int s = -1; s <= 256; ++s) { if (s + 5 < 256) S5_DMA(s + 5); asm volatile("s_waitcnt vmcnt(2)" ::: "memory"); S5_BAR(); }
        } else if (role == 0) {
            S5_BAR();
            for (int s = -1; s <= 256; ++s) {
                if (s + 1 < 256) { u32x4 areg = *(const LAS u32x4*)(Rl + ((s + 1) & 7) * 1024 + lane * 16); if (quad >= 2) areg = (u32x4){0u, 0u, 0u, 0u};
                    const bf16x8 a_ = __builtin_bit_cast(bf16x8, areg); ldsp bw_ = BUl + ((s + 1) & 1) * 10240;
#pragma unroll
                    for (int tile = 0; tile < 8; ++tile) { const f32x4 bu = mfma16(a_, bbf[tile], (f32x4){0.f, 0.f, 0.f, 0.f}); *(LAS f32x4*)(bw_ + (16 * tile + li) * 80 + 16 * quad) = bu; } }
                S5_BAR(); }
        } else if (role == 1) {
            S5_BAR();
            for (int s = -1; s <= 256; ++s) {
                if (s >= 0 && s < 256) { f32x4 br[4], bi[4]; ldsp br_ = BUl + (s & 1) * 10240;
#pragma unroll
                    for (int q = 0; q < 4; ++q) { br[q] = *(const LAS f32x4*)(br_ + lane * 80 + 16 * q); bi[q] = *(const LAS f32x4*)(br_ + (64 + lane) * 80 + 16 * q); }
                    float hrs[16], his[16];
#pragma unroll
                    for (int t = 0; t < 16; ++t) { const float nr = lbr * hr - lbi * hi + br[t >> 2][t & 3], ni = lbr * hi + lbi * hr + bi[t >> 2][t & 3]; hr = nr; hi = ni; hrs[t] = hr; his[t] = hi; }
                    ldsp hw_ = Hl + (s & 1) * 6144;
#pragma unroll
                    for (int q = 0; q < 2; ++q) { u32x4 wr_, wi_;
                        wr_.x = pk2(hrs[8 * q + 0], hrs[8 * q + 1]); wr_.y = pk2(hrs[8 * q + 2], hrs[8 * q + 3]); wr_.z = pk2(hrs[8 * q + 4], hrs[8 * q + 5]); wr_.w = pk2(hrs[8 * q + 6], hrs[8 * q + 7]);
                        wi_.x = pk2(his[8 * q + 0], his[8 * q + 1]); wi_.y = pk2(his[8 * q + 2], his[8 * q + 3]); wi_.z = pk2(his[8 * q + 4], his[8 * q + 5]); wi_.w = pk2(his[8 * q + 6], his[8 * q + 7]);
                        *(LAS u32x4*)(hw_ + lane * 48 + 16 * q) = wr_; *(LAS u32x4*)(hw_ + (64 + lane) * 48 + 16 * q) = wi_; } }
                S5_BAR(); }
        } else {
            S5_BAR();
            for (int s = -1; s <= 256; ++s) {
                if (s >= 1) { const u32x2 uu = *(const LAS u32x2*)(Rl + ((s - 1) & 7) * 1024 + (li + 16 * (quad >> 1)) * 16 + 8 * (quad & 1));
                    ldsp hp_ = Hl + ((s - 1) & 1) * 6144; f32x4 yacc = (f32x4){0.f, 0.f, 0.f, 0.f};
#pragma unroll
                    for (int ks = 0; ks < 4; ++ks) { const int r0 = 32 * ks + 8 * quad + qq; const bf16x8 bop = cat8(vtr(hp_ + r0 * 48 + 8 * pp), vtr(hp_ + (r0 + 4) * 48 + 8 * pp)); yacc = mfma16(cmf[ks], bop, yacc); }
                    const float y0 = yacc[0] + dsk[0] * bf_lo(uu.x), y1 = yacc[1] + dsk[1] * bf_hi(uu.x), y2 = yacc[2] + dsk[2] * bf_lo(uu.y), y3 = yacc[3] + dsk[3] * bf_hi(uu.y);
                    u32x2 o; o.x = pk2(gelu_tanh_f(y0), gelu_tanh_f(y1)); o.y = pk2(gelu_tanh_f(y2), gelu_tanh_f(y3)); *(u32x2*)(yb + (size_t)((s - 1) * 16 + li) * 2048 + 4 * quad) = o; }
                S5_BAR(); }
        }
#undef S5_BAR
#undef S5_DMA
        asm volatile("s_waitcnt vmcnt(0) lgkmcnt(0)" ::: "memory"); __syncthreads();
    }
}

template <class Epi> __device__ __forceinline__ void run_gemm(ldsp lds, const bf16_t* A, int lda, const bf16_t* Bt, int ldb, int N, int K, const Epi& E) {
    pg8::Gemm g; g.A = A; g.Bt = Bt; g.M = M; g.N = N; g.K = K; g.lda = lda; g.ldb = ldb; g.alias_a = 0;
    pg8::StaticOrder S; S.init(M, N, (int)gridDim.x, (int)blockIdx.x);
#if GEMM_SKEW_TICKS > 0
    {
      const unsigned sk = (unsigned)GEMM_SKEW_TICKS * (((blockIdx.x >> 3) & 7u) + ((blockIdx.x >> 6) & 3u));
      if (threadIdx.x == 0) { const unsigned long long t0 = __builtin_amdgcn_s_memrealtime(); while (__builtin_amdgcn_s_memrealtime() - t0 < sk) __builtin_amdgcn_s_sleep(8); }
      __syncthreads(); }
#endif
    pg8::gemm_phase<Epi, pg8::StaticOrder, false>(lds, g, S, E, nullptr);
}

__device__ __forceinline__ void gsync(cg::grid_group& grid) {
    asm volatile("s_waitcnt vmcnt(0) lgkmcnt(0)" ::: "memory");
    __syncthreads();
    if (threadIdx.x < 64) { __builtin_amdgcn_fence(__ATOMIC_RELEASE, "agent"); asm volatile("s_waitcnt vmcnt(0)" ::: "memory"); }
    grid.sync();
#if GSYNC_WAVE_ACQ
    __builtin_amdgcn_fence(__ATOMIC_ACQUIRE, ""); asm volatile("s_waitcnt vmcnt(0)" ::: "memory");
#else
    if (threadIdx.x < 64) { __builtin_amdgcn_fence(__ATOMIC_ACQUIRE, "agent"); asm volatile("s_waitcnt vmcnt(0)" ::: "memory"); }
#endif
    __syncthreads();
}
#ifndef REP_P0
#define REP_P0 1
#endif
#ifndef REP_IN0
#define REP_IN0 1
#endif
#ifndef REP_CONV
#define REP_CONV 1
#endif
#ifndef REP_MOBA_DUMMY
#define REP_MOBA_DUMMY 0
#endif
#ifndef REP_SSDA
#define REP_SSDA 1
#endif
#ifndef REP_SSDB
#define REP_SSDB 1
#endif
#ifndef REP_LN0
#define REP_LN0 1
#endif
#ifndef REP_IN1
#define REP_IN1 1
#endif
#ifndef REP_S5
#define REP_S5 1
#endif
#ifndef PHASE_MASK
#define PHASE_MASK 0x3fff
#endif
#if defined(__HIP_DEVICE_COMPILE__)
#define GETP() ({ const __attribute__((address_space(4))) Params* kp_ = (const __attribute__((address_space(4))) Params*)__builtin_amdgcn_kernarg_segment_ptr(); asm volatile("" : "+s"(kp_)); *kp_; })
#else
#define GETP() (P_unused)
#endif
__global__ void __launch_bounds__(512, 2) mega_fwd(Params P_unused) {
    constexpr int PM = PHASE_MASK;
    extern __shared__ __attribute__((aligned(16))) unsigned char shm[];
    ldsp lds = (ldsp)shm;
    cg::grid_group grid = cg::this_grid();
    for (int rep = 0; rep < REP_P0; ++rep) { const Params P = GETP(); p0_phase(P, lds); }
    gsync(grid);
    for (int rep = 0; rep < REP_IN0; ++rep) { const Params P = GETP(); unsigned char* ws = P.ws;
      EpiIn0 E; E.A0 = (bf16_t*)P.out; E.XBCraw = (bf16_t*)(ws + OFF_RB); E.Kb = (bf16_t*)(ws + OFF_K); E.Vb = (bf16_t*)(ws + OFF_V); E.Gb = (bf16_t*)(ws + OFF_G);
      E.DTf = (float*)(ws + OFF_DT); E.kmean = (float*)(ws + OFF_KM); E.ctab = (const float*)(ws + OFF_CT); E.stab = (const float*)(ws + OFF_STB); E.dt_bias = P.dt_bias;
      run_gemm(lds, (const bf16_t*)(ws + OFF_XB), 2048, (const bf16_t*)(ws + OFF_W0T), 2048, N0P, 2048, E); }
    gsync(grid);
    for (int rep = 0; rep < REP_CONV; ++rep) { const Params P = GETP(); conv_phase(P); }
    gsync(grid);
    for (int rep = 0; rep < REP_MOBA_DUMMY; ++rep) { const Params P = GETP(); moba_phase(P, lds, (bf16_t*)(P.ws + WS_END), 2048, 4095u); }
    if (PM & 8) { const Params P = GETP(); moba_phase(P, lds, (bf16_t*)P.out + 2048, 4096, 0xffffffffu); }
    for (int rep = 0; rep < REP_SSDA; ++rep) { const Params P = GETP(); ssd_a_phase(P, lds); }
    gsync(grid);
    for (int rep = 0; rep < REP_SSDB; ++rep) { const Params P = GETP(); ssd_b_phase(P); }
    gsync(grid);
    if (PM & 64) { const Params P = GETP(); ssd_c_phase(P, lds); }
    gsync(grid);
    if (PM & 128) { const Params P = GETP(); unsigned char* ws = P.ws;
      EpiOut<32> E; E.resid = P.x; E.Y = (float*)(ws + OFF_K); E.rsl = (const LAS float*)(lds + 131072);
      { pg8::StaticOrder S; S.init(M, 2048, (int)gridDim.x, (int)blockIdx.x); const float* ssq = (const float*)(ws + OFF_SSQ); LAS float* rw = (LAS float*)(lds + 131072);
        for (int q = threadIdx.x; q < 2048; q += 512) { const int ui = q >> 8; Unit u; if (S.next(ui, u)) { const f32x4* p = (const f32x4*)(ssq + (size_t)(u.pm * 256 + (q & 255)) * 32); float sm = 0.f;
#pragma unroll
            for (int k = 0; k < 8; ++k) { const f32x4 v = p[k]; sm += (v[0] + v[1]) + (v[2] + v[3]); }
            rw[q] = rsqrtf(sm * (1.f / 2048.f) + 1e-5f); } }
        __syncthreads(); }
      run_gemm(lds, (const bf16_t*)P.out, 4096, (const bf16_t*)(ws + OFF_WO0), 4096, 2048, 4096, E); }
    gsync(grid);
    for (int rep = 0; rep < REP_LN0; ++rep) { const Params P = GETP(); unsigned char* ws = P.ws; ln_phase((const float*)(ws + OFF_K), P.ln_g, P.ln_b, P.out, (bf16_t*)(ws + X1B_OFF), X1B_LD); }
    gsync(grid);
#ifdef PROBE_L2GEMM
    { const Params P = GETP(); unsigned char* ws = P.ws; EpiIn1 E; E.U = (bf16_t*)(ws + OFF_XB); E.SG = (bf16_t*)(ws + OFF_RB);
      pg8::Gemm g; g.A = (const bf16_t*)(ws + X1B_OFF); g.Bt = (const bf16_t*)(ws + W1_OFF); g.M = M; g.N = 4096; g.K = 2048; g.lda = X1B_LD; g.ldb = W1_LD; g.alias_a = 1;
      pg8::StaticOrder S; S.init(M, 4096, (int)gridDim.x, (int)blockIdx.x); pg8::gemm_phase<EpiIn1, pg8::StaticOrder, false>(lds, g, S, E, nullptr); }
#endif
    for (int rep = 0; rep < REP_IN1; ++rep) { const Params P = GETP(); unsigned char* ws = P.ws;
      EpiIn1 E; E.U = (bf16_t*)(ws + OFF_K); E.SG = (bf16_t*)(ws + OFF_V);
      run_gemm(lds, (const bf16_t*)(ws + X1B_OFF), X1B_LD, (const bf16_t*)(ws + W1_OFF), W1_LD, 4096, 2048, E); }
    gsync(grid);
    for (int rep = 0; rep < REP_S5; ++rep) { const Params P = GETP(); s5_phase(P, lds); }
    gsync(grid);
    if (PM & 2048) { const Params P = GETP(); unsigned char* ws = P.ws;
      EpiGlu E; E.A1 = (bf16_t*)(ws + OFF_XB); E.SG = (const bf16_t*)(ws + OFF_V);
      run_gemm(lds, (const bf16_t*)(ws + OFF_RB), 2048, (const bf16_t*)(ws + OFF_WG), 2048, 4096, 2048, E); }
    gsync(grid);
    if (PM & 4096) { const Params P = GETP(); unsigned char* ws = P.ws;
      EpiOut<-1> E; E.resid = P.out; E.Y = (float*)(ws + OFF_K); E.rsl = nullptr;
      run_gemm(lds, (const bf16_t*)(ws + OFF_XB), 2048, (const bf16_t*)(ws + OFF_WO1), 2048, 2048, 2048, E); }
    gsync(grid);
    if (PM & 8192) { const Params P = GETP(); unsigned char* ws = P.ws; ln_phase((const float*)(ws + OFF_K), P.ln_g + 2048, P.ln_b + 2048, P.out, nullptr, 0); }
}

extern "C" void kernel_launch(void* const* d_in, const int* in_sizes, int n_in, void* d_out, int out_size, void* d_ws, size_t ws_size, hipStream_t stream) {
    static int grid_blocks = 0;
    if (grid_blocks == 0) {
        if (n_in != 22 || out_size != M * DM || ws_size < WS_END) { fprintf(stderr, "kernel_launch: unexpected shapes (n_in %d out %d ws %zu need %zu)\n", n_in, out_size, ws_size, (size_t)WS_END); grid_blocks = -1; return; }
        int dev = 0, cus = 0, per_cu = 0;
        hipGetDevice(&dev); hipDeviceGetAttribute(&cus, hipDeviceAttributeMultiprocessorCount, dev);
        if (hipFuncSetAttribute((const void*)mega_fwd, hipFuncAttributeMaxDynamicSharedMemorySize, LDS_BYTES) != hipSuccess) { fprintf(stderr, "kernel_launch: hipFuncSetAttribute failed\n"); grid_blocks = -1; return; }
        if (hipOccupancyMaxActiveBlocksPerMultiprocessor(&per_cu, (const void*)mega_fwd, 512, LDS_BYTES) != hipSuccess || per_cu < 1) { fprintf(stderr, "kernel_launch: occupancy query failed (%d)\n", per_cu); (void)hipGetLastError(); per_cu = 1; }
        grid_blocks = cus * 1;
        if (grid_blocks > 256) grid_blocks = 256;
    }
    if (grid_blocks < 0) return;
    Params p{};
    const float** pp = (const float**)&p;
    for (int i = 0; i < 22; ++i) pp[i] = (const float*)d_in[i];
    p.out = (float*)d_out; p.ws = (unsigned char*)d_ws;
    void* args[] = {&p};
    hipError_t e = hipLaunchCooperativeKernel((const void*)mega_fwd, dim3(grid_blocks), dim3(512), args, LDS_BYTES, stream);
    if (e != hipSuccess) fprintf(stderr, "cooperative launch failed: %s (grid %d)\n", hipGetErrorString(e), grid_blocks);
}
```

```cpp
#include <hip/hip_runtime.h>
#include <hip/hip_cooperative_groups.h>
#include <cstdio>
#include <cstdint>
namespace cg = cooperative_groups;
namespace pg8 {
#define PG8_LAS __attribute__((address_space(3)))
typedef unsigned short bf16_t;
typedef short bf16x8 __attribute__((ext_vector_type(8)));
typedef float f32x4 __attribute__((ext_vector_type(4)));
typedef unsigned u32x4 __attribute__((ext_vector_type(4)));
constexpr int BM = 256, BK = 64, HALF = 128, HTB = HALF * BK * 2  , STAGE_BYTES = 8 * HTB, NXCD = 8, WGM = 8;

__host__ __device__ __forceinline__ int lds_byte(int r, int c) { const int st = (r >> 4) * 2 + (c >> 5), rr = r & 15, cc = c & 31, ob = rr * 64 + cc * 2; return st * 1024 + (ob ^ (((ob >> 9) & 1) << 5)); }
__host__ __device__ __forceinline__ void stage_rc(int b, int& R, int& C) { const int st = b / 1024, sb = b % 1024, swz = sb ^ (((sb >> 9) & 1) << 5); R = (st >> 1) * 16 + swz / 64; C = (st & 1) * 32 + (swz % 64) / 2; }
__host__ __device__ __forceinline__ int perm32(int rho) { const int n = rho >> 4, i = rho & 15; return 8 * (i >> 2) + 4 * n + (i & 3); }

struct Unit { int pm, pn; };
struct Gemm { const bf16_t* A; const bf16_t* Bt; int M, N, K, lda, ldb, alias_a; };

struct StaticOrder {
    int nM, nN, nwg, G, c;
    __host__ __device__ void init(int M, int N, int G_, int c_) { nM = M / BM; nN = N / BM; nwg = nM * nN; G = G_; c = c_; }
    __host__ __device__ bool next(int i, Unit& u) const {
        const long L = (long)i * G + c; if (L >= nwg) return false;
        int wgid = (int)L; { const int q = nwg / NXCD, r = nwg % NXCD, xcd = wgid % NXCD, off = wgid / NXCD; wgid = (xcd < r ? xcd * (q + 1) : r * (q + 1) + (xcd - r) * q) + off; }
        const int nig = WGM * nN, gid = wgid / nig, fm = gid * WGM, gsz = (nM - fm) < WGM ? (nM - fm) : WGM;
        u.pm = fm + ((wgid % nig) % gsz); u.pn = (wgid % nig) / gsz; return true;
    }
    __device__ __forceinline__ void a_ready(const Unit&) const {}
    __device__ __forceinline__ void done(const Unit&) const {}
};
__device__ __forceinline__ unsigned cvt_pk_bf16(float lo, float hi) { unsigned r; asm volatile("v_cvt_pk_bf16_f32 %0, %1, %2" : "=v"(r) : "v"(lo), "v"(hi)); return r; }
template <class Epi, class Sched, bool STAMP = false>
__device__ __forceinline__ void gemm_phase(PG8_LAS unsigned char* lds, const Gemm g, const Sched& S, const Epi& E, unsigned long long* stamps) {
    const int tid = threadIdx.x, wid = __builtin_amdgcn_readfirstlane(tid >> 6), lane = tid & 63, wr = wid >> 2, wc = wid & 3, fr = lane & 15, fq = lane >> 4;
    const int K = g.K, nt = K / BK;
    int ts_lo = 0, ts_hi = 0, nts = 0; const unsigned long long rt_entry = STAMP ? (unsigned long long)wall_clock64() : 0ull;
#define PG8_STAMP() do { if (STAMP && wid == 0 && nts < 64) { const unsigned long long _c = (unsigned long long)clock64(); \
        ts_lo = (lane == nts) ? (int)(unsigned)_c : ts_lo; ts_hi = (lane == nts) ? (int)(unsigned)(_c >> 32) : ts_hi; ++nts; } } while (0)
    PG8_STAMP();
    unsigned voffA[2], voffB[2];
#pragma unroll
    for (int i = 0; i < 2; ++i) { int R, C; stage_rc(tid * 16 + i * 8192, R, C); const int Rb = Epi::PERM ? ((R & ~31) + perm32(R & 31)) : R;
        voffA[i] = (unsigned)(R * g.lda + C) * 2u; voffB[i] = (unsigned)(Rb * g.ldb + C) * 2u; }
    const size_t kstep = (size_t)(BK * 2);
    const size_t hstepA = (size_t)HALF * g.lda * 2, hstepB = (size_t)HALF * g.ldb * 2;
    const size_t tstepA = g.alias_a ? (size_t)0 : 2 * hstepA, tstepB = 2 * hstepB;
    const unsigned ldsw = (unsigned)wid * 1024u;
    const int aoff = lds_byte(wr * 64 + fr, fq * 8), boff = lds_byte(wc * 32 + fr, fq * 8);
#define PG8_SA(b, h) (((b) * 2 + (h)) * HTB)
#define PG8_SB(b, h) ((4 + (b) * 2 + (h)) * HTB)
#define PG8_STAGE(bufoff, gbase, voff) do { _Pragma("unroll") for (int _i = 0; _i < 2; ++_i) \
        __builtin_amdgcn_global_load_lds((const unsigned*)((const char*)(gbase) + (voff)[_i]), (PG8_LAS unsigned*)(lds + (bufoff) + ldsw + _i * 8192), 16, 0, 0); } while (0)
#define PG8_LDA(dst, b, h) do { _Pragma("unroll") for (int m = 0; m < 4; ++m) _Pragma("unroll") for (int k = 0; k < 2; ++k) dst[m][k] = *(const PG8_LAS bf16x8*)(lds + PG8_SA(b, h) + aoff + m * 2048 + k * 1024); } while (0)
#define PG8_LDB(dst, b, h) do { _Pragma("unroll") for (int n = 0; n < 2; ++n) _Pragma("unroll") for (int k = 0; k < 2; ++k) dst[n][k] = *(const PG8_LAS bf16x8*)(lds + PG8_SB(b, h) + boff + n * 2048 + k * 1024); } while (0)
#define PG8_MMA(ai, bj, At, Bt) do { __builtin_amdgcn_s_setprio(1); _Pragma("unroll") for (int m = 0; m < 4; ++m) _Pragma("unroll") for (int n = 0; n < 2; ++n) _Pragma("unroll") for (int k = 0; k < 2; ++k) \
        acc[ai][bj][m][n] = __builtin_amdgcn_mfma_f32_16x16x32_bf16(Bt[n][k], At[m][k], acc[ai][bj][m][n], 0, 0, 0); __builtin_amdgcn_s_setprio(0); } while (0)
#define PG8_WAIT_V(n) asm volatile("s_waitcnt vmcnt(" #n ")" ::: "memory")
#define PG8_WAIT_L(n) asm volatile("s_waitcnt lgkmcnt(" #n ")" ::: "memory")
#define PG8_BAR __builtin_amdgcn_s_barrier()
#define PG8_SCHED __builtin_amdgcn_sched_barrier(0)
    Unit cur, nxt; int ui = 0;
    if (!S.next(0, cur)) return;
    f32x4 acc[2][2][4][2];
#pragma unroll
    for (int a = 0; a < 2; ++a)
#pragma unroll
        for (int b = 0; b < 2; ++b)
#pragma unroll
            for (int m = 0; m < 4; ++m)
#pragma unroll
                for (int n = 0; n < 2; ++n) acc[a][b][m][n] = (f32x4){0.f, 0.f, 0.f, 0.f};
    bf16x8 At[4][2], B0[2][2], B1[2][2];
    const char* cA = (const char*)g.A + (size_t)cur.pm * tstepA; const char* cB = (const char*)g.Bt + (size_t)cur.pn * tstepB;
    S.a_ready(cur);
    PG8_STAGE(PG8_SB(0, 0), cB, voffB); PG8_STAGE(PG8_SA(0, 0), cA, voffA); PG8_STAGE(PG8_SB(0, 1), cB + hstepB, voffB); PG8_STAGE(PG8_SA(0, 1), cA + hstepA, voffA);
    if (wr == 1) PG8_BAR;
    PG8_WAIT_V(4); PG8_BAR;
    PG8_STAGE(PG8_SB(1, 0), cB + kstep, voffB); PG8_STAGE(PG8_SA(1, 0), cA + kstep, voffA); PG8_STAGE(PG8_SB(1, 1), cB + hstepB + kstep, voffB);
    PG8_WAIT_V(6); PG8_BAR;
    PG8_STAMP();
    for (;;) {
        const bool has_next = S.next(ui + 1, nxt);
        const char* nA = has_next ? (const char*)g.A + (size_t)nxt.pm * tstepA : cA; const char* nB = has_next ? (const char*)g.Bt + (size_t)nxt.pn * tstepB : cB;
        for (int t = 0; t < nt; t += 2) {
            if constexpr (Epi::MID >= 0) { if (t == Epi::MID) E.mid(acc, cur, ui, wr, wc, fr, fq); }
            const bool last = (t == nt - 2);
            const char* a1 = cA + (size_t)(t + 1) * kstep;
            const char* a2 = last ? nA : cA + (size_t)(t + 2) * kstep; const char* b2 = last ? nB : cB + (size_t)(t + 2) * kstep;
            const char* a3 = a2 + kstep; const char* b3 = b2 + kstep;
            if (last && has_next) S.a_ready(nxt);
            PG8_LDB(B0, 0, 0); PG8_SCHED; PG8_LDA(At, 0, 0); PG8_STAGE(PG8_SA(1, 1), a1 + hstepA, voffA);
            PG8_WAIT_L(8); PG8_BAR; PG8_WAIT_L(0); PG8_MMA(0, 0, At, B0); PG8_BAR; PG8_SCHED;
            PG8_LDB(B1, 0, 1); PG8_STAGE(PG8_SB(0, 0), b2, voffB);
            PG8_BAR; PG8_WAIT_L(0); PG8_MMA(0, 1, At, B1); PG8_BAR;
            PG8_LDA(At, 0, 1); PG8_STAGE(PG8_SA(0, 0), a2, voffA);
            PG8_BAR; PG8_WAIT_L(0); PG8_MMA(1, 0, At, B0); PG8_BAR; PG8_SCHED;
            PG8_STAGE(PG8_SB(0, 1), b2 + hstepB, voffB);
            PG8_WAIT_V(6); PG8_BAR; PG8_MMA(1, 1, At, B1); PG8_BAR;
            PG8_LDB(B0, 1, 0); PG8_SCHED; PG8_LDA(At, 1, 0); PG8_STAGE(PG8_SA(0, 1), a2 + hstepA, voffA);
            PG8_WAIT_L(8); PG8_BAR; PG8_WAIT_L(0); PG8_MMA(0, 0, At, B0); PG8_BAR; PG8_SCHED;
            PG8_LDB(B1, 1, 1); PG8_STAGE(PG8_SB(1, 0), b3, voffB);
            PG8_BAR; PG8_WAIT_L(0); PG8_MMA(0, 1, At, B1); PG8_BAR;
            PG8_LDA(At, 1, 1); PG8_STAGE(PG8_SA(1, 0), a3, voffA);
            PG8_BAR; PG8_WAIT_L(0); PG8_MMA(1, 0, At, B0); PG8_BAR; PG8_SCHED;
            PG8_STAGE(PG8_SB(1, 1), b3 + hstepB, voffB);
            PG8_WAIT_V(6); PG8_BAR; PG8_MMA(1, 1, At, B1); PG8_BAR;
        }
        PG8_STAMP();
        if constexpr (!Epi::AFTER_DRAIN) { E(acc, cur, wr, wc, fr, fq); S.done(cur); }
        PG8_STAMP();
        if (!has_next) break;
#pragma unroll
        for (int a = 0; a < 2; ++a)
#pragma unroll
            for (int b = 0; b < 2; ++b)
#pragma unroll
                for (int m = 0; m < 4; ++m)
#pragma unroll
                    for (int n = 0; n < 2; ++n) acc[a][b][m][n] = (f32x4){0.f, 0.f, 0.f, 0.f};
        cur = nxt; cA = nA; cB = nB; ++ui;
    }
    PG8_WAIT_V(0);
    if (wr == 0) PG8_BAR;
    PG8_BAR;
    if constexpr (Epi::AFTER_DRAIN) { E.fused(acc, cur, wr, wc, fr, fq, lds, wid, lane); S.done(cur); }
    PG8_STAMP();
    if (STAMP && wid == 0) { stamps[lane] = lane < nts ? (((unsigned long long)(unsigned)ts_hi << 32) | (unsigned)ts_lo) : 0ull;
        if (lane == 62) stamps[62] = rt_entry; if (lane == 63) stamps[63] = (unsigned long long)wall_clock64(); }
#undef PG8_STAMP
#undef PG8_SA
#undef PG8_SB
#undef PG8_STAGE
#undef PG8_LDA
#undef PG8_LDB
#undef PG8_MMA
#undef PG8_WAIT_V
#undef PG8_WAIT_L
#undef PG8_BAR
#undef PG8_SCHED
}
}

using pg8::bf16_t; using pg8::bf16x8; using pg8::f32x4; using pg8::u32x4; using pg8::Unit;
#define LAS __attribute__((address_space(3)))
#ifndef GSYNC_WAVE_ACQ
#define GSYNC_WAVE_ACQ 0
#endif
#ifndef GEMM_SKEW_TICKS
#define GEMM_SKEW_TICKS 0
#endif
typedef short s16x4 __attribute__((ext_vector_type(4)));
typedef short v4i16_t __attribute__((ext_vector_type(4)));
typedef unsigned u32x2 __attribute__((ext_vector_type(2)));
typedef LAS unsigned char* ldsp;

constexpr int M = 16384, DM = 2048, SEQ = 4096;
constexpr int N0P = 13568;
constexpr float ALPHA = 1.41421356237309515f;
constexpr int LDS_BYTES = 131072 + 8192;

constexpr size_t OFF_XB = 0;
constexpr size_t OFF_W0T = 67108864;
constexpr size_t OFF_RB = 122683392;
constexpr size_t OFF_SIN = OFF_RB + 67108864;
constexpr size_t OFF_K = 223346688;
constexpr size_t OFF_V = 290455552;
constexpr size_t OFF_G = 357564416;
constexpr size_t OFF_WO0 = 424673280;
constexpr size_t OFF_W1 = 441450496;
constexpr size_t OFF_WG = 458227712;
constexpr size_t OFF_WO1 = 475004928;
constexpr size_t OFF_DT = 483393536;
constexpr size_t OFF_CUM = 485490688;
constexpr size_t OFF_SSQ = 487587840;
constexpr size_t OFF_KM = 490733568;
constexpr size_t OFF_CT = 490209280;
constexpr size_t OFF_STB = 490471424;
constexpr size_t WS_END = 490733568 + 1048576;
#ifdef PITCH_EXP
constexpr size_t X1B_OFF = OFF_XB, W1_OFF = WS_END; constexpr int X1B_LD = 2112, W1_LD = 2112;
#else
constexpr size_t X1B_OFF = OFF_G, W1_OFF = OFF_W1; constexpr int X1B_LD = 2048, W1_LD = 2048;
#endif

struct Params {
    const float *x, *in0_w, *conv_w, *conv_b, *dt_bias, *a_log, *ssd_d, *ssd_norm_g, *out0_w, *in1_w,
                *lam_re, *lam_im, *log_dt, *b_re, *b_im, *c_re, *c_im, *s5_d, *glu_w, *out1_w, *ln_g, *ln_b;
    float* out; unsigned char* ws;
};

__constant__ float INVF[16] = {1.000000000e+00f, 4.403665960e-01f, 1.939227432e-01f, 8.539710194e-02f, 3.760603070e-02f, 1.656043902e-02f, 7.292664610e-03f, 3.211445874e-03f,
                               1.414213562e-03f, 6.227723788e-04f, 2.742481884e-04f, 1.207697351e-04f, 5.318296098e-05f, 2.341999971e-05f, 1.031338616e-05f, 4.541670478e-06f};

#define LDS_WAIT() asm volatile("s_waitcnt lgkmcnt(0)" ::: "memory")
__device__ __forceinline__ unsigned pk2(float lo, float hi) { return pg8::cvt_pk_bf16(lo, hi); }
__device__ __forceinline__ float bf_lo(unsigned u) { return __uint_as_float(u << 16); }
__device__ __forceinline__ float bf_hi(unsigned u) { return __uint_as_float(u & 0xffff0000u); }
__device__ __forceinline__ float bf1(bf16_t h) { return __uint_as_float(((unsigned)h) << 16); }
__device__ __forceinline__ float silu_f(float v) { return v * __builtin_amdgcn_rcpf(1.f + __expf(-v)); }
__device__ __forceinline__ float sigmoid_f(float v) { return __builtin_amdgcn_rcpf(1.f + __expf(-v)); }
__device__ __forceinline__ float softplus_f(float v) { return fmaxf(v, 0.f) + log1pf(__expf(-fabsf(v))); }
__device__ __forceinline__ float gelu_tanh_f(float v) { const float u = 0.7978845608028654f * (v + 0.044715f * v * v * v); const float t = 1.f - 2.f * __builtin_amdgcn_rcpf(1.f + __expf(2.f * u)); return 0.5f * v * (1.f + t); }
__device__ __forceinline__ s16x4 vtr(const LAS unsigned char* p) { return __builtin_bit_cast(s16x4, __builtin_amdgcn_ds_read_tr16_b64_v4i16((LAS v4i16_t*)p)); }
__device__ __forceinline__ bf16x8 cat8(s16x4 lo, s16x4 hi) { return __builtin_shufflevector(lo, hi, 0, 1, 2, 3, 4, 5, 6, 7); }
__device__ __forceinline__ f32x4 mfma16(bf16x8 a, bf16x8 b, f32x4 c) { return __builtin_amdgcn_mfma_f32_16x16x32_bf16(a, b, c, 0, 0, 0); }
__device__ __forceinline__ void sincos_d(double a, float& s, float& c) {
    const double k = rint(a * 0.63661977236758134308);
    double r = fma(-k, 1.57079632679489661923, a); r = fma(-k, 6.123233995736766e-17, r);
    const double r2 = r * r;
    const double sp = r * (1.0 + r2 * (-1.0 / 6.0 + r2 * (1.0 / 120.0 + r2 * (-1.0 / 5040.0 + r2 * (1.0 / 362880.0 + r2 * (-1.0 / 39916800.0 + r2 * (1.0 / 6227020800.0)))))));
    const double cp = 1.0 + r2 * (-0.5 + r2 * (1.0 / 24.0 + r2 * (-1.0 / 720.0 + r2 * (1.0 / 40320.0 + r2 * (-1.0 / 3628800.0 + r2 * (1.0 / 479001600.0 + r2 * (-1.0 / 87178291200.0)))))));
    const int q = ((int)k) & 3;
    const double ss = (q == 0) ? sp : (q == 1) ? cp : (q == 2) ? -sp : -cp;
    const double cc = (q == 0) ? cp : (q == 1) ? -sp : (q == 2) ? -cp : sp;
    s = (float)ss; c = (float)cc;
}

struct EpiIn0 {
    static constexpr bool PERM = false, AFTER_DRAIN = false; static constexpr int MID = -1;
    bf16_t *A0, *XBCraw, *Kb, *Vb, *Gb; float *DTf, *kmean; const float *ctab, *stab, *dt_bias;
    __device__ __forceinline__ void mid(f32x4 (&)[2][2][4][2], const Unit&, int, int, int, int, int) const {}
    __device__ __forceinline__ void operator()(const f32x4 (&acc)[2][2][4][2], const Unit& u, int wr, int wc, int fr, int fq) const {
        const int pn = u.pn, rowb = u.pm * 256 + wr * 64 + fr, colw = wc * 32 + 4 * fq;
        if (pn >= 52) {
            if (pn == 52 && wc == 0) {
#pragma unroll
                for (int ai = 0; ai < 2; ++ai)
#pragma unroll
                    for (int m = 0; m < 4; ++m) { const int row = rowb + ai * 128 + m * 16;
#pragma unroll
                        for (int n = 0; n < 2; ++n) { const f32x4 v = acc[ai][0][m][n]; const f32x4 bb = *(const f32x4*)(dt_bias + 16 * n + 4 * fq); f32x4 r;
                            r[0] = softplus_f(v[0] + bb[0]); r[1] = softplus_f(v[1] + bb[1]); r[2] = softplus_f(v[2] + bb[2]); r[3] = softplus_f(v[3] + bb[3]);
                            *(f32x4*)(DTf + (size_t)row * 32 + 16 * n + 4 * fq) = r; } }
            }
            return;
        }
        bf16_t* dst; int ld; int mode;
        if (pn < 8) { dst = A0 + 256 * pn; ld = 4096; mode = 0; }
        else if (pn < 20) { dst = XBCraw + 256 * (pn - 8); ld = 3072; mode = 0; }
        else if (pn < 28) { dst = A0 + 2048 + 256 * (pn - 20); ld = 4096; mode = 1; }
        else if (pn < 36) { dst = Kb + 256 * (pn - 28); ld = 2048; mode = 2; }
        else if (pn < 44) { dst = Vb + 256 * (pn - 36); ld = 2048; mode = 0; }
        else { dst = Gb + 256 * (pn - 44); ld = 2048; mode = 3; }
        const bool rot = (mode == 1 || mode == 2) && (wc == 0);
        f32x4 cs[2][2];
#pragma unroll
        for (int bj = 0; bj < 2; ++bj)
#pragma unroll
            for (int n = 0; n < 2; ++n) cs[bj][n] = (f32x4){0.f, 0.f, 0.f, 0.f};
#pragma unroll
        for (int ai = 0; ai < 2; ++ai)
#pragma unroll
            for (int m = 0; m < 4; ++m) { const int row = rowb + ai * 128 + m * 16; f32x4 v[2][2];
#pragma unroll
                for (int bj = 0; bj < 2; ++bj)
#pragma unroll
                    for (int n = 0; n < 2; ++n) v[bj][n] = acc[ai][bj][m][n];
                if (rot) { const int pos = row & (SEQ - 1); const f32x4 cv = *(const f32x4*)(ctab + pos * 16 + 4 * fq), sv = *(const f32x4*)(stab + pos * 16 + 4 * fq);
#pragma unroll
                    for (int bj = 0; bj < 2; ++bj) { const f32x4 x1 = v[bj][0], x2 = v[bj][1]; v[bj][0] = x1 * cv - x2 * sv; v[bj][1] = x1 * sv + x2 * cv; } }
                if (mode == 2) {
#pragma unroll
                    for (int bj = 0; bj < 2; ++bj)
#pragma unroll
                        for (int n = 0; n < 2; ++n) cs[bj][n] += v[bj][n]; }
                if (mode == 3) {
#pragma unroll
                    for (int bj = 0; bj < 2; ++bj)
#pragma unroll
                        for (int n = 0; n < 2; ++n)
#pragma unroll
                            for (int j = 0; j < 4; ++j) v[bj][n][j] = silu_f(v[bj][n][j]); }
                bf16_t* rp = dst + (size_t)row * ld + colw;
#pragma unroll
                for (int bj = 0; bj < 2; ++bj)
#pragma unroll
                    for (int n = 0; n < 2; ++n) { u32x2 o; o.x = pk2(v[bj][n][0], v[bj][n][1]); o.y = pk2(v[bj][n][2], v[bj][n][3]); *(u32x2*)(rp + bj * 128 + n * 16) = o; }
            }
        if (mode == 2) {
#pragma unroll
            for (int bj = 0; bj < 2; ++bj)
#pragma unroll
                for (int n = 0; n < 2; ++n)
#pragma unroll
                    for (int j = 0; j < 4; ++j) { float s = cs[bj][n][j]; s += __shfl_xor(s, 1); s += __shfl_xor(s, 2); s += __shfl_xor(s, 4); s += __shfl_xor(s, 8); cs[bj][n][j] = s; }
            if (fr == 0) { const int b = u.pm >> 4, blk = u.pm & 15;
#pragma unroll
                for (int bj = 0; bj < 2; ++bj) { const int head = 2 * (pn - 28) + bj; float* kp = kmean + ((size_t)((b * 16 + head) * 16 + blk)) * 128 + colw;
#pragma unroll
                    for (int n = 0; n < 2; ++n) *(f32x4*)(kp + wr * 131072 + n * 16) = cs[bj][n]; } }
        }
    }
};
struct EpiIn1 {
    static constexpr bool PERM = false, AFTER_DRAIN = false; static constexpr int MID = -1;
    bf16_t *U, *SG;
    __device__ __forceinline__ void mid(f32x4 (&)[2][2][4][2], const Unit&, int, int, int, int, int) const {}
    __device__ __forceinline__ void operator()(const f32x4 (&acc)[2][2][4][2], const Unit& u, int wr, int wc, int fr, int fq) const {
        const int pn = u.pn, rowb = u.pm * 256 + wr * 64 + fr, colw = wc * 32 + 4 * fq; const bool sg = pn >= 8;
        bf16_t* dst = sg ? SG + 256 * (pn - 8) : U + 256 * pn;
#pragma unroll
        for (int ai = 0; ai < 2; ++ai)
#pragma unroll
            for (int m = 0; m < 4; ++m) { bf16_t* rp = dst + (size_t)(rowb + ai * 128 + m * 16) * 2048 + colw;
#pragma unroll
                for (int bj = 0; bj < 2; ++bj)
#pragma unroll
                    for (int n = 0; n < 2; ++n) { f32x4 v = acc[ai][bj][m][n];
                        if (sg) { v[0] = silu_f(v[0]); v[1] = silu_f(v[1]); v[2] = silu_f(v[2]); v[3] = silu_f(v[3]); }
                        u32x2 o; o.x = pk2(v[0], v[1]); o.y = pk2(v[2], v[3]); *(u32x2*)(rp + bj * 128 + n * 16) = o; } }
    }
};
struct EpiGlu {
    static constexpr bool PERM = false, AFTER_DRAIN = false; static constexpr int MID = -1;
    bf16_t* __restrict__ A1; const bf16_t* __restrict__ SG;
    __device__ __forceinline__ void mid(f32x4 (&)[2][2][4][2], const Unit&, int, int, int, int, int) const {}
    __device__ __forceinline__ void operator()(const f32x4 (&acc)[2][2][4][2], const Unit& u, int wr, int wc, int fr, int fq) const {
        const int rowb = u.pm * 256 + wr * 64 + fr, colb = u.pn * 128 + wc * 32 + 4 * fq;
        u32x2 sgv[2][4][2];
#pragma unroll
        for (int ai = 0; ai < 2; ++ai)
#pragma unroll
            for (int m = 0; m < 4; ++m)
#pragma unroll
                for (int n = 0; n < 2; ++n) sgv[ai][m][n] = *(const u32x2*)(SG + (size_t)(rowb + ai * 128 + m * 16) * 2048 + colb + n * 16);
#pragma unroll
        for (int ai = 0; ai < 2; ++ai)
#pragma unroll
            for (int m = 0; m < 4; ++m) { const size_t ro = (size_t)(rowb + ai * 128 + m * 16) * 2048 + colb;
#pragma unroll
                for (int n = 0; n < 2; ++n) { const f32x4 ga = acc[ai][0][m][n], gb = acc[ai][1][m][n]; const u32x2 s = sgv[ai][m][n];
                    const float o0 = ga[0] * sigmoid_f(gb[0]) * bf_lo(s.x), o1 = ga[1] * sigmoid_f(gb[1]) * bf_hi(s.x), o2 = ga[2] * sigmoid_f(gb[2]) * bf_lo(s.y), o3 = ga[3] * sigmoid_f(gb[3]) * bf_hi(s.y);
                    u32x2 o; o.x = pk2(o0, o1); o.y = pk2(o2, o3); *(u32x2*)(A1 + ro + n * 16) = o; } }
    }
};
template <int MIDK> struct EpiOut {
    static constexpr bool PERM = false, AFTER_DRAIN = false; static constexpr int MID = MIDK;
    const float* __restrict__ resid; float* __restrict__ Y; const LAS float* rsl;
    __device__ __forceinline__ void mid(f32x4 (&acc)[2][2][4][2], const Unit& u, int ui, int wr, int wc, int fr, int fq) const {
        const LAS float* rp = rsl + ui * 256 + wr * 64 + fr;
#pragma unroll
        for (int ai = 0; ai < 2; ++ai)
#pragma unroll
            for (int m = 0; m < 4; ++m) { const float rs = rp[ai * 128 + m * 16];
#pragma unroll
                for (int bj = 0; bj < 2; ++bj)
#pragma unroll
                    for (int n = 0; n < 2; ++n) acc[ai][bj][m][n] *= rs; }
    }
    __device__ __forceinline__ void operator()(const f32x4 (&acc)[2][2][4][2], const Unit& u, int wr, int wc, int fr, int fq) const {
        const int rowb = u.pm * 256 + wr * 64 + fr, colb = u.pn * 256 + wc * 32 + 4 * fq;
#pragma unroll
        for (int ai = 0; ai < 2; ++ai)
#pragma unroll
            for (int mp = 0; mp < 2; ++mp) { f32x4 r[2][2][2];
#pragma unroll
                for (int mm = 0; mm < 2; ++mm) { const size_t ro = (size_t)(rowb + ai * 128 + (2 * mp + mm) * 16) * 2048 + colb;
#pragma unroll
                    for (int bj = 0; bj < 2; ++bj)
#pragma unroll
                        for (int n = 0; n < 2; ++n) r[mm][bj][n] = *(const f32x4*)(resid + ro + bj * 128 + n * 16); }
#pragma unroll
                for (int mm = 0; mm < 2; ++mm) { const size_t ro = (size_t)(rowb + ai * 128 + (2 * mp + mm) * 16) * 2048 + colb;
#pragma unroll
                    for (int bj = 0; bj < 2; ++bj)
#pragma unroll
                        for (int n = 0; n < 2; ++n) *(f32x4*)(Y + ro + bj * 128 + n * 16) = r[mm][bj][n] * ALPHA + acc[ai][bj][2 * mp + mm][n]; } }
    }
};

__device__ __forceinline__ void transpose_item(const float* W, int Nsrc, int nsrc0, bf16_t* WT, int Kdim, int k0, int ndst0, const float* kscale, LAS float* scr, int lane) {
    if (nsrc0 >= 0) {
#pragma unroll 8
        for (int i = 0; i < 32; ++i) { const int kk = 2 * i + (lane >> 5); float v = W[(size_t)(k0 + kk) * Nsrc + nsrc0 + (lane & 31)]; if (kscale) v *= kscale[k0 + kk]; scr[kk * 33 + (lane & 31)] = v; }
    } else {
#pragma unroll 8
        for (int i = 0; i < 32; ++i) { const int kk = 2 * i + (lane >> 5); scr[kk * 33 + (lane & 31)] = 0.f; }
    }
    LDS_WAIT();
    const int c = lane & 7;
#pragma unroll
    for (int j = 0; j < 4; ++j) { const int n = (lane >> 3) + 8 * j; const LAS float* s = scr + (8 * c) * 33 + n;
        u32x4 o; o.x = pk2(s[0 * 33], s[1 * 33]); o.y = pk2(s[2 * 33], s[3 * 33]); o.z = pk2(s[4 * 33], s[5 * 33]); o.w = pk2(s[6 * 33], s[7 * 33]);
        *(u32x4*)(WT + (size_t)(ndst0 + n) * Kdim + k0 + 8 * c) = o; }
    LDS_WAIT();
}
__device__ __forceinline__ void p0_phase(const Params& P, ldsp lds) {
    const int tid = threadIdx.x, wave = __builtin_amdgcn_readfirstlane(tid >> 6), lane = tid & 63;
    const int gw = blockIdx.x * 8 + wave, NGW = gridDim.x * 8;
    const size_t gtid = (size_t)blockIdx.x * 512 + tid, nth = (size_t)gridDim.x * 512;
    unsigned char* ws = P.ws;
    LAS float* scr = (LAS float*)(lds + wave * 8704);
    constexpr int I0 = 32 * 424, I1 = 64 * 64, I2 = 32 * 128, I3 = 32 * 128, I4 = 32 * 64;
    for (int it = gw; it < I0 + I1 + I2 + I3 + I4; it += NGW) {
        int r = it;
        if (r < I0) { const int kb = r / 424, nb = r % 424, nd = 32 * nb; const int ns = nd < 5120 ? nd : (nd < 13312 ? nd + 32 : (nd == 13312 ? 5120 : -1));
            transpose_item(P.in0_w, 13344, ns, (bf16_t*)(ws + OFF_W0T), 2048, 64 * kb, nd, nullptr, scr, lane); continue; } r -= I0;
        if (r < I1) { const int kb = r / 64, nb = r % 64; transpose_item(P.out0_w, 2048, 32 * nb, (bf16_t*)(ws + OFF_WO0), 4096, 64 * kb, 32 * nb, kb < 32 ? P.ssd_norm_g : nullptr, scr, lane); continue; } r -= I1;
        if (r < I2) { const int kb = r / 128, nb = r % 128; transpose_item(P.in1_w, 4096, 32 * nb, (bf16_t*)(ws + W1_OFF), W1_LD, 64 * kb, 32 * nb, nullptr, scr, lane); continue; } r -= I2;
        if (r < I3) { const int kb = r / 128, nb = r % 128, nd = 32 * nb; const int ns = ((nd >> 7) & 1) * 2048 + 128 * (nd >> 8) + (nd & 127);
            transpose_item(P.glu_w, 4096, ns, (bf16_t*)(ws + OFF_WG), 2048, 64 * kb, nd, nullptr, scr, lane); continue; } r -= I3;
        { const int kb = r / 64, nb = r % 64; transpose_item(P.out1_w, 2048, 32 * nb, (bf16_t*)(ws + OFF_WO1), 2048, 64 * kb, 32 * nb, nullptr, scr, lane); }
    }
    { const f32x4* xs = (const f32x4*)P.x; u32x2* xd = (u32x2*)(ws + OFF_XB);
      for (size_t i = gtid; i < (size_t)M * DM / 4; i += nth) { const f32x4 v = xs[i]; u32x2 o; o.x = pk2(v[0], v[1]); o.y = pk2(v[2], v[3]); xd[i] = o; } }
    { float* ct = (float*)(ws + OFF_CT); float* st = (float*)(ws + OFF_STB);
      for (size_t i = gtid; i < 4096 * 16; i += nth) { const int pos = (int)(i >> 4), k = (int)(i & 15); const float ang = (float)pos * INVF[k]; float s, c; sincos_d((double)ang, s, c); ct[i] = c; st[i] = s; } }

}

__device__ __forceinline__ void conv_phase(const Params& P) {
    const int tid = threadIdx.x, wave = __builtin_amdgcn_readfirstlane(tid >> 6), lane = tid & 63;
    const size_t gtid = (size_t)blockIdx.x * 512 + tid, nth = (size_t)gridDim.x * 512;
    const bf16_t* XR = (const bf16_t*)(P.ws + OFF_RB); bf16_t* X2 = (bf16_t*)(P.ws + OFF_XB);
    for (size_t it = gtid; it < (size_t)1024 * 384; it += nth) {
        const int tb = (int)(it / 384), cc = (int)(it % 384), t0 = tb * 16, ch = cc * 8;
        float w[4][8], bb[8];
#pragma unroll
        for (int j = 0; j < 4; ++j) { const f32x4 a = *(const f32x4*)(P.conv_w + j * 3072 + ch), b = *(const f32x4*)(P.conv_w + j * 3072 + ch + 4);
            w[j][0] = a[0]; w[j][1] = a[1]; w[j][2] = a[2]; w[j][3] = a[3]; w[j][4] = b[0]; w[j][5] = b[1]; w[j][6] = b[2]; w[j][7] = b[3]; }
        { const f32x4 a = *(const f32x4*)(P.conv_b + ch), b = *(const f32x4*)(P.conv_b + ch + 4); bb[0] = a[0]; bb[1] = a[1]; bb[2] = a[2]; bb[3] = a[3]; bb[4] = b[0]; bb[5] = b[1]; bb[6] = b[2]; bb[7] = b[3]; }
        const bool first = (t0 & (SEQ - 1)) == 0;
        u32x4 raw[19];
#pragma unroll
        for (int r = 0; r < 19; ++r) { if (r < 3 && first) raw[r] = (u32x4){0u, 0u, 0u, 0u}; else raw[r] = *(const u32x4*)(XR + (size_t)(t0 - 3 + r) * 3072 + ch); }
#pragma unroll
        for (int r = 0; r < 16; ++r) { float o[8];
#pragma unroll
            for (int e = 0; e < 8; ++e) o[e] = bb[e];
#pragma unroll
            for (int j = 0; j < 4; ++j) { const u32x4 q = raw[r + j];
                o[0] += w[j][0] * bf_lo(q.x); o[1] += w[j][1] * bf_hi(q.x); o[2] += w[j][2] * bf_lo(q.y); o[3] += w[j][3] * bf_hi(q.y);
                o[4] += w[j][4] * bf_lo(q.z); o[5] += w[j][5] * bf_hi(q.z); o[6] += w[j][6] * bf_lo(q.w); o[7] += w[j][7] * bf_hi(q.w); }
#pragma unroll
            for (int e = 0; e < 8; ++e) o[e] = silu_f(o[e]);
            u32x4 ov; ov.x = pk2(o[0], o[1]); ov.y = pk2(o[2], o[3]); ov.z = pk2(o[4], o[5]); ov.w = pk2(o[6], o[7]);
            *(u32x4*)(X2 + (size_t)(t0 + r) * 3072 + ch) = ov; }
    }
    const float* DTf = (const float*)(P.ws + OFF_DT); float* CUM = (float*)(P.ws + OFF_CUM);
    for (int it = blockIdx.x * 8 + wave; it < 2048; it += gridDim.x * 8) {
        const int b = it >> 9, c = (it >> 5) & 15, h = it & 31; const size_t rowbase = (size_t)b * 4096 + c * 256 + 4 * lane;
        const float Ah = -__expf(P.a_log[h]);
        const float a0 = DTf[(rowbase + 0) * 32 + h] * Ah, a1 = DTf[(rowbase + 1) * 32 + h] * Ah, a2 = DTf[(rowbase + 2) * 32 + h] * Ah, a3 = DTf[(rowbase + 3) * 32 + h] * Ah;
        const float s0 = a0, s1 = s0 + a1, s2 = s1 + a2, s3 = s2 + a3;
        float x = s3;
#pragma unroll
        for (int o = 1; o < 64; o <<= 1) { const float t = __shfl_up(x, o); if (lane >= o) x += t; }
        const float off = x - s3;
        CUM[(rowbase + 0) * 32 + h] = off + s0; CUM[(rowbase + 1) * 32 + h] = off + s1; CUM[(rowbase + 2) * 32 + h] = off + s2; CUM[(rowbase + 3) * 32 + h] = off + s3;
    }
}

__device__ __forceinline__ void ssd_a_phase(const Params& P, ldsp lds) {
    const int tid = threadIdx.x, wave = __builtin_amdgcn_readfirstlane(tid >> 6), lane = tid & 63, quad = lane >> 4, li = lane & 15, qq = li >> 2, pp = li & 3;
    const bf16_t* X2 = (const bf16_t*)(P.ws + OFF_XB); const float* DTf = (const float*)(P.ws + OFF_DT); const float* CUM = (const float*)(P.ws + OFF_CUM); float* ST = (float*)(P.ws + OFF_RB);
    ldsp Bl = lds, Xl = lds + 69632;
    for (int item = blockIdx.x; item < 256; item += gridDim.x) {
        const int b = item >> 6, c = (item >> 2) & 15, g = item & 3; const size_t rowbase = (size_t)b * 4096 + c * 256;
        __syncthreads();
#pragma unroll
        for (int k = 0; k < 8; ++k) { const int idx = tid + 512 * k, r = idx >> 4, ch = idx & 15; *(LAS u32x4*)(Bl + r * 272 + ch * 16) = *(const u32x4*)(X2 + (rowbase + r) * 3072 + 2048 + g * 128 + ch * 8); }
        for (int hh = 0; hh < 8; ++hh) { const int h = g * 8 + hh;
            __syncthreads();
            const float cl = CUM[(rowbase + 255) * 32 + h];
#pragma unroll
            for (int k = 0; k < 4; ++k) { const int idx = tid + 512 * k, r = idx >> 3, ch = idx & 7; const size_t row = rowbase + r;
                const float w = __expf(cl - CUM[row * 32 + h]) * DTf[row * 32 + h]; const u32x4 v = *(const u32x4*)(X2 + row * 3072 + h * 64 + ch * 8); u32x4 o;
                o.x = pk2(bf_lo(v.x) * w, bf_hi(v.x) * w); o.y = pk2(bf_lo(v.y) * w, bf_hi(v.y) * w); o.z = pk2(bf_lo(v.z) * w, bf_hi(v.z) * w); o.w = pk2(bf_lo(v.w) * w, bf_hi(v.w) * w);
                *(LAS u32x4*)(Xl + r * 160 + ch * 16) = o; }
            __syncthreads();
            f32x4 acc[4];
#pragma unroll
            for (int pt = 0; pt < 4; ++pt) acc[pt] = (f32x4){0.f, 0.f, 0.f, 0.f};
#pragma unroll
            for (int ks = 0; ks < 8; ++ks) { const int l0 = 32 * ks + 8 * quad + qq;
                const bf16x8 bop = cat8(vtr(Bl + l0 * 272 + (16 * wave + 4 * pp) * 2), vtr(Bl + (l0 + 4) * 272 + (16 * wave + 4 * pp) * 2));
#pragma unroll
                for (int pt = 0; pt < 4; ++pt) { const bf16x8 aop = cat8(vtr(Xl + l0 * 160 + (16 * pt + 4 * pp) * 2), vtr(Xl + (l0 + 4) * 160 + (16 * pt + 4 * pp) * 2)); acc[pt] = mfma16(aop, bop, acc[pt]); } }
            float* sp = ST + ((size_t)((b * 16 + c) * 32 + h) * 64) * 128 + 16 * wave + li;
#pragma unroll
            for (int pt = 0; pt < 4; ++pt)
#pragma unroll
                for (int j = 0; j < 4; ++j) sp[(size_t)(16 * pt + 4 * quad + j) * 128] = acc[pt][j];
        }
    }
}
__device__ __forceinline__ void ssd_b_phase(const Params& P) {
    const size_t gtid = (size_t)blockIdx.x * 512 + threadIdx.x, nth = (size_t)gridDim.x * 512;
    const float* ST = (const float*)(P.ws + OFF_RB); bf16_t* SIN = (bf16_t*)(P.ws + OFF_SIN); const float* CUM = (const float*)(P.ws + OFF_CUM);
    for (size_t it = gtid; it < (size_t)4 * 32 * 64 * 32; it += nth) {
        const int n4 = (int)(it & 31), p = (int)((it >> 5) & 63), h = (int)((it >> 11) & 31), b = (int)(it >> 16);
        f32x4 cur = (f32x4){0.f, 0.f, 0.f, 0.f};
#pragma unroll 4
        for (int c = 0; c < 16; ++c) { const size_t base = ((size_t)((b * 16 + c) * 32 + h) * 64 + p) * 128 + 4 * n4;
            u32x2 o; o.x = pk2(cur[0], cur[1]); o.y = pk2(cur[2], cur[3]); *(u32x2*)(SIN + base) = o;
            const float dec = __expf(CUM[((size_t)b * 4096 + c * 256 + 255) * 32 + h]); const f32x4 st = *(const f32x4*)(ST + base); cur = cur * dec + st; }
    }
}
__device__ __forceinline__ void ssd_c_phase(const Params& P, ldsp lds) {
    const int tid = threadIdx.x, wave = __builtin_amdgcn_readfirstlane(tid >> 6), lane = tid & 63, quad = lane >> 4, li = lane & 15, qq = li >> 2, pp = li & 3;
    const bf16_t* X2 = (const bf16_t*)(P.ws + OFF_XB); const float* DTf = (const float*)(P.ws + OFF_DT); const float* CUM = (const float*)(P.ws + OFF_CUM);
    const bf16_t* SIN = (const bf16_t*)(P.ws + OFF_SIN); float* SSQ = (float*)(P.ws + OFF_SSQ); bf16_t* A0 = (bf16_t*)P.out;
    ldsp Bl = lds, Xl = lds + 69632, Sl = lds + 110592; LAS float* cuml = (LAS float*)(lds + 128000); LAS float* dtl = cuml + 256;
    for (int item = blockIdx.x; item < 256; item += gridDim.x) {
        const int b = item >> 6, c = (item >> 2) & 15, g = item & 3; const size_t rowbase = (size_t)b * 4096 + c * 256;
        __syncthreads();
#pragma unroll
        for (int k = 0; k < 8; ++k) { const int idx = tid + 512 * k, r = idx >> 4, ch = idx & 15; *(LAS u32x4*)(Bl + r * 272 + ch * 16) = *(const u32x4*)(X2 + (rowbase + r) * 3072 + 2048 + g * 128 + ch * 8); }
        bf16x8 qf[2][4];
#pragma unroll
        for (int nt = 0; nt < 2; ++nt)
#pragma unroll
            for (int ks = 0; ks < 4; ++ks) qf[nt][ks] = *(const bf16x8*)(X2 + (rowbase + 32 * wave + 16 * nt + li) * 3072 + 2560 + g * 128 + 32 * ks + 8 * quad);
        for (int hh = 0; hh < 8; ++hh) { const int h = g * 8 + hh;
            __syncthreads();
#pragma unroll
            for (int k = 0; k < 4; ++k) { const int idx = tid + 512 * k, r = idx >> 3, ch = idx & 7; *(LAS u32x4*)(Xl + r * 160 + ch * 16) = *(const u32x4*)(X2 + (rowbase + r) * 3072 + h * 64 + ch * 8); }
#pragma unroll
            for (int k = 0; k < 2; ++k) { const int idx = tid + 512 * k, r = idx >> 4, ch = idx & 15; *(LAS u32x4*)(Sl + r * 272 + ch * 16) = *(const u32x4*)(SIN + ((size_t)((b * 16 + c) * 32 + h) * 64 + r) * 128 + ch * 8); }
            if (tid < 256) { cuml[tid] = CUM[(rowbase + tid) * 32 + h]; dtl[tid] = DTf[(rowbase + tid) * 32 + h]; }
            __syncthreads();
            f32x4 oacc[2][4];
#pragma unroll
            for (int nt = 0; nt < 2; ++nt)
#pragma unroll
                for (int pt = 0; pt < 4; ++pt) oacc[nt][pt] = (f32x4){0.f, 0.f, 0.f, 0.f};
#pragma unroll
            for (int pt = 0; pt < 4; ++pt)
#pragma unroll
                for (int ks = 0; ks < 4; ++ks) { const bf16x8 a = *(const LAS bf16x8*)(Sl + (16 * pt + li) * 272 + (32 * ks + 8 * quad) * 2);
                    oacc[0][pt] = mfma16(a, qf[0][ks], oacc[0][pt]); oacc[1][pt] = mfma16(a, qf[1][ks], oacc[1][pt]); }
            int lq[2]; float cq[2];
#pragma unroll
            for (int nt = 0; nt < 2; ++nt) { lq[nt] = 32 * wave + 16 * nt + li; cq[nt] = cuml[lq[nt]]; const float e = __expf(cq[nt]);
#pragma unroll
                for (int pt = 0; pt < 4; ++pt) oacc[nt][pt] *= e; }
            const int nkt = (32 * wave + 31) / 64 + 1;
#pragma unroll 1
            for (int kt = 0; kt < nkt; ++kt) {
                {
                    f32x4 sacc[2][4];
#pragma unroll
                    for (int nt = 0; nt < 2; ++nt)
#pragma unroll
                        for (int mt = 0; mt < 4; ++mt) sacc[nt][mt] = (f32x4){0.f, 0.f, 0.f, 0.f};
#pragma unroll
                    for (int mt = 0; mt < 4; ++mt)
#pragma unroll
                        for (int ks = 0; ks < 4; ++ks) { const bf16x8 a = *(const LAS bf16x8*)(Bl + (64 * kt + 16 * mt + li) * 272 + (32 * ks + 8 * quad) * 2);
                            sacc[0][mt] = mfma16(a, qf[0][ks], sacc[0][mt]); sacc[1][mt] = mfma16(a, qf[1][ks], sacc[1][mt]); }
#pragma unroll
                    for (int mt = 0; mt < 4; ++mt) { const int s0 = 64 * kt + 16 * mt + 4 * quad; const f32x4 cs = *(const LAS f32x4*)(cuml + s0), ds = *(const LAS f32x4*)(dtl + s0);
#pragma unroll
                        for (int nt = 0; nt < 2; ++nt)
#pragma unroll
                            for (int j = 0; j < 4; ++j) { const float v = sacc[nt][mt][j] * __expf(cq[nt] - cs[j]) * ds[j]; sacc[nt][mt][j] = (s0 + j <= lq[nt]) ? v : 0.f; } }
                    bf16x8 pb[2][2];
#pragma unroll
                    for (int nt = 0; nt < 2; ++nt)
#pragma unroll
                        for (int kk = 0; kk < 2; ++kk) { u32x4 t; t.x = pk2(sacc[nt][2 * kk][0], sacc[nt][2 * kk][1]); t.y = pk2(sacc[nt][2 * kk][2], sacc[nt][2 * kk][3]);
                            t.z = pk2(sacc[nt][2 * kk + 1][0], sacc[nt][2 * kk + 1][1]); t.w = pk2(sacc[nt][2 * kk + 1][2], sacc[nt][2 * kk + 1][3]); pb[nt][kk] = __builtin_bit_cast(bf16x8, t); }
#pragma unroll
                    for (int pt = 0; pt < 4; ++pt)
#pragma unroll
                        for (int kk = 0; kk < 2; ++kk) { const int r0 = 64 * kt + 32 * kk + 4 * quad + qq;
                            const bf16x8 a = cat8(vtr(Xl + r0 * 160 + (16 * pt + 4 * pp) * 2), vtr(Xl + (r0 + 16) * 160 + (16 * pt + 4 * pp) * 2));
                            oacc[0][pt] = mfma16(a, pb[0][kk], oacc[0][pt]); oacc[1][pt] = mfma16(a, pb[1][kk], oacc[1][pt]); }
                }
            }
            const float Dh = P.ssd_d[h];
#pragma unroll
            for (int nt = 0; nt < 2; ++nt) { const size_t row = rowbase + lq[nt]; float ss = 0.f;
#pragma unroll
                for (int pt = 0; pt < 4; ++pt) { const int col = h * 64 + 16 * pt + 4 * quad; const u32x2 xs = *(const u32x2*)(X2 + row * 3072 + col); const u32x2 z = *(const u32x2*)(A0 + row * 4096 + col);
                    const float t0 = (oacc[nt][pt][0] + Dh * bf_lo(xs.x)) * silu_f(bf_lo(z.x)), t1 = (oacc[nt][pt][1] + Dh * bf_hi(xs.x)) * silu_f(bf_hi(z.x));
                    const float t2 = (oacc[nt][pt][2] + Dh * bf_lo(xs.y)) * silu_f(bf_lo(z.y)), t3 = (oacc[nt][pt][3] + Dh * bf_hi(xs.y)) * silu_f(bf_hi(z.y));
                    ss += (t0 * t0 + t1 * t1) + (t2 * t2 + t3 * t3); u32x2 o; o.x = pk2(t0, t1); o.y = pk2(t2, t3); *(u32x2*)(A0 + row * 4096 + col) = o; }
                ss += __shfl_xor(ss, 16); ss += __shfl_xor(ss, 32);
                if (quad == 0) SSQ[row * 32 + h] = ss; }
        }
    }
}

__device__ __forceinline__ void moba_phase(const Params& P, ldsp lds, bf16_t* obase, int old_, unsigned rmask) {
    const int tid = threadIdx.x, wave = __builtin_amdgcn_readfirstlane(tid >> 6), lane = tid & 63, quad = lane >> 4, li = lane & 15, qq = li >> 2, pp = li & 3;
    bf16_t* A0 = (bf16_t*)P.out; const bf16_t* Kb = (const bf16_t*)(P.ws + OFF_K); const bf16_t* Vb = (const bf16_t*)(P.ws + OFF_V); const bf16_t* Gb = (const bf16_t*)(P.ws + OFF_G);
    const float* kmean = (const float*)(P.ws + OFF_KM);
    ldsp Kl = lds, Vl = lds + 34816; LAS float* gl = (LAS float*)(lds + 71680); LAS float* kml = (LAS float*)(lds + 89088); LAS unsigned* selm = (LAS unsigned*)(lds + 97280);
    const float c2 = 0.08838834764831845f * 1.4426950408889634f;
    const int G = gridDim.x, cb = blockIdx.x;
    const int sr = tid >> 4, sc = tid & 15;
    for (int kr = 0; kr * G < 1024; ++kr) {
        const int idx = (kr & 1) ? (kr * G + G - 1 - cb) : (kr * G + cb);
        if (idx >= 1024) continue;
        const int i = 15 - (idx >> 6), b = (idx & 63) >> 4, h = idx & 15;
        const size_t qrow0 = (size_t)b * 4096 + i * 256;
        __syncthreads();
        { const float* kq = kmean + (size_t)((b * 16 + h) * 16) * 128 + tid * 4; f32x4 v = *(const f32x4*)kq + *(const f32x4*)(kq + 131072); v *= (1.f / 256.f); *(LAS f32x4*)(kml + tid * 4) = v; }
        __syncthreads();
        { const int r = tid >> 1, hf = tid & 1; const bf16_t* qp = A0 + (qrow0 + r) * 4096 + 2048 + h * 128; float gs[8];
#pragma unroll
          for (int jb = 0; jb < 8; ++jb) gs[jb] = 0.f;
#pragma unroll 2
          for (int dc = 0; dc < 16; ++dc) { const u32x4 qv = *(const u32x4*)(qp + dc * 8);
              const float q0 = bf_lo(qv.x), q1 = bf_hi(qv.x), q2 = bf_lo(qv.y), q3 = bf_hi(qv.y), q4 = bf_lo(qv.z), q5 = bf_hi(qv.z), q6 = bf_lo(qv.w), q7 = bf_hi(qv.w);
#pragma unroll
              for (int jb = 0; jb < 8; ++jb) { const LAS float* kp = kml + (hf * 8 + jb) * 128 + dc * 8; const f32x4 k0 = *(const LAS f32x4*)kp, k1 = *(const LAS f32x4*)(kp + 4);
                  gs[jb] += (q0 * k0[0] + q1 * k0[1]) + (q2 * k0[2] + q3 * k0[3]) + (q4 * k1[0] + q5 * k1[1]) + (q6 * k1[2] + q7 * k1[3]); } }
#pragma unroll
          for (int jb = 0; jb < 8; ++jb) gl[r * 17 + hf * 8 + jb] = gs[jb]; }
        __syncthreads();
        if (tid < 256) { unsigned mask = 0u; const int nsel = i < 3 ? i : 3;
            for (int s = 0; s < nsel; ++s) { float best = -INFINITY; int bj = -1;
                for (int j = 0; j < i; ++j) { const float v = gl[tid * 17 + j]; if (!((mask >> j) & 1u) && v > best) { best = v; bj = j; } }
                if (bj >= 0) mask |= 1u << bj; }
            selm[tid] = mask; }
        bf16x8 qf[2][4];
#pragma unroll
        for (int nt = 0; nt < 2; ++nt)
#pragma unroll
            for (int ks = 0; ks < 4; ++ks) qf[nt][ks] = *(const bf16x8*)(A0 + (qrow0 + 32 * wave + 16 * nt + li) * 4096 + 2048 + h * 128 + 32 * ks + 8 * quad);
        const int ntile = 4 * (i + 1);
        u32x4 kreg[2], vreg[2];
        { const size_t kr0 = (qrow0 + sr) * 2048 + h * 128 + sc * 8;
          kreg[0] = *(const u32x4*)(Kb + kr0); kreg[1] = *(const u32x4*)(Kb + kr0 + 32 * 2048); vreg[0] = *(const u32x4*)(Vb + kr0); vreg[1] = *(const u32x4*)(Vb + kr0 + 32 * 2048); }
        *(LAS u32x4*)(Kl + sr * 272 + sc * 16) = kreg[0]; *(LAS u32x4*)(Kl + (sr + 32) * 272 + sc * 16) = kreg[1];
        *(LAS u32x4*)(Vl + sr * 288 + sc * 16) = vreg[0]; *(LAS u32x4*)(Vl + (sr + 32) * 288 + sc * 16) = vreg[1];
        __syncthreads();
        unsigned sel[2]; float mrun[2], lrun[2]; f32x4 oacc[2][8];
#pragma unroll
        for (int nt = 0; nt < 2; ++nt) { sel[nt] = selm[32 * wave + 16 * nt + li]; mrun[nt] = -1e30f; lrun[nt] = 0.f;
#pragma unroll
            for (int dt = 0; dt < 8; ++dt) oacc[nt][dt] = (f32x4){0.f, 0.f, 0.f, 0.f}; }
        for (int tt = 0; tt < ntile; ++tt) {
            const int buf = tt & 1;
            u32x4 kn0, kn1, vn0, vn1;
            { const int t1 = (tt + 1 < ntile) ? tt + 1 : tt; const int jb = (t1 < 4) ? i : (t1 >> 2) - 1; const int kt1 = t1 & 3;
                const size_t kr0 = ((size_t)b * 4096 + jb * 256 + kt1 * 64 + sr) * 2048 + h * 128 + sc * 8;
                kn0 = *(const u32x4*)(Kb + kr0); kn1 = *(const u32x4*)(Kb + kr0 + 32 * 2048); vn0 = *(const u32x4*)(Vb + kr0); vn1 = *(const u32x4*)(Vb + kr0 + 32 * 2048); }
            const bool own = tt < 4; const int kt = tt & 3; const int jblk = own ? i : (tt >> 2) - 1;
            bool active;
            if (own) active = (64 * kt <= 32 * wave + 31); else active = __any((int)(((sel[0] | sel[1]) >> jblk) & 1u)) != 0;
            if (active) {
                ldsp Kt = Kl + buf * 17408; ldsp Vt = Vl + buf * 18432;
                f32x4 sacc[2][4];
#pragma unroll
                for (int nt = 0; nt < 2; ++nt)
#pragma unroll
                    for (int mt = 0; mt < 4; ++mt) sacc[nt][mt] = (f32x4){0.f, 0.f, 0.f, 0.f};
                { bf16x8 kf[2][4];
#pragma unroll
                  for (int ks = 0; ks < 4; ++ks) kf[0][ks] = *(const LAS bf16x8*)(Kt + li * 272 + (32 * ks + 8 * quad) * 2);
#pragma unroll
                  for (int mt = 0; mt < 4; ++mt) {
                      if (mt < 3) {
#pragma unroll
                          for (int ks = 0; ks < 4; ++ks) kf[(mt + 1) & 1][ks] = *(const LAS bf16x8*)(Kt + (16 * (mt + 1) + li) * 272 + (32 * ks + 8 * quad) * 2); }
                      __builtin_amdgcn_sched_barrier(0);
#pragma unroll
                      for (int ks = 0; ks < 4; ++ks) { sacc[0][mt] = mfma16(kf[mt & 1][ks], qf[0][ks], sacc[0][mt]); sacc[1][mt] = mfma16(kf[mt & 1][ks], qf[1][ks], sacc[1][mt]); }
                      __builtin_amdgcn_sched_barrier(0);
                  } }
                bf16x8 pb[2][2];
#pragma unroll
                for (int nt = 0; nt < 2; ++nt) { const int qpos = 32 * wave + 16 * nt + li; const bool selj = ((sel[nt] >> jblk) & 1u) != 0u; float alpha, ps = 0.f;
                    if (own) {
                        float mx = -1e30f;
#pragma unroll
                        for (int mt = 0; mt < 4; ++mt)
#pragma unroll
                            for (int j = 0; j < 4; ++j) { const int kpos = 64 * kt + 16 * mt + 4 * quad + j;
                                const float s = (kpos <= qpos) ? sacc[nt][mt][j] * c2 : -1e30f; sacc[nt][mt][j] = s; mx = fmaxf(mx, s); }
                        mx = fmaxf(mx, __shfl_xor(mx, 16)); mx = fmaxf(mx, __shfl_xor(mx, 32));
                        const float mnew = fmaxf(mrun[nt], mx); alpha = __builtin_amdgcn_exp2f(mrun[nt] - mnew); mrun[nt] = mnew;
#pragma unroll
                        for (int mt = 0; mt < 4; ++mt)
#pragma unroll
                            for (int j = 0; j < 4; ++j) { const float p = __builtin_amdgcn_exp2f(sacc[nt][mt][j] - mnew); sacc[nt][mt][j] = p; ps += p; }
                    } else {
                        const float bias = selj ? 0.f : -1e30f; float mx = sacc[nt][0][0];
#pragma unroll
                        for (int mt = 0; mt < 4; ++mt)
#pragma unroll
                            for (int j = 0; j < 4; ++j) mx = fmaxf(mx, sacc[nt][mt][j]);
                        mx = fmaxf(mx, __shfl_xor(mx, 16)); mx = fmaxf(mx, __shfl_xor(mx, 32));
                        const float mnew = fmaxf(mrun[nt], fmaf(mx, c2, bias)); alpha = __builtin_amdgcn_exp2f(mrun[nt] - mnew); mrun[nt] = mnew; const float nb = bias - mnew;
#pragma unroll
                        for (int mt = 0; mt < 4; ++mt)
#pragma unroll
                            for (int j = 0; j < 4; ++j) { const float p = __builtin_amdgcn_exp2f(fmaf(sacc[nt][mt][j], c2, nb)); sacc[nt][mt][j] = p; ps += p; }
                    }
                    lrun[nt] = lrun[nt] * alpha + ps;
#pragma unroll
                    for (int dt = 0; dt < 8; ++dt) oacc[nt][dt] *= alpha;
#pragma unroll
                    for (int kk = 0; kk < 2; ++kk) { u32x4 t; t.x = pk2(sacc[nt][2 * kk][0], sacc[nt][2 * kk][1]); t.y = pk2(sacc[nt][2 * kk][2], sacc[nt][2 * kk][3]);
                        t.z = pk2(sacc[nt][2 * kk + 1][0], sacc[nt][2 * kk + 1][1]); t.w = pk2(sacc[nt][2 * kk + 1][2], sacc[nt][2 * kk + 1][3]); pb[nt][kk] = __builtin_bit_cast(bf16x8, t); }
                }
                { bf16x8 vf[2][2]; const ldsp vbase = Vt + (4 * quad + qq) * 288 + 8 * pp;
#pragma unroll
                  for (int kk = 0; kk < 2; ++kk) vf[0][kk] = cat8(vtr(vbase + (32 * kk) * 288), vtr(vbase + (32 * kk + 16) * 288));
#pragma unroll
                  for (int dt = 0; dt < 8; ++dt) {
                      if (dt < 7) {
#pragma unroll
                          for (int kk = 0; kk < 2; ++kk) vf[(dt + 1) & 1][kk] = cat8(vtr(vbase + (32 * kk) * 288 + 32 * (dt + 1)), vtr(vbase + (32 * kk + 16) * 288 + 32 * (dt + 1))); }
                      __builtin_amdgcn_sched_barrier(0);
#pragma unroll
                      for (int kk = 0; kk < 2; ++kk) { oacc[0][dt] = mfma16(vf[dt & 1][kk], pb[0][kk], oacc[0][dt]); oacc[1][dt] = mfma16(vf[dt & 1][kk], pb[1][kk], oacc[1][dt]); }
                      __builtin_amdgcn_sched_barrier(0);
                  } }
            }
            { ldsp Kn = Kl + (buf ^ 1) * 17408; ldsp Vn = Vl + (buf ^ 1) * 18432;
                *(LAS u32x4*)(Kn + sr * 272 + sc * 16) = kn0; *(LAS u32x4*)(Kn + (sr + 32) * 272 + sc * 16) = kn1;
                *(LAS u32x4*)(Vn + sr * 288 + sc * 16) = vn0; *(LAS u32x4*)(Vn + (sr + 32) * 288 + sc * 16) = vn1; }
            __syncthreads();
        }
#pragma unroll
        for (int nt = 0; nt < 2; ++nt) { float l = lrun[nt]; l += __shfl_xor(l, 16); l += __shfl_xor(l, 32); const float inv = 1.f / l; const size_t row = qrow0 + 32 * wave + 16 * nt + li;
#pragma unroll
            for (int dt = 0; dt < 8; ++dt) { const int col = h * 128 + 16 * dt + 4 * quad; const u32x2 gv = *(const u32x2*)(Gb + row * 2048 + col);
                u32x2 o; o.x = pk2(oacc[nt][dt][0] * inv * bf_lo(gv.x), oacc[nt][dt][1] * inv * bf_hi(gv.x)); o.y = pk2(oacc[nt][dt][2] * inv * bf_lo(gv.y), oacc[nt][dt][3] * inv * bf_hi(gv.y));
                *(u32x2*)(obase + (size_t)((unsigned)row & rmask) * old_ + col) = o; } }
    }
}

__device__ __forceinline__ void ln_phase(const float* Y, const float* g, const float* bta, float* outf, bf16_t* outb, int ldb_) {
    const int lane = threadIdx.x & 63; const int gw = blockIdx.x * 8 + __builtin_amdgcn_readfirstlane(threadIdx.x >> 6), NGW = gridDim.x * 8;
    f32x4 gv[8], bv[8];
#pragma unroll
    for (int k = 0; k < 8; ++k) { gv[k] = ((const f32x4*)g)[lane + 64 * k]; bv[k] = ((const f32x4*)bta)[lane + 64 * k]; }
    for (int row = gw; row < M; row += NGW) { const f32x4* yr = (const f32x4*)(Y + (size_t)row * 2048); f32x4 v[8]; float s = 0.f;
#pragma unroll
        for (int k = 0; k < 8; ++k) { v[k] = yr[lane + 64 * k]; s += (v[k][0] + v[k][1]) + (v[k][2] + v[k][3]); }
#pragma unroll
        for (int o = 1; o < 64; o <<= 1) s += __shfl_xor(s, o);
        const float mu = s * (1.f / 2048.f); float s2 = 0.f;
#pragma unroll
        for (int k = 0; k < 8; ++k) { v[k] = v[k] - mu; s2 += (v[k][0] * v[k][0] + v[k][1] * v[k][1]) + (v[k][2] * v[k][2] + v[k][3] * v[k][3]); }
#pragma unroll
        for (int o = 1; o < 64; o <<= 1) s2 += __shfl_xor(s2, o);
        const float rstd = rsqrtf(s2 * (1.f / 2048.f) + 1e-5f);
#pragma unroll
        for (int k = 0; k < 8; ++k) { const f32x4 o = v[k] * rstd * gv[k] + bv[k]; ((f32x4*)(outf + (size_t)row * 2048))[lane + 64 * k] = o;
            if (outb) { u32x2 ob; ob.x = pk2(o[0], o[1]); ob.y = pk2(o[2], o[3]); ((u32x2*)(outb + (size_t)row * ldb_))[lane + 64 * k] = ob; } }
    }
}

__device__ __forceinline__ void s5_phase(const Params& P, ldsp lds) {
    const int tid = threadIdx.x, wave = __builtin_amdgcn_readfirstlane(tid >> 6), lane = tid & 63, quad = lane >> 4, li = lane & 15, qq = li >> 2, pp = li & 3;
    const bf16_t* U = (const bf16_t*)(P.ws + OFF_K); bf16_t* YG = (bf16_t*)(P.ws + OFF_RB);
    const int sq = wave >> 2, role = (wave + 2 * sq) & 3;
    ldsp BUl = lds + sq * 32768; ldsp Hl = lds + sq * 32768 + 20480; ldsp Rl = lds + 65536 + sq * 8192;
    for (int it0 = blockIdx.x; it0 < 256; it0 += gridDim.x) {
        const int item = it0 + 256 * sq;
        const int b = item >> 7, g = item & 127;
        const float dtg = expf(P.log_dt[g]);
        float lbr = 0.f, lbi = 0.f; bf16x8 bbf[8], cmf[4]; f32x4 dsk = (f32x4){0.f, 0.f, 0.f, 0.f};
        if (role == 1) { const float lr = P.lam_re[g * 64 + lane], lim = P.lam_im[g * 64 + lane]; const float e = expf(lr * dtg); float s_, c_; sincos_d((double)(lim * dtg), s_, c_); lbr = e * c_; lbi = e * s_; }
        if (role == 0) {
            float lr4[4], li4[4]; f32x4 brr[4][2], bir[4][2];
#pragma unroll
            for (int q = 0; q < 4; ++q) { const int n = 16 * q + li; lr4[q] = P.lam_re[g * 64 + n]; li4[q] = P.lam_im[g * 64 + n];
                const float* br = P.b_re + ((size_t)(g * 64 + n)) * 16 + 8 * (quad & 1); const float* bi = P.b_im + ((size_t)(g * 64 + n)) * 16 + 8 * (quad & 1);
                brr[q][0] = *(const f32x4*)br; brr[q][1] = *(const f32x4*)(br + 4); bir[q][0] = *(const f32x4*)bi; bir[q][1] = *(const f32x4*)(bi + 4); }
#pragma unroll
            for (int q = 0; q < 4; ++q) { const float lr = lr4[q], lim = li4[q]; const float e = expf(lr * dtg); float s_, c_; sincos_d((double)(lim * dtg), s_, c_);
                const float ar = e * c_ - 1.f, aim = e * s_; const float den = 1.f / (lr * lr + lim * lim); const float cr = (ar * lr + aim * lim) * den, ci = (aim * lr - ar * lim) * den;
                float ore[8], oim[8];
#pragma unroll
                for (int e2 = 0; e2 < 8; ++e2) { const float xr = brr[q][e2 >> 2][e2 & 3], xi = bir[q][e2 >> 2][e2 & 3]; ore[e2] = cr * xr - ci * xi; oim[e2] = cr * xi + ci * xr; }
                u32x4 tr_ = (u32x4){0u, 0u, 0u, 0u}, ti_ = (u32x4){0u, 0u, 0u, 0u};
                if (quad < 2) { tr_.x = pk2(ore[0], ore[1]); tr_.y = pk2(ore[2], ore[3]); tr_.z = pk2(ore[4], ore[5]); tr_.w = pk2(ore[6], ore[7]);
                                ti_.x = pk2(oim[0], oim[1]); ti_.y = pk2(oim[2], oim[3]); ti_.z = pk2(oim[4], oim[5]); ti_.w = pk2(oim[6], oim[7]); }
                bbf[q] = __builtin_bit_cast(bf16x8, tr_); bbf[q + 4] = __builtin_bit_cast(bf16x8, ti_); }
        }
        if (role == 2) {
            f32x4 cr_[4][2];
#pragma unroll
            for (int ks = 0; ks < 4; ++ks) { const float* cp = (ks < 2 ? P.c_re : P.c_im) + ((size_t)(g * 16 + li)) * 64 + 32 * (ks & 1) + 8 * quad; cr_[ks][0] = *(const f32x4*)cp; cr_[ks][1] = *(const f32x4*)(cp + 4); }
            dsk = *(const f32x4*)(P.s5_d + g * 16 + 4 * quad);
#pragma unroll
            for (int ks = 0; ks < 4; ++ks) { const float sg = ks < 2 ? 1.f : -1.f; const f32x4 a_ = cr_[ks][0] * sg, b_ = cr_[ks][1] * sg;
                u32x4 t; t.x = pk2(a_[0], a_[1]); t.y = pk2(a_[2], a_[3]); t.z = pk2(b_[0], b_[1]); t.w = pk2(b_[2], b_[3]); cmf[ks] = __builtin_bit_cast(bf16x8, t); }
        }
        const bf16_t* ub = U + ((size_t)b * 4096) * 2048 + g * 16;
        bf16_t* yb = YG + ((size_t)b * 4096) * 2048 + g * 16;
        float hr = 0.f, hi = 0.f;
#define S5_BAR() do { asm volatile("s_waitcnt lgkmcnt(0)" ::: "memory"); __builtin_amdgcn_s_barrier(); asm volatile("" ::: "memory"); } while (0)
#define S5_DMA(st) __builtin_amdgcn_global_load_lds((const unsigned*)(ub + (size_t)((st) * 16 + li) * 2048 + 8 * (quad & 1)), (LAS unsigned*)(Rl + ((st) & 7) * 1024), 16, 0, 0)
        if (role == 3) {
            S5_DMA(0); S5_DMA(1); S5_DMA(2); S5_DMA(3);
            asm volatile("s_waitcnt vmcnt(0)" ::: "memory"); S5_BAR();
            for (int s = -1; s <= 256; ++s) { if (s + 5 < 256) S5_DMA(s + 5); asm volatile("s_waitcnt vmcnt(2)" ::: "memory"); S5_BAR(); }
        } else if (role == 0) {
            S5_BAR();
            for (int s = -1; s <= 256; ++s) {
                if (s + 1 < 256) { u32x4 areg = *(const LAS u32x4*)(Rl + ((s + 1) & 7) * 1024 + lane * 16); if (quad >= 2) areg = (u32x4){0u, 0u, 0u, 0u};
                    const bf16x8 a_ = __builtin_bit_cast(bf16x8, areg); ldsp bw_ = BUl + ((s + 1) & 1) * 10240;
#pragma unroll
                    for (int tile = 0; tile < 8; ++tile) { const f32x4 bu = mfma16(a_, bbf[tile], (f32x4){0.f, 0.f, 0.f, 0.f}); *(LAS f32x4*)(bw_ + (16 * tile + li) * 80 + 16 * quad) = bu; } }
                S5_BAR(); }
        } else if (role == 1) {
            S5_BAR();
            for (int s = -1; s <= 256; ++s) {
                if (s >= 0 && s < 256) { f32x4 br[4], bi[4]; ldsp br_ = BUl + (s & 1) * 10240;
#pragma unroll
                    for (int q = 0; q < 4; ++q) { br[q] = *(const LAS f32x4*)(br_ + lane * 80 + 16 * q); bi[q] = *(const LAS f32x4*)(br_ + (64 + lane) * 80 + 16 * q); }
                    float hrs[16], his[16];
#pragma unroll
                    for (int t = 0; t < 16; ++t) { const float nr = lbr * hr - lbi * hi + br[t >> 2][t & 3], ni = lbr * hi + lbi * hr + bi[t >> 2][t & 3]; hr = nr; hi = ni; hrs[t] = hr; his[t] = hi; }
                    ldsp hw_ = Hl + (s & 1) * 6144;
#pragma unroll
                    for (int q = 0; q < 2; ++q) { u32x4 wr_, wi_;
                        wr_.x = pk2(hrs[8 * q + 0], hrs[8 * q + 1]); wr_.y = pk2(hrs[8 * q + 2], hrs[8 * q + 3]); wr_.z = pk2(hrs[8 * q + 4], hrs[8 * q + 5]); wr_.w = pk2(hrs[8 * q + 6], hrs[8 * q + 7]);
                        wi_.x = pk2(his[8 * q + 0], his[8 * q + 1]); wi_.y = pk2(his[8 * q + 2], his[8 * q + 3]); wi_.z = pk2(his[8 * q + 4], his[8 * q + 5]); wi_.w = pk2(his[8 * q + 6], his[8 * q + 7]);
                        *(LAS u32x4*)(hw_ + lane * 48 + 16 * q) = wr_; *(LAS u32x4*)(hw_ + (64 + lane) * 48 + 16 * q) = wi_; } }
                S5_BAR(); }
        } else {
            S5_BAR();
            for (int s = -1; s <= 256; ++s) {
                if (s >= 1) { const u32x2 uu = *(const LAS u32x2*)(Rl + ((s - 1) & 7) * 1024 + (li + 16 * (quad >> 1)) * 16 + 8 * (quad & 1));
                    ldsp hp_ = Hl + ((s - 1) & 1) * 6144; f32x4 yacc = (f32x4){0.f, 0.f, 0.f, 0.f};
#pragma unroll
                    for (int ks = 0; ks < 4; ++ks) { const int r0 = 32 * ks + 8 * quad + qq; const bf16x8 bop = cat8(vtr(hp_ + r0 * 48 + 8 * pp), vtr(hp_ + (r0 + 4) * 48 + 8 * pp)); yacc = mfma16(cmf[ks], bop, yacc); }
                    const float y0 = yacc[0] + dsk[0] * bf_lo(uu.x), y1 = yacc[1] + dsk[1] * bf_hi(uu.x), y2 = yacc[2] + dsk[2] * bf_lo(uu.y), y3 = yacc[3] + dsk[3] * bf_hi(uu.y);
                    u32x2 o; o.x = pk2(gelu_tanh_f(y0), gelu_tanh_f(y1)); o.y = pk2(gelu_tanh_f(y2), gelu_tanh_f(y3)); *(u32x2*)(yb + (size_t)((s - 1) * 16 + li) * 2048 + 4 * quad) = o; }
                S5_BAR(); }
        }
#undef S5_BAR
#undef S5_DMA
        asm volatile("s_waitcnt vmcnt(0) lgkmcnt(0)" ::: "memory"); __syncthreads();
    }
}

template <class Epi> __device__ __forceinline__ void run_gemm(ldsp lds, const bf16_t* A, int lda, const bf16_t* Bt, int ldb, int N, int K, const Epi& E) {
    pg8::Gemm g; g.A = A; g.Bt = Bt; g.M = M; g.N = N; g.K = K; g.lda = lda; g.ldb = ldb; g.alias_a = 0;
    pg8::StaticOrder S; S.init(M, N, (int)gridDim.x, (int)blockIdx.x);
#if GEMM_SKEW_TICKS > 0
    {
      const unsigned sk = (unsigned)GEMM_SKEW_TICKS * (((blockIdx.x >> 3) & 7u) + ((blockIdx.x >> 6) & 3u));
      if (threadIdx.x == 0) { const unsigned long long t0 = __builtin_amdgcn_s_memrealtime(); while (__builtin_amdgcn_s_memrealtime() - t0 < sk) __builtin_amdgcn_s_sleep(8); }
      __syncthreads(); }
#endif
    pg8::gemm_phase<Epi, pg8::StaticOrder, false>(lds, g, S, E, nullptr);
}

__device__ __forceinline__ void gsync(cg::grid_group& grid) {
    asm volatile("s_waitcnt vmcnt(0) lgkmcnt(0)" ::: "memory");
    __syncthreads();
    if (threadIdx.x < 64) { __builtin_amdgcn_fence(__ATOMIC_RELEASE, "agent"); asm volatile("s_waitcnt vmcnt(0)" ::: "memory"); }
    grid.sync();
#if GSYNC_WAVE_ACQ
    __builtin_amdgcn_fence(__ATOMIC_ACQUIRE, ""); asm volatile("s_waitcnt vmcnt(0)" ::: "memory");
#else
    if (threadIdx.x < 64) { __builtin_amdgcn_fence(__ATOMIC_ACQUIRE, "agent"); asm volatile("s_waitcnt vmcnt(0)" ::: "memory"); }
#endif
    __syncthreads();
}
#ifndef REP_P0
#define REP_P0 1
#endif
#ifndef REP_IN0
#define REP_IN0 1
#endif
#ifndef REP_CONV
#define REP_CONV 1
#endif
#ifndef REP_MOBA_DUMMY
#define REP_MOBA_DUMMY 0
#endif
#ifndef REP_SSDA
#define REP_SSDA 1
#endif
#ifndef REP_SSDB
#define REP_SSDB 1
#endif
#ifndef REP_LN0
#define REP_LN0 1
#endif
#ifndef REP_IN1
#define REP_IN1 1
#endif
#ifndef REP_S5
#define REP_S5 1
#endif
#ifndef PHASE_MASK
#define PHASE_MASK 0x3fff
#endif
#if defined(__HIP_DEVICE_COMPILE__)
#define GETP() ({ const __attribute__((address_space(4))) Params* kp_ = (const __attribute__((address_space(4))) Params*)__builtin_amdgcn_kernarg_segment_ptr(); asm volatile("" : "+s"(kp_)); *kp_; })
#else
#define GETP() (P_unused)
#endif
__global__ void __launch_bounds__(512, 2) mega_fwd(Params P_unused) {
    constexpr int PM = PHASE_MASK;
    extern __shared__ __attribute__((aligned(16))) unsigned char shm[];
    ldsp lds = (ldsp)shm;
    cg::grid_group grid = cg::this_grid();
    for (int rep = 0; rep < REP_P0; ++rep) { const Params P = GETP(); p0_phase(P, lds); }
    gsync(grid);
    for (int rep = 0; rep < REP_IN0; ++rep) { const Params P = GETP(); unsigned char* ws = P.ws;
      EpiIn0 E; E.A0 = (bf16_t*)P.out; E.XBCraw = (bf16_t*)(ws + OFF_RB); E.Kb = (bf16_t*)(ws + OFF_K); E.Vb = (bf16_t*)(ws + OFF_V); E.Gb = (bf16_t*)(ws + OFF_G);
      E.DTf = (float*)(ws + OFF_DT); E.kmean = (float*)(ws + OFF_KM); E.ctab = (const float*)(ws + OFF_CT); E.stab = (const float*)(ws + OFF_STB); E.dt_bias = P.dt_bias;
      run_gemm(lds, (const bf16_t*)(ws + OFF_XB), 2048, (const bf16_t*)(ws + OFF_W0T), 2048, N0P, 2048, E); }
    gsync(grid);
    for (int rep = 0; rep < REP_CONV; ++rep) { const Params P = GETP(); conv_phase(P); }
    gsync(grid);
    for (int rep = 0; rep < REP_MOBA_DUMMY; ++rep) { const Params P = GETP(); moba_phase(P, lds, (bf16_t*)(P.ws + WS_END), 2048, 4095u); }
    if (PM & 8) { const Params P = GETP(); moba_phase(P, lds, (bf16_t*)P.out + 2048, 4096, 0xffffffffu); }
    for (int rep = 0; rep < REP_SSDA; ++rep) { const Params P = GETP(); ssd_a_phase(P, lds); }
    gsync(grid);
    for (int rep = 0; rep < REP_SSDB; ++rep) { const Params P = GETP(); ssd_b_phase(P); }
    gsync(grid);
    if (PM & 64) { const Params P = GETP(); ssd_c_phase(P, lds); }
    gsync(grid);
    if (PM & 128) { const Params P = GETP(); unsigned char* ws = P.ws;
      EpiOut<32> E; E.resid = P.x; E.Y = (float*)(ws + OFF_K); E.rsl = (const LAS float*)(lds + 131072);
      { pg8::StaticOrder S; S.init(M, 2048, (int)gridDim.x, (int)blockIdx.x); const float* ssq = (const float*)(ws + OFF_SSQ); LAS float* rw = (LAS float*)(lds + 131072);
        for (int q = threadIdx.x; q < 2048; q += 512) { const int ui = q >> 8; Unit u; if (S.next(ui, u)) { const f32x4* p = (const f32x4*)(ssq + (size_t)(u.pm * 256 + (q & 255)) * 32); float sm = 0.f;
#pragma unroll
            for (int k = 0; k < 8; ++k) { const f32x4 v = p[k]; sm += (v[0] + v[1]) + (v[2] + v[3]); }
            rw[q] = rsqrtf(sm * (1.f / 2048.f) + 1e-5f); } }
        __syncthreads(); }
      run_gemm(lds, (const bf16_t*)P.out, 4096, (const bf16_t*)(ws + OFF_WO0), 4096, 2048, 4096, E); }
    gsync(grid);
    for (int rep = 0; rep < REP_LN0; ++rep) { const Params P = GETP(); unsigned char* ws = P.ws; ln_phase((const float*)(ws + OFF_K), P.ln_g, P.ln_b, P.out, (bf16_t*)(ws + X1B_OFF), X1B_LD); }
    gsync(grid);
#ifdef PROBE_L2GEMM
    { const Params P = GETP(); unsigned char* ws = P.ws; EpiIn1 E; E.U = (bf16_t*)(ws + OFF_XB); E.SG = (bf16_t*)(ws + OFF_RB);
      pg8::Gemm g; g.A = (const bf16_t*)(ws + X1B_OFF); g.Bt = (const bf16_t*)(ws + W1_OFF); g.M = M; g.N = 4096; g.K = 2048; g.lda = X1B_LD; g.ldb = W1_LD; g.alias_a = 1;
      pg8::StaticOrder S; S.init(M, 4096, (int)gridDim.x, (int)blockIdx.x); pg8::gemm_phase<EpiIn1, pg8::StaticOrder, false>(lds, g, S, E, nullptr); }
#endif
    for (int rep = 0; rep < REP_IN1; ++rep) { const Params P = GETP(); unsigned char* ws = P.ws;
      EpiIn1 E; E.U = (bf16_t*)(ws + OFF_K); E.SG = (bf16_t*)(ws + OFF_V);
      run_gemm(lds, (const bf16_t*)(ws + X1B_OFF), X1B_LD, (const bf16_t*)(ws + W1_OFF), W1_LD, 4096, 2048, E); }
    gsync(grid);
    for (int rep = 0; rep < REP_S5; ++rep) { const Params P = GETP(); s5_phase(P, lds); }
    gsync(grid);
    if (PM & 2048) { const Params P = GETP(); unsigned char* ws = P.ws;
      EpiGlu E; E.A1 = (bf16_t*)(ws + OFF_XB); E.SG = (const bf16_t*)(ws + OFF_V);
      run_gemm(lds, (const bf16_t*)(ws + OFF_RB), 2048, (const bf16_t*)(ws + OFF_WG), 2048, 4096, 2048, E); }
    gsync(grid);
    if (PM & 4096) { const Params P = GETP(); unsigned char* ws = P.ws;
      EpiOut<-1> E; E.resid = P.out; E.Y = (float*)(ws + OFF_K); E.rsl = nullptr;
      run_gemm(lds, (const bf16_t*)(ws + OFF_XB), 2048, (const bf16_t*)(ws + OFF_WO1), 2048, 2048, 2048, E); }
    gsync(grid);
    if (PM & 8192) { const Params P = GETP(); unsigned char* ws = P.ws; ln_phase((const float*)(ws + OFF_K), P.ln_g + 2048, P.ln_b + 2048, P.out, nullptr, 0); }
}

extern "C" void kernel_launch(void* const* d_in, const int* in_sizes, int n_in, void* d_out, int out_size, void* d_ws, size_t ws_size, hipStream_t stream) {
    static int grid_blocks = 0;
    if (grid_blocks == 0) {
        if (n_in != 22 || out_size != M * DM || ws_size < WS_END) { fprintf(stderr, "kernel_launch: unexpected shapes (n_in %d out %d ws %zu need %zu)\n", n_in, out_size, ws_size, (size_t)WS_END); grid_blocks = -1; return; }
        int dev = 0, cus = 0, per_cu = 0;
        hipGetDevice(&dev); hipDeviceGetAttribute(&cus, hipDeviceAttributeMultiprocessorCount, dev);
        if (hipFuncSetAttribute((const void*)mega_fwd, hipFuncAttributeMaxDynamicSharedMemorySize, LDS_BYTES) != hipSuccess) { fprintf(stderr, "kernel_launch: hipFuncSetAttribute failed\n"); grid_blocks = -1; return; }
        if (hipOccupancyMaxActiveBlocksPerMultiprocessor(&per_cu, (const void*)mega_fwd, 512, LDS_BYTES) != hipSuccess || per_cu < 1) { fprintf(stderr, "kernel_launch: occupancy query failed (%d)\n", per_cu); (void)hipGetLastError(); per_cu = 1; }
        grid_blocks = cus * 1;
        if (grid_blocks > 256) grid_blocks = 256;
    }
    if (grid_blocks < 0) return;
    Params p{};
    const float** pp = (const float**)&p;
    for (int i = 0; i < 22; ++i) pp[i] = (const float*)d_in[i];
    p.out = (float*)d_out; p.ws = (unsigned char*)d_ws;
    void* args[] = {&p};
    hipError_t e = hipLaunchCooperativeKernel((const void*)mega_fwd, dim3(grid_blocks), dim3(512), args, LDS_BYTES, stream);
    if (e != hipSuccess) fprintf(stderr, "cooperative launch failed: %s (grid %d)\n", hipGetErrorString(e), grid_blocks);
}
```

```cpp
#include <hip/hip_runtime.h>
#include <hip/hip_cooperative_groups.h>
#include <cstdio>
#include <cstdint>
namespace cg = cooperative_groups;
namespace pg8 {
#define PG8_LAS __attribute__((address_space(3)))
typedef unsigned short bf16_t;
typedef short bf16x8 __attribute__((ext_vector_type(8)));
typedef float f32x4 __attribute__((ext_vector_type(4)));
typedef unsigned u32x4 __attribute__((ext_vector_type(4)));
constexpr int BM = 256, BK = 64, HALF = 128, HTB = HALF * BK * 2  , STAGE_BYTES = 8 * HTB, NXCD = 8, WGM = 8;

__host__ __device__ __forceinline__ int lds_byte(int r, int c) { const int st = (r >> 4) * 2 + (c >> 5), rr = r & 15, cc = c & 31, ob = rr * 64 + cc * 2; return st * 1024 + (ob ^ (((ob >> 9) & 1) << 5)); }
__host__ __device__ __forceinline__ void stage_rc(int b, int& R, int& C) { const int st = b / 1024, sb = b % 1024, swz = sb ^ (((sb >> 9) & 1) << 5); R = (st >> 1) * 16 + swz / 64; C = (st & 1) * 32 + (swz % 64) / 2; }
__host__ __device__ __forceinline__ int perm32(int rho) { const int n = rho >> 4, i = rho & 15; return 8 * (i >> 2) + 4 * n + (i & 3); }

struct Unit { int pm, pn; };
struct Gemm { const bf16_t* A; const bf16_t* Bt; int M, N, K, lda, ldb, alias_a; };

struct StaticOrder {
    int nM, nN, nwg, G, c;
    __host__ __device__ void init(int M, int N, int G_, int c_) { nM = M / BM; nN = N / BM; nwg = nM * nN; G = G_; c = c_; }
    __host__ __device__ bool next(int i, Unit& u) const {
        const long L = (long)i * G + c; if (L >= nwg) return false;
        int wgid = (int)L; { const int q = nwg / NXCD, r = nwg % NXCD, xcd = wgid % NXCD, off = wgid / NXCD; wgid = (xcd < r ? xcd * (q + 1) : r * (q + 1) + (xcd - r) * q) + off; }
        const int nig = WGM * nN, gid = wgid / nig, fm = gid * WGM, gsz = (nM - fm) < WGM ? (nM - fm) : WGM;
        u.pm = fm + ((wgid % nig) % gsz); u.pn = (wgid % nig) / gsz; return true;
    }
    __device__ __forceinline__ void a_ready(const Unit&) const {}
    __device__ __forceinline__ void done(const Unit&) const {}
};
__device__ __forceinline__ unsigned cvt_pk_bf16(float lo, float hi) { unsigned r; asm volatile("v_cvt_pk_bf16_f32 %0, %1, %2" : "=v"(r) : "v"(lo), "v"(hi)); return r; }
template <class Epi, class Sched, bool STAMP = false, bool ALIGN_EPI = false, bool SP2 = true>
__device__ __forceinline__ void gemm_phase(PG8_LAS unsigned char* lds, const Gemm g, const Sched& S, const Epi& E, unsigned long long* stamps) {
    const int tid = threadIdx.x, wid = __builtin_amdgcn_readfirstlane(tid >> 6), lane = tid & 63, wr = wid >> 2, wc = wid & 3, fr = lane & 15, fq = lane >> 4;
    const int K = g.K, nt = K / BK;
    int ts_lo = 0, ts_hi = 0, nts = 0; const unsigned long long rt_entry = STAMP ? (unsigned long long)wall_clock64() : 0ull;
#define PG8_STAMP() do { if (STAMP && wid == 0 && nts < 64) { const unsigned long long _c = (unsigned long long)clock64(); \
        ts_lo = (lane == nts) ? (int)(unsigned)_c : ts_lo; ts_hi = (lane == nts) ? (int)(unsigned)(_c >> 32) : ts_hi; ++nts; } } while (0)
    PG8_STAMP();
    unsigned voffA[2], voffB[2];
#pragma unroll
    for (int i = 0; i < 2; ++i) { int R, C; stage_rc(tid * 16 + i * 8192, R, C); const int Rb = Epi::PERM ? ((R & ~31) + perm32(R & 31)) : R;
        voffA[i] = (unsigned)(R * g.lda + C) * 2u; voffB[i] = (unsigned)(Rb * g.ldb + C) * 2u; }
    const size_t kstep = (size_t)(BK * 2);
    const size_t hstepA = (size_t)HALF * g.lda * 2, hstepB = (size_t)HALF * g.ldb * 2;
    const size_t tstepA = g.alias_a ? (size_t)0 : 2 * hstepA, tstepB = 2 * hstepB;
    const unsigned ldsw = (unsigned)wid * 1024u;
    const int aoff = lds_byte(wr * 64 + fr, fq * 8), boff = lds_byte(wc * 32 + fr, fq * 8);
#define PG8_SA(b, h) (((b) * 2 + (h)) * HTB)
#define PG8_SB(b, h) ((4 + (b) * 2 + (h)) * HTB)
#define PG8_STAGE(bufoff, gbase, voff) do { _Pragma("unroll") for (int _i = 0; _i < 2; ++_i) \
        __builtin_amdgcn_global_load_lds((const unsigned*)((const char*)(gbase) + (voff)[_i]), (PG8_LAS unsigned*)(lds + (bufoff) + ldsw + _i * 8192), 16, 0, 0); } while (0)
#define PG8_LDA(dst, b, h) do { _Pragma("unroll") for (int m = 0; m < 4; ++m) _Pragma("unroll") for (int k = 0; k < 2; ++k) dst[m][k] = *(const PG8_LAS bf16x8*)(lds + PG8_SA(b, h) + aoff + m * 2048 + k * 1024); } while (0)
#define PG8_LDB(dst, b, h) do { _Pragma("unroll") for (int n = 0; n < 2; ++n) _Pragma("unroll") for (int k = 0; k < 2; ++k) dst[n][k] = *(const PG8_LAS bf16x8*)(lds + PG8_SB(b, h) + boff + n * 2048 + k * 1024); } while (0)
#define PG8_MMA(ai, bj, At, Bt) do { __builtin_amdgcn_s_setprio(1); _Pragma("unroll") for (int m = 0; m < 4; ++m) _Pragma("unroll") for (int n = 0; n < 2; ++n) _Pragma("unroll") for (int k = 0; k < 2; ++k) \
        acc[ai][bj][m][n] = __builtin_amdgcn_mfma_f32_16x16x32_bf16(Bt[n][k], At[m][k], acc[ai][bj][m][n], 0, 0, 0); __builtin_amdgcn_s_setprio(0); } while (0)
#define PG8_WAIT_V(n) asm volatile("s_waitcnt vmcnt(" #n ")" ::: "memory")
#define PG8_WAIT_L(n) asm volatile("s_waitcnt lgkmcnt(" #n ")" ::: "memory")
#define PG8_BAR __builtin_amdgcn_s_barrier()
#define PG8_SCHED __builtin_amdgcn_sched_barrier(0)
    Unit cur, nxt; int ui = 0;
    if (!S.next(0, cur)) return;
    f32x4 acc[2][2][4][2];
#pragma unroll
    for (int a = 0; a < 2; ++a)
#pragma unroll
        for (int b = 0; b < 2; ++b)
#pragma unroll
            for (int m = 0; m < 4; ++m)
#pragma unroll
                for (int n = 0; n < 2; ++n) acc[a][b][m][n] = (f32x4){0.f, 0.f, 0.f, 0.f};
    bf16x8 At[4][2], B0[2][2], B1[2][2];
    const char* cA = (const char*)g.A + (size_t)cur.pm * tstepA; const char* cB = (const char*)g.Bt + (size_t)cur.pn * tstepB;
    S.a_ready(cur);
    if constexpr (SP2) {
        PG8_STAGE(PG8_SB(0, 0), cB, voffB); PG8_STAGE(PG8_SB(0, 1), cB + hstepB, voffB); PG8_STAGE(PG8_SA(0, 0), cA, voffA); PG8_STAGE(PG8_SA(0, 1), cA + hstepA, voffA);
        if (wr == 1) PG8_BAR;
        PG8_WAIT_V(2); PG8_BAR;
        PG8_STAGE(PG8_SB(1, 0), cB + kstep, voffB); PG8_STAGE(PG8_SA(1, 0), cA + kstep, voffA); PG8_STAGE(PG8_SB(1, 1), cB + hstepB + kstep, voffB);
        PG8_WAIT_V(6); PG8_BAR;
    } else {
    PG8_STAGE(PG8_SB(0, 0), cB, voffB); PG8_STAGE(PG8_SA(0, 0), cA, voffA); PG8_STAGE(PG8_SB(0, 1), cB + hstepB, voffB); PG8_STAGE(PG8_SA(0, 1), cA + hstepA, voffA);
    if (wr == 1) PG8_BAR;
    PG8_WAIT_V(4); PG8_BAR;
    PG8_STAGE(PG8_SB(1, 0), cB + kstep, voffB); PG8_STAGE(PG8_SA(1, 0), cA + kstep, voffA); PG8_STAGE(PG8_SB(1, 1), cB + hstepB + kstep, voffB);
    PG8_WAIT_V(6); PG8_BAR;
    }
    PG8_STAMP();
    for (;;) {
        const bool has_next = S.next(ui + 1, nxt);
        const char* nA = has_next ? (const char*)g.A + (size_t)nxt.pm * tstepA : cA; const char* nB = has_next ? (const char*)g.Bt + (size_t)nxt.pn * tstepB : cB;
        for (int t = 0; t < nt; t += 2) {
            if constexpr (Epi::MID >= 0) { if (t == Epi::MID) E.mid(acc, cur, ui, wr, wc, fr, fq); }
            const bool last = (t == nt - 2);
            const char* a1 = cA + (size_t)(t + 1) * kstep;
            const char* a2 = last ? nA : cA + (size_t)(t + 2) * kstep; const char* b2 = last ? nB : cB + (size_t)(t + 2) * kstep;
            const char* a3 = a2 + kstep; const char* b3 = b2 + kstep;
            if (last && has_next) S.a_ready(nxt);
            if constexpr (SP2) {
            PG8_LDB(B0, 0, 0); PG8_LDB(B1, 0, 1); PG8_SCHED; PG8_LDA(At, 0, 0); PG8_STAGE(PG8_SA(1, 1), a1 + hstepA, voffA);
            PG8_WAIT_V(8); PG8_WAIT_L(0); PG8_BAR; PG8_MMA(0, 0, At, B0); PG8_MMA(0, 1, At, B1); PG8_BAR; PG8_SCHED;
            PG8_LDA(At, 0, 1); PG8_STAGE(PG8_SB(0, 0), b2, voffB); PG8_STAGE(PG8_SB(0, 1), b2 + hstepB, voffB); PG8_STAGE(PG8_SA(0, 0), a2, voffA);
            PG8_WAIT_V(8); PG8_WAIT_L(0); PG8_BAR; PG8_MMA(1, 0, At, B0); PG8_MMA(1, 1, At, B1); PG8_BAR; PG8_SCHED;
            PG8_LDB(B0, 1, 0); PG8_LDB(B1, 1, 1); PG8_SCHED; PG8_LDA(At, 1, 0); PG8_STAGE(PG8_SA(0, 1), a2 + hstepA, voffA);
            PG8_WAIT_V(8); PG8_WAIT_L(0); PG8_BAR; PG8_MMA(0, 0, At, B0); PG8_MMA(0, 1, At, B1); PG8_BAR; PG8_SCHED;
            PG8_LDA(At, 1, 1); PG8_STAGE(PG8_SB(1, 0), b3, voffB); PG8_STAGE(PG8_SB(1, 1), b3 + hstepB, voffB); PG8_STAGE(PG8_SA(1, 0), a3, voffA);
            PG8_WAIT_V(8); PG8_WAIT_L(0); PG8_BAR; PG8_MMA(1, 0, At, B0); PG8_MMA(1, 1, At, B1); PG8_BAR; PG8_SCHED;
            } else {
            PG8_LDB(B0, 0, 0); PG8_SCHED; PG8_LDA(At, 0, 0); PG8_STAGE(PG8_SA(1, 1), a1 + hstepA, voffA);
            PG8_WAIT_L(8); PG8_BAR; PG8_WAIT_L(0); PG8_MMA(0, 0, At, B0); PG8_BAR; PG8_SCHED;
            PG8_LDB(B1, 0, 1); PG8_STAGE(PG8_SB(0, 0), b2, voffB);
            PG8_BAR; PG8_WAIT_L(0); PG8_MMA(0, 1, At, B1); PG8_BAR;
            PG8_LDA(At, 0, 1); PG8_STAGE(PG8_SA(0, 0), a2, voffA);
            PG8_BAR; PG8_WAIT_L(0); PG8_MMA(1, 0, At, B0); PG8_BAR; PG8_SCHED;
            PG8_STAGE(PG8_SB(0, 1), b2 + hstepB, voffB);
            PG8_WAIT_V(6); PG8_BAR; PG8_MMA(1, 1, At, B1); PG8_BAR;
            PG8_LDB(B0, 1, 0); PG8_SCHED; PG8_LDA(At, 1, 0); PG8_STAGE(PG8_SA(0, 1), a2 + hstepA, voffA);
            PG8_WAIT_L(8); PG8_BAR; PG8_WAIT_L(0); PG8_MMA(0, 0, At, B0); PG8_BAR; PG8_SCHED;
            PG8_LDB(B1, 1, 1); PG8_STAGE(PG8_SB(1, 0), b3, voffB);
            PG8_BAR; PG8_WAIT_L(0); PG8_MMA(0, 1, At, B1); PG8_BAR;
            PG8_LDA(At, 1, 1); PG8_STAGE(PG8_SA(1, 0), a3, voffA);
            PG8_BAR; PG8_WAIT_L(0); PG8_MMA(1, 0, At, B0); PG8_BAR; PG8_SCHED;
            PG8_STAGE(PG8_SB(1, 1), b3 + hstepB, voffB);
            PG8_WAIT_V(6); PG8_BAR; PG8_MMA(1, 1, At, B1); PG8_BAR;
            }
        }
        PG8_STAMP();
        if constexpr (ALIGN_EPI) { if (wr == 0) PG8_BAR; }
        if constexpr (!Epi::AFTER_DRAIN) { E(acc, cur, wr, wc, fr, fq); S.done(cur); }
        PG8_STAMP();
        if (!has_next) break;
#pragma unroll
        for (int a = 0; a < 2; ++a)
#pragma unroll
            for (int b = 0; b < 2; ++b)
#pragma unroll
                for (int m = 0; m < 4; ++m)
#pragma unroll
                    for (int n = 0; n < 2; ++n) acc[a][b][m][n] = (f32x4){0.f, 0.f, 0.f, 0.f};
        cur = nxt; cA = nA; cB = nB; ++ui;
        if constexpr (ALIGN_EPI) { if (wr == 1) PG8_BAR; }
    }
    PG8_WAIT_V(0);
    if constexpr (!ALIGN_EPI) { if (wr == 0) PG8_BAR; }
    PG8_BAR;
    if constexpr (Epi::AFTER_DRAIN) { E.fused(acc, cur, wr, wc, fr, fq, lds, wid, lane); S.done(cur); }
    PG8_STAMP();
    if (STAMP && wid == 0) { stamps[lane] = lane < nts ? (((unsigned long long)(unsigned)ts_hi << 32) | (unsigned)ts_lo) : 0ull;
        if (lane == 62) stamps[62] = rt_entry; if (lane == 63) stamps[63] = (unsigned long long)wall_clock64(); }
#undef PG8_STAMP
#undef PG8_SA
#undef PG8_SB
#undef PG8_STAGE
#undef PG8_LDA
#undef PG8_LDB
#undef PG8_MMA
#undef PG8_WAIT_V
#undef PG8_WAIT_L
#undef PG8_BAR
#undef PG8_SCHED
}
}

using pg8::bf16_t; using pg8::bf16x8; using pg8::f32x4; using pg8::u32x4; using pg8::Unit;
#define LAS __attribute__((address_space(3)))
#ifndef GSYNC_WAVE_ACQ
#define GSYNC_WAVE_ACQ 0
#endif
#ifndef GEMM_SKEW_TICKS
#define GEMM_SKEW_TICKS 0
#endif
typedef short s16x4 __attribute__((ext_vector_type(4)));
typedef short v4i16_t __attribute__((ext_vector_type(4)));
typedef unsigned u32x2 __attribute__((ext_vector_type(2)));
typedef LAS unsigned char* ldsp;

constexpr int M = 16384, DM = 2048, SEQ = 4096;
constexpr int N0P = 13568;
constexpr float ALPHA = 1.41421356237309515f;
constexpr int LDS_BYTES = 131072 + 8192;

constexpr size_t OFF_XB = 0;
constexpr size_t OFF_W0T = 67108864;
constexpr size_t OFF_RB = 122683392;
constexpr size_t OFF_SIN = OFF_RB + 67108864;
constexpr size_t OFF_K = 223346688;
constexpr size_t OFF_V = 290455552;
constexpr size_t OFF_G = 357564416;
constexpr size_t OFF_WO0 = 424673280;
constexpr size_t OFF_W1 = 441450496;
constexpr size_t OFF_WG = 458227712;
constexpr size_t OFF_WO1 = 475004928;
constexpr size_t OFF_DT = 483393536;
constexpr size_t OFF_CUM = 485490688;
constexpr size_t OFF_SSQ = 487587840;
constexpr size_t OFF_KM = 490733568;
constexpr size_t OFF_CT = 490209280;
constexpr size_t OFF_STB = 490471424;
constexpr size_t WS_END = 490733568 + 1048576;
#ifdef PITCH_EXP
constexpr size_t X1B_OFF = OFF_XB, W1_OFF = WS_END; constexpr int X1B_LD = 2112, W1_LD = 2112;
#else
constexpr size_t X1B_OFF = OFF_G, W1_OFF = OFF_W1; constexpr int X1B_LD = 2048, W1_LD = 2048;
#endif

struct Params {
    const float *x, *in0_w, *conv_w, *conv_b, *dt_bias, *a_log, *ssd_d, *ssd_norm_g, *out0_w, *in1_w,
                *lam_re, *lam_im, *log_dt, *b_re, *b_im, *c_re, *c_im, *s5_d, *glu_w, *out1_w, *ln_g, *ln_b;
    float* out; unsigned char* ws;
};

__constant__ float INVF[16] = {1.000000000e+00f, 4.403665960e-01f, 1.939227432e-01f, 8.539710194e-02f, 3.760603070e-02f, 1.656043902e-02f, 7.292664610e-03f, 3.211445874e-03f,
                               1.414213562e-03f, 6.227723788e-04f, 2.742481884e-04f, 1.207697351e-04f, 5.318296098e-05f, 2.341999971e-05f, 1.031338616e-05f, 4.541670478e-06f};

#define LDS_WAIT() asm volatile("s_waitcnt lgkmcnt(0)" ::: "memory")
__device__ __forceinline__ unsigned pk2(float lo, float hi) { return pg8::cvt_pk_bf16(lo, hi); }
__device__ __forceinline__ float bf_lo(unsigned u) { return __uint_as_float(u << 16); }
__device__ __forceinline__ float bf_hi(unsigned u) { return __uint_as_float(u & 0xffff0000u); }
__device__ __forceinline__ float bf1(bf16_t h) { return __uint_as_float(((unsigned)h) << 16); }
__device__ __forceinline__ float silu_f(float v) { return v * __builtin_amdgcn_rcpf(1.f + __expf(-v)); }
__device__ __forceinline__ float sigmoid_f(float v) { return __builtin_amdgcn_rcpf(1.f + __expf(-v)); }
__device__ __forceinline__ float softplus_f(float v) { return fmaxf(v, 0.f) + log1pf(__expf(-fabsf(v))); }
__device__ __forceinline__ float gelu_tanh_f(float v) { const float u = 0.7978845608028654f * (v + 0.044715f * v * v * v); const float t = 1.f - 2.f * __builtin_amdgcn_rcpf(1.f + __expf(2.f * u)); return 0.5f * v * (1.f + t); }
__device__ __forceinline__ s16x4 vtr(const LAS unsigned char* p) { return __builtin_bit_cast(s16x4, __builtin_amdgcn_ds_read_tr16_b64_v4i16((LAS v4i16_t*)p)); }
__device__ __forceinline__ bf16x8 cat8(s16x4 lo, s16x4 hi) { return __builtin_shufflevector(lo, hi, 0, 1, 2, 3, 4, 5, 6, 7); }
__device__ __forceinline__ f32x4 mfma16(bf16x8 a, bf16x8 b, f32x4 c) { return __builtin_amdgcn_mfma_f32_16x16x32_bf16(a, b, c, 0, 0, 0); }
__device__ __forceinline__ void sincos_d(double a, float& s, float& c) {
    const double k = rint(a * 0.63661977236758134308);
    double r = fma(-k, 1.57079632679489661923, a); r = fma(-k, 6.123233995736766e-17, r);
    const double r2 = r * r;
    const double sp = r * (1.0 + r2 * (-1.0 / 6.0 + r2 * (1.0 / 120.0 + r2 * (-1.0 / 5040.0 + r2 * (1.0 / 362880.0 + r2 * (-1.0 / 39916800.0 + r2 * (1.0 / 6227020800.0)))))));
    const double cp = 1.0 + r2 * (-0.5 + r2 * (1.0 / 24.0 + r2 * (-1.0 / 720.0 + r2 * (1.0 / 40320.0 + r2 * (-1.0 / 3628800.0 + r2 * (1.0 / 479001600.0 + r2 * (-1.0 / 87178291200.0)))))));
    const int q = ((int)k) & 3;
    const double ss = (q == 0) ? sp : (q == 1) ? cp : (q == 2) ? -sp : -cp;
    const double cc = (q == 0) ? cp : (q == 1) ? -sp : (q == 2) ? -cp : sp;
    s = (float)ss; c = (float)cc;
}

struct EpiIn0 {
    static constexpr bool PERM = false, AFTER_DRAIN = false; static constexpr int MID = -1;
    bf16_t *A0, *XBCraw, *Kb, *Vb, *Gb; float *DTf, *kmean; const float *ctab, *stab, *dt_bias;
    __device__ __forceinline__ void mid(f32x4 (&)[2][2][4][2], const Unit&, int, int, int, int, int) const {}
    __device__ __forceinline__ void operator()(const f32x4 (&acc)[2][2][4][2], const Unit& u, int wr, int wc, int fr, int fq) const {
        const int pn = u.pn, rowb = u.pm * 256 + wr * 64 + fr, colw = wc * 32 + 4 * fq;
        if (pn >= 52) {
            if (pn == 52 && wc == 0) {
#pragma unroll
                for (int ai = 0; ai < 2; ++ai)
#pragma unroll
                    for (int m = 0; m < 4; ++m) { const int row = rowb + ai * 128 + m * 16;
#pragma unroll
                        for (int n = 0; n < 2; ++n) { const f32x4 v = acc[ai][0][m][n]; const f32x4 bb = *(const f32x4*)(dt_bias + 16 * n + 4 * fq); f32x4 r;
                            r[0] = softplus_f(v[0] + bb[0]); r[1] = softplus_f(v[1] + bb[1]); r[2] = softplus_f(v[2] + bb[2]); r[3] = softplus_f(v[3] + bb[3]);
                            *(f32x4*)(DTf + (size_t)row * 32 + 16 * n + 4 * fq) = r; } }
            }
            return;
        }
        bf16_t* dst; int ld; int mode;
        if (pn < 8) { dst = A0 + 256 * pn; ld = 4096; mode = 0; }
        else if (pn < 20) { dst = XBCraw + 256 * (pn - 8); ld = 3072; mode = 0; }
        else if (pn < 28) { dst = A0 + 2048 + 256 * (pn - 20); ld = 4096; mode = 1; }
        else if (pn < 36) { dst = Kb + 256 * (pn - 28); ld = 2048; mode = 2; }
        else if (pn < 44) { dst = Vb + 256 * (pn - 36); ld = 2048; mode = 0; }
        else { dst = Gb + 256 * (pn - 44); ld = 2048; mode = 3; }
        const bool rot = (mode == 1 || mode == 2) && (wc == 0);
        f32x4 cs[2][2];
#pragma unroll
        for (int bj = 0; bj < 2; ++bj)
#pragma unroll
            for (int n = 0; n < 2; ++n) cs[bj][n] = (f32x4){0.f, 0.f, 0.f, 0.f};
#pragma unroll
        for (int ai = 0; ai < 2; ++ai)
#pragma unroll
            for (int m = 0; m < 4; ++m) { const int row = rowb + ai * 128 + m * 16; f32x4 v[2][2];
#pragma unroll
                for (int bj = 0; bj < 2; ++bj)
#pragma unroll
                    for (int n = 0; n < 2; ++n) v[bj][n] = acc[ai][bj][m][n];
                if (rot) { const int pos = row & (SEQ - 1); const f32x4 cv = *(const f32x4*)(ctab + pos * 16 + 4 * fq), sv = *(const f32x4*)(stab + pos * 16 + 4 * fq);
#pragma unroll
                    for (int bj = 0; bj < 2; ++bj) { const f32x4 x1 = v[bj][0], x2 = v[bj][1]; v[bj][0] = x1 * cv - x2 * sv; v[bj][1] = x1 * sv + x2 * cv; } }
                if (mode == 2) {
#pragma unroll
                    for (int bj = 0; bj < 2; ++bj)
#pragma unroll
                        for (int n = 0; n < 2; ++n) cs[bj][n] += v[bj][n]; }
                if (mode == 3) {
#pragma unroll
                    for (int bj = 0; bj < 2; ++bj)
#pragma unroll
                        for (int n = 0; n < 2; ++n)
#pragma unroll
                            for (int j = 0; j < 4; ++j) v[bj][n][j] = silu_f(v[bj][n][j]); }
                bf16_t* rp = dst + (size_t)row * ld + colw;
#pragma unroll
                for (int bj = 0; bj < 2; ++bj)
#pragma unroll
                    for (int n = 0; n < 2; ++n) { u32x2 o; o.x = pk2(v[bj][n][0], v[bj][n][1]); o.y = pk2(v[bj][n][2], v[bj][n][3]); *(u32x2*)(rp + bj * 128 + n * 16) = o; }
            }
        if (mode == 2) {
#pragma unroll
            for (int bj = 0; bj < 2; ++bj)
#pragma unroll
                for (int n = 0; n < 2; ++n)
#pragma unroll
                    for (int j = 0; j < 4; ++j) { float s = cs[bj][n][j]; s += __shfl_xor(s, 1); s += __shfl_xor(s, 2); s += __shfl_xor(s, 4); s += __shfl_xor(s, 8); cs[bj][n][j] = s; }
            if (fr == 0) { const int b = u.pm >> 4, blk = u.pm & 15;
#pragma unroll
                for (int bj = 0; bj < 2; ++bj) { const int head = 2 * (pn - 28) + bj; float* kp = kmean + ((size_t)((b * 16 + head) * 16 + blk)) * 128 + colw;
#pragma unroll
                    for (int n = 0; n < 2; ++n) *(f32x4*)(kp + wr * 131072 + n * 16) = cs[bj][n]; } }
        }
    }
};
struct EpiIn1 {
    static constexpr bool PERM = false, AFTER_DRAIN = false; static constexpr int MID = -1;
    bf16_t *U, *SG;
    __device__ __forceinline__ void mid(f32x4 (&)[2][2][4][2], const Unit&, int, int, int, int, int) const {}
    __device__ __forceinline__ void operator()(const f32x4 (&acc)[2][2][4][2], const Unit& u, int wr, int wc, int fr, int fq) const {
        const int pn = u.pn, rowb = u.pm * 256 + wr * 64 + fr, colw = wc * 32 + 4 * fq; const bool sg = pn >= 8;
        bf16_t* dst = sg ? SG + 256 * (pn - 8) : U + 256 * pn;
#pragma unroll
        for (int ai = 0; ai < 2; ++ai)
#pragma unroll
            for (int m = 0; m < 4; ++m) { bf16_t* rp = dst + (size_t)(rowb + ai * 128 + m * 16) * 2048 + colw;
#pragma unroll
                for (int bj = 0; bj < 2; ++bj)
#pragma unroll
                    for (int n = 0; n < 2; ++n) { f32x4 v = acc[ai][bj][m][n];
                        if (sg) { v[0] = silu_f(v[0]); v[1] = silu_f(v[1]); v[2] = silu_f(v[2]); v[3] = silu_f(v[3]); }
                        u32x2 o; o.x = pk2(v[0], v[1]); o.y = pk2(v[2], v[3]); *(u32x2*)(rp + bj * 128 + n * 16) = o; } }
    }
};
struct EpiGlu {
    static constexpr bool PERM = false, AFTER_DRAIN = false; static constexpr int MID = -1;
    bf16_t* __restrict__ A1; const bf16_t* __restrict__ SG;
    __device__ __forceinline__ void mid(f32x4 (&)[2][2][4][2], const Unit&, int, int, int, int, int) const {}
    __device__ __forceinline__ void operator()(const f32x4 (&acc)[2][2][4][2], const Unit& u, int wr, int wc, int fr, int fq) const {
        const int rowb = u.pm * 256 + wr * 64 + fr, colb = u.pn * 128 + wc * 32 + 4 * fq;
        u32x2 sgv[2][4][2];
#pragma unroll
        for (int ai = 0; ai < 2; ++ai)
#pragma unroll
            for (int m = 0; m < 4; ++m)
#pragma unroll
                for (int n = 0; n < 2; ++n) sgv[ai][m][n] = *(const u32x2*)(SG + (size_t)(rowb + ai * 128 + m * 16) * 2048 + colb + n * 16);
#pragma unroll
        for (int ai = 0; ai < 2; ++ai)
#pragma unroll
            for (int m = 0; m < 4; ++m) { const size_t ro = (size_t)(rowb + ai * 128 + m * 16) * 2048 + colb;
#pragma unroll
                for (int n = 0; n < 2; ++n) { const f32x4 ga = acc[ai][0][m][n], gb = acc[ai][1][m][n]; const u32x2 s = sgv[ai][m][n];
                    const float o0 = ga[0] * sigmoid_f(gb[0]) * bf_lo(s.x), o1 = ga[1] * sigmoid_f(gb[1]) * bf_hi(s.x), o2 = ga[2] * sigmoid_f(gb[2]) * bf_lo(s.y), o3 = ga[3] * sigmoid_f(gb[3]) * bf_hi(s.y);
                    u32x2 o; o.x = pk2(o0, o1); o.y = pk2(o2, o3); *(u32x2*)(A1 + ro + n * 16) = o; } }
    }
};
template <int MIDK> struct EpiOut {
    static constexpr bool PERM = false, AFTER_DRAIN = false; static constexpr int MID = MIDK;
    const float* __restrict__ resid; float* __restrict__ Y; const LAS float* rsl;
    __device__ __forceinline__ void mid(f32x4 (&acc)[2][2][4][2], const Unit& u, int ui, int wr, int wc, int fr, int fq) const {
        const LAS float* rp = rsl + ui * 256 + wr * 64 + fr;
#pragma unroll
        for (int ai = 0; ai < 2; ++ai)
#pragma unroll
            for (int m = 0; m < 4; ++m) { const float rs = rp[ai * 128 + m * 16];
#pragma unroll
                for (int bj = 0; bj < 2; ++bj)
#pragma unroll
                    for (int n = 0; n < 2; ++n) acc[ai][bj][m][n] *= rs; }
    }
    __device__ __forceinline__ void operator()(const f32x4 (&acc)[2][2][4][2], const Unit& u, int wr, int wc, int fr, int fq) const {
        const int rowb = u.pm * 256 + wr * 64 + fr, colb = u.pn * 256 + wc * 32 + 4 * fq;
#pragma unroll
        for (int ai = 0; ai < 2; ++ai)
#pragma unroll
            for (int mp = 0; mp < 2; ++mp) { f32x4 r[2][2][2];
#pragma unroll
                for (int mm = 0; mm < 2; ++mm) { const size_t ro = (size_t)(rowb + ai * 128 + (2 * mp + mm) * 16) * 2048 + colb;
#pragma unroll
                    for (int bj = 0; bj < 2; ++bj)
#pragma unroll
                        for (int n = 0; n < 2; ++n) r[mm][bj][n] = *(const f32x4*)(resid + ro + bj * 128 + n * 16); }
#pragma unroll
                for (int mm = 0; mm < 2; ++mm) { const size_t ro = (size_t)(rowb + ai * 128 + (2 * mp + mm) * 16) * 2048 + colb;
#pragma unroll
                    for (int bj = 0; bj < 2; ++bj)
#pragma unroll
                        for (int n = 0; n < 2; ++n) *(f32x4*)(Y + ro + bj * 128 + n * 16) = r[mm][bj][n] * ALPHA + acc[ai][bj][2 * mp + mm][n]; } }
    }
};

__device__ __forceinline__ void transpose_item(const float* W, int Nsrc, int nsrc0, bf16_t* WT, int Kdim, int k0, int ndst0, const float* kscale, LAS float* scr, int lane) {
    if (nsrc0 >= 0) {
#pragma unroll 8
        for (int i = 0; i < 32; ++i) { const int kk = 2 * i + (lane >> 5); float v = W[(size_t)(k0 + kk) * Nsrc + nsrc0 + (lane & 31)]; if (kscale) v *= kscale[k0 + kk]; scr[kk * 33 + (lane & 31)] = v; }
    } else {
#pragma unroll 8
        for (int i = 0; i < 32; ++i) { const int kk = 2 * i + (lane >> 5); scr[kk * 33 + (lane & 31)] = 0.f; }
    }
    LDS_WAIT();
    const int c = lane & 7;
#pragma unroll
    for (int j = 0; j < 4; ++j) { const int n = (lane >> 3) + 8 * j; const LAS float* s = scr + (8 * c) * 33 + n;
        u32x4 o; o.x = pk2(s[0 * 33], s[1 * 33]); o.y = pk2(s[2 * 33], s[3 * 33]); o.z = pk2(s[4 * 33], s[5 * 33]); o.w = pk2(s[6 * 33], s[7 * 33]);
        *(u32x4*)(WT + (size_t)(ndst0 + n) * Kdim + k0 + 8 * c) = o; }
    LDS_WAIT();
}
__device__ __forceinline__ void p0_phase(const Params& P, ldsp lds) {
    const int tid = threadIdx.x, wave = __builtin_amdgcn_readfirstlane(tid >> 6), lane = tid & 63;
    const int gw = blockIdx.x * 8 + wave, NGW = gridDim.x * 8;
    const size_t gtid = (size_t)blockIdx.x * 512 + tid, nth = (size_t)gridDim.x * 512;
    unsigned char* ws = P.ws;
    LAS float* scr = (LAS float*)(lds + wave * 8704);
    constexpr int I0 = 32 * 424, I1 = 64 * 64, I2 = 32 * 128, I3 = 32 * 128, I4 = 32 * 64;
    for (int it = gw; it < I0 + I1 + I2 + I3 + I4; it += NGW) {
        int r = it;
        if (r < I0) { const int kb = r / 424, nb = r % 424, nd = 32 * nb; const int ns = nd < 5120 ? nd : (nd < 13312 ? nd + 32 : (nd == 13312 ? 5120 : -1));
            transpose_item(P.in0_w, 13344, ns, (bf16_t*)(ws + OFF_W0T), 2048, 64 * kb, nd, nullptr, scr, lane); continue; } r -= I0;
        if (r < I1) { const int kb = r / 64, nb = r % 64; transpose_item(P.out0_w, 2048, 32 * nb, (bf16_t*)(ws + OFF_WO0), 4096, 64 * kb, 32 * nb, kb < 32 ? P.ssd_norm_g : nullptr, scr, lane); continue; } r -= I1;
        if (r < I2) { const int kb = r / 128, nb = r % 128; transpose_item(P.in1_w, 4096, 32 * nb, (bf16_t*)(ws + W1_OFF), W1_LD, 64 * kb, 32 * nb, nullptr, scr, lane); continue; } r -= I2;
        if (r < I3) { const int kb = r / 128, nb = r % 128, nd = 32 * nb; const int ns = ((nd >> 7) & 1) * 2048 + 128 * (nd >> 8) + (nd & 127);
            transpose_item(P.glu_w, 4096, ns, (bf16_t*)(ws + OFF_WG), 2048, 64 * kb, nd, nullptr, scr, lane); continue; } r -= I3;
        { const int kb = r / 64, nb = r % 64; transpose_item(P.out1_w, 2048, 32 * nb, (bf16_t*)(ws + OFF_WO1), 2048, 64 * kb, 32 * nb, nullptr, scr, lane); }
    }
    { const f32x4* xs = (const f32x4*)P.x; u32x2* xd = (u32x2*)(ws + OFF_XB);
      for (size_t i = gtid; i < (size_t)M * DM / 4; i += nth) { const f32x4 v = xs[i]; u32x2 o; o.x = pk2(v[0], v[1]); o.y = pk2(v[2], v[3]); xd[i] = o; } }
    { float* ct = (float*)(ws + OFF_CT); float* st = (float*)(ws + OFF_STB);
      for (size_t i = gtid; i < 4096 * 16; i += nth) { const int pos = (int)(i >> 4), k = (int)(i & 15); const float ang = (float)pos * INVF[k]; float s, c; sincos_d((double)ang, s, c); ct[i] = c; st[i] = s; } }

}

__device__ __forceinline__ void conv_phase(const Params& P) {
    const int tid = threadIdx.x, wave = __builtin_amdgcn_readfirstlane(tid >> 6), lane = tid & 63;
    const size_t gtid = (size_t)blockIdx.x * 512 + tid, nth = (size_t)gridDim.x * 512;
    const bf16_t* XR = (const bf16_t*)(P.ws + OFF_RB); bf16_t* X2 = (bf16_t*)(P.ws + OFF_XB);
    for (size_t it = gtid; it < (size_t)1024 * 384; it += nth) {
        const int tb = (int)(it / 384), cc = (int)(it % 384), t0 = tb * 16, ch = cc * 8;
        float w[4][8], bb[8];
#pragma unroll
        for (int j = 0; j < 4; ++j) { const f32x4 a = *(const f32x4*)(P.conv_w + j * 3072 + ch), b = *(const f32x4*)(P.conv_w + j * 3072 + ch + 4);
            w[j][0] = a[0]; w[j][1] = a[1]; w[j][2] = a[2]; w[j][3] = a[3]; w[j][4] = b[0]; w[j][5] = b[1]; w[j][6] = b[2]; w[j][7] = b[3]; }
        { const f32x4 a = *(const f32x4*)(P.conv_b + ch), b = *(const f32x4*)(P.conv_b + ch + 4); bb[0] = a[0]; bb[1] = a[1]; bb[2] = a[2]; bb[3] = a[3]; bb[4] = b[0]; bb[5] = b[1]; bb[6] = b[2]; bb[7] = b[3]; }
        const bool first = (t0 & (SEQ - 1)) == 0;
        u32x4 raw[19];
#pragma unroll
        for (int r = 0; r < 19; ++r) { if (r < 3 && first) raw[r] = (u32x4){0u, 0u, 0u, 0u}; else raw[r] = *(const u32x4*)(XR + (size_t)(t0 - 3 + r) * 3072 + ch); }
#pragma unroll
        for (int r = 0; r < 16; ++r) { float o[8];
#pragma unroll
            for (int e = 0; e < 8; ++e) o[e] = bb[e];
#pragma unroll
            for (int j = 0; j < 4; ++j) { const u32x4 q = raw[r + j];
                o[0] += w[j][0] * bf_lo(q.x); o[1] += w[j][1] * bf_hi(q.x); o[2] += w[j][2] * bf_lo(q.y); o[3] += w[j][3] * bf_hi(q.y);
                o[4] += w[j][4] * bf_lo(q.z); o[5] += w[j][5] * bf_hi(q.z); o[6] += w[j][6] * bf_lo(q.w); o[7] += w[j][7] * bf_hi(q.w); }
#pragma unroll
            for (int e = 0; e < 8; ++e) o[e] = silu_f(o[e]);
            u32x4 ov; ov.x = pk2(o[0], o[1]); ov.y = pk2(o[2], o[3]); ov.z = pk2(o[4], o[5]); ov.w = pk2(o[6], o[7]);
            *(u32x4*)(X2 + (size_t)(t0 + r) * 3072 + ch) = ov; }
    }
    const float* DTf = (const float*)(P.ws + OFF_DT); float* CUM = (float*)(P.ws + OFF_CUM);
    for (int it = blockIdx.x * 8 + wave; it < 2048; it += gridDim.x * 8) {
        const int b = it >> 9, c = (it >> 5) & 15, h = it & 31; const size_t rowbase = (size_t)b * 4096 + c * 256 + 4 * lane;
        const float Ah = -__expf(P.a_log[h]);
        const float a0 = DTf[(rowbase + 0) * 32 + h] * Ah, a1 = DTf[(rowbase + 1) * 32 + h] * Ah, a2 = DTf[(rowbase + 2) * 32 + h] * Ah, a3 = DTf[(rowbase + 3) * 32 + h] * Ah;
        const float s0 = a0, s1 = s0 + a1, s2 = s1 + a2, s3 = s2 + a3;
        float x = s3;
#pragma unroll
        for (int o = 1; o < 64; o <<= 1) { const float t = __shfl_up(x, o); if (lane >= o) x += t; }
        const float off = x - s3;
        CUM[(rowbase + 0) * 32 + h] = off + s0; CUM[(rowbase + 1) * 32 + h] = off + s1; CUM[(rowbase + 2) * 32 + h] = off + s2; CUM[(rowbase + 3) * 32 + h] = off + s3;
    }
}

__device__ __forceinline__ void ssd_a_phase(const Params& P, ldsp lds) {
    const int tid = threadIdx.x, wave = __builtin_amdgcn_readfirstlane(tid >> 6), lane = tid & 63, quad = lane >> 4, li = lane & 15, qq = li >> 2, pp = li & 3;
    const bf16_t* X2 = (const bf16_t*)(P.ws + OFF_XB); const float* DTf = (const float*)(P.ws + OFF_DT); const float* CUM = (const float*)(P.ws + OFF_CUM); float* ST = (float*)(P.ws + OFF_RB);
    ldsp Bl = lds, Xl = lds + 69632;
    for (int item = blockIdx.x; item < 256; item += gridDim.x) {
        const int b = item >> 6, c = (item >> 2) & 15, g = item & 3; const size_t rowbase = (size_t)b * 4096 + c * 256;
        __syncthreads();
#pragma unroll
        for (int k = 0; k < 8; ++k) { const int idx = tid + 512 * k, r = idx >> 4, ch = idx & 15; *(LAS u32x4*)(Bl + r * 272 + ch * 16) = *(const u32x4*)(X2 + (rowbase + r) * 3072 + 2048 + g * 128 + ch * 8); }
        for (int hh = 0; hh < 8; ++hh) { const int h = g * 8 + hh;
            __syncthreads();
            const float cl = CUM[(rowbase + 255) * 32 + h];
#pragma unroll
            for (int k = 0; k < 4; ++k) { const int idx = tid + 512 * k, r = idx >> 3, ch = idx & 7; const size_t row = rowbase + r;
                const float w = __expf(cl - CUM[row * 32 + h]) * DTf[row * 32 + h]; const u32x4 v = *(const u32x4*)(X2 + row * 3072 + h * 64 + ch * 8); u32x4 o;
                o.x = pk2(bf_lo(v.x) * w, bf_hi(v.x) * w); o.y = pk2(bf_lo(v.y) * w, bf_hi(v.y) * w); o.z = pk2(bf_lo(v.z) * w, bf_hi(v.z) * w); o.w = pk2(bf_lo(v.w) * w, bf_hi(v.w) * w);
                *(LAS u32x4*)(Xl + r * 160 + ch * 16) = o; }
            __syncthreads();
            f32x4 acc[4];
#pragma unroll
            for (int pt = 0; pt < 4; ++pt) acc[pt] = (f32x4){0.f, 0.f, 0.f, 0.f};
#pragma unroll
            for (int ks = 0; ks < 8; ++ks) { const int l0 = 32 * ks + 8 * quad + qq;
                const bf16x8 bop = cat8(vtr(Bl + l0 * 272 + (16 * wave + 4 * pp) * 2), vtr(Bl + (l0 + 4) * 272 + (16 * wave + 4 * pp) * 2));
#pragma unroll
                for (int pt = 0; pt < 4; ++pt) { const bf16x8 aop = cat8(vtr(Xl + l0 * 160 + (16 * pt + 4 * pp) * 2), vtr(Xl + (l0 + 4) * 160 + (16 * pt + 4 * pp) * 2)); acc[pt] = mfma16(aop, bop, acc[pt]); } }
            float* sp = ST + ((size_t)((b * 16 + c) * 32 + h) * 64) * 128 + 16 * wave + li;
#pragma unroll
            for (int pt = 0; pt < 4; ++pt)
#pragma unroll
                for (int j = 0; j < 4; ++j) sp[(size_t)(16 * pt + 4 * quad + j) * 128] = acc[pt][j];
        }
    }
}
__device__ __forceinline__ void ssd_b_phase(const Params& P) {
    const size_t gtid = (size_t)blockIdx.x * 512 + threadIdx.x, nth = (size_t)gridDim.x * 512;
    const float* ST = (const float*)(P.ws + OFF_RB); bf16_t* SIN = (bf16_t*)(P.ws + OFF_SIN); const float* CUM = (const float*)(P.ws + OFF_CUM);
    for (size_t it = gtid; it < (size_t)4 * 32 * 64 * 32; it += nth) {
        const int n4 = (int)(it & 31), p = (int)((it >> 5) & 63), h = (int)((it >> 11) & 31), b = (int)(it >> 16);
        f32x4 cur = (f32x4){0.f, 0.f, 0.f, 0.f};
#pragma unroll 4
        for (int c = 0; c < 16; ++c) { const size_t base = ((size_t)((b * 16 + c) * 32 + h) * 64 + p) * 128 + 4 * n4;
            u32x2 o; o.x = pk2(cur[0], cur[1]); o.y = pk2(cur[2], cur[3]); *(u32x2*)(SIN + base) = o;
            const float dec = __expf(CUM[((size_t)b * 4096 + c * 256 + 255) * 32 + h]); const f32x4 st = *(const f32x4*)(ST + base); cur = cur * dec + st; }
    }
}
__device__ __forceinline__ void ssd_c_phase(const Params& P, ldsp lds) {
    const int tid = threadIdx.x, wave = __builtin_amdgcn_readfirstlane(tid >> 6), lane = tid & 63, quad = lane >> 4, li = lane & 15, qq = li >> 2, pp = li & 3;
    const bf16_t* X2 = (const bf16_t*)(P.ws + OFF_XB); const float* DTf = (const float*)(P.ws + OFF_DT); const float* CUM = (const float*)(P.ws + OFF_CUM);
    const bf16_t* SIN = (const bf16_t*)(P.ws + OFF_SIN); float* SSQ = (float*)(P.ws + OFF_SSQ); bf16_t* A0 = (bf16_t*)P.out;
    ldsp Bl = lds, Xl = lds + 69632, Sl = lds + 110592; LAS float* cuml = (LAS float*)(lds + 128000); LAS float* dtl = cuml + 256;
    for (int item = blockIdx.x; item < 256; item += gridDim.x) {
        const int b = item >> 6, c = (item >> 2) & 15, g = item & 3; const size_t rowbase = (size_t)b * 4096 + c * 256;
        __syncthreads();
#pragma unroll
        for (int k = 0; k < 8; ++k) { const int idx = tid + 512 * k, r = idx >> 4, ch = idx & 15; *(LAS u32x4*)(Bl + r * 272 + ch * 16) = *(const u32x4*)(X2 + (rowbase + r) * 3072 + 2048 + g * 128 + ch * 8); }
        bf16x8 qf[2][4];
#pragma unroll
        for (int nt = 0; nt < 2; ++nt)
#pragma unroll
            for (int ks = 0; ks < 4; ++ks) qf[nt][ks] = *(const bf16x8*)(X2 + (rowbase + 32 * wave + 16 * nt + li) * 3072 + 2560 + g * 128 + 32 * ks + 8 * quad);
        for (int hh = 0; hh < 8; ++hh) { const int h = g * 8 + hh;
            __syncthreads();
#pragma unroll
            for (int k = 0; k < 4; ++k) { const int idx = tid + 512 * k, r = idx >> 3, ch = idx & 7; *(LAS u32x4*)(Xl + r * 160 + ch * 16) = *(const u32x4*)(X2 + (rowbase + r) * 3072 + h * 64 + ch * 8); }
#pragma unroll
            for (int k = 0; k < 2; ++k) { const int idx = tid + 512 * k, r = idx >> 4, ch = idx & 15; *(LAS u32x4*)(Sl + r * 272 + ch * 16) = *(const u32x4*)(SIN + ((size_t)((b * 16 + c) * 32 + h) * 64 + r) * 128 + ch * 8); }
            if (tid < 256) { cuml[tid] = CUM[(rowbase + tid) * 32 + h]; dtl[tid] = DTf[(rowbase + tid) * 32 + h]; }
            __syncthreads();
            f32x4 oacc[2][4];
#pragma unroll
            for (int nt = 0; nt < 2; ++nt)
#pragma unroll
                for (int pt = 0; pt < 4; ++pt) oacc[nt][pt] = (f32x4){0.f, 0.f, 0.f, 0.f};
#pragma unroll
            for (int pt = 0; pt < 4; ++pt)
#pragma unroll
                for (int ks = 0; ks < 4; ++ks) { const bf16x8 a = *(const LAS bf16x8*)(Sl + (16 * pt + li) * 272 + (32 * ks + 8 * quad) * 2);
                    oacc[0][pt] = mfma16(a, qf[0][ks], oacc[0][pt]); oacc[1][pt] = mfma16(a, qf[1][ks], oacc[1][pt]); }
            int lq[2]; float cq[2];
#pragma unroll
            for (int nt = 0; nt < 2; ++nt) { lq[nt] = 32 * wave + 16 * nt + li; cq[nt] = cuml[lq[nt]]; const float e = __expf(cq[nt]);
#pragma unroll
                for (int pt = 0; pt < 4; ++pt) oacc[nt][pt] *= e; }
            const int nkt = (32 * wave + 31) / 64 + 1;
#pragma unroll 1
            for (int kt = 0; kt < nkt; ++kt) {
                {
                    f32x4 sacc[2][4];
#pragma unroll
                    for (int nt = 0; nt < 2; ++nt)
#pragma unroll
                        for (int mt = 0; mt < 4; ++mt) sacc[nt][mt] = (f32x4){0.f, 0.f, 0.f, 0.f};
#pragma unroll
                    for (int mt = 0; mt < 4; ++mt)
#pragma unroll
                        for (int ks = 0; ks < 4; ++ks) { const bf16x8 a = *(const LAS bf16x8*)(Bl + (64 * kt + 16 * mt + li) * 272 + (32 * ks + 8 * quad) * 2);
                            sacc[0][mt] = mfma16(a, qf[0][ks], sacc[0][mt]); sacc[1][mt] = mfma16(a, qf[1][ks], sacc[1][mt]); }
#pragma unroll
                    for (int mt = 0; mt < 4; ++mt) { const int s0 = 64 * kt + 16 * mt + 4 * quad; const f32x4 cs = *(const LAS f32x4*)(cuml + s0), ds = *(const LAS f32x4*)(dtl + s0);
#pragma unroll
                        for (int nt = 0; nt < 2; ++nt)
#pragma unroll
                            for (int j = 0; j < 4; ++j) { const float v = sacc[nt][mt][j] * __expf(cq[nt] - cs[j]) * ds[j]; sacc[nt][mt][j] = (s0 + j <= lq[nt]) ? v : 0.f; } }
                    bf16x8 pb[2][2];
#pragma unroll
                    for (int nt = 0; nt < 2; ++nt)
#pragma unroll
                        for (int kk = 0; kk < 2; ++kk) { u32x4 t; t.x = pk2(sacc[nt][2 * kk][0], sacc[nt][2 * kk][1]); t.y = pk2(sacc[nt][2 * kk][2], sacc[nt][2 * kk][3]);
                            t.z = pk2(sacc[nt][2 * kk + 1][0], sacc[nt][2 * kk + 1][1]); t.w = pk2(sacc[nt][2 * kk + 1][2], sacc[nt][2 * kk + 1][3]); pb[nt][kk] = __builtin_bit_cast(bf16x8, t); }
#pragma unroll
                    for (int pt = 0; pt < 4; ++pt)
#pragma unroll
                        for (int kk = 0; kk < 2; ++kk) { const int r0 = 64 * kt + 32 * kk + 4 * quad + qq;
                            const bf16x8 a = cat8(vtr(Xl + r0 * 160 + (16 * pt + 4 * pp) * 2), vtr(Xl + (r0 + 16) * 160 + (16 * pt + 4 * pp) * 2));
                            oacc[0][pt] = mfma16(a, pb[0][kk], oacc[0][pt]); oacc[1][pt] = mfma16(a, pb[1][kk], oacc[1][pt]); }
                }
            }
            const float Dh = P.ssd_d[h];
#pragma unroll
            for (int nt = 0; nt < 2; ++nt) { const size_t row = rowbase + lq[nt]; float ss = 0.f;
#pragma unroll
                for (int pt = 0; pt < 4; ++pt) { const int col = h * 64 + 16 * pt + 4 * quad; const u32x2 xs = *(const u32x2*)(X2 + row * 3072 + col); const u32x2 z = *(const u32x2*)(A0 + row * 4096 + col);
                    const float t0 = (oacc[nt][pt][0] + Dh * bf_lo(xs.x)) * silu_f(bf_lo(z.x)), t1 = (oacc[nt][pt][1] + Dh * bf_hi(xs.x)) * silu_f(bf_hi(z.x));
                    const float t2 = (oacc[nt][pt][2] + Dh * bf_lo(xs.y)) * silu_f(bf_lo(z.y)), t3 = (oacc[nt][pt][3] + Dh * bf_hi(xs.y)) * silu_f(bf_hi(z.y));
                    ss += (t0 * t0 + t1 * t1) + (t2 * t2 + t3 * t3); u32x2 o; o.x = pk2(t0, t1); o.y = pk2(t2, t3); *(u32x2*)(A0 + row * 4096 + col) = o; }
                ss += __shfl_xor(ss, 16); ss += __shfl_xor(ss, 32);
                if (quad == 0) SSQ[row * 32 + h] = ss; }
        }
    }
}

__device__ __forceinline__ void moba_phase(const Params& P, ldsp lds, bf16_t* obase, int old_, unsigned rmask) {
    const int tid = threadIdx.x, wave = __builtin_amdgcn_readfirstlane(tid >> 6), lane = tid & 63, quad = lane >> 4, li = lane & 15, qq = li >> 2, pp = li & 3;
    bf16_t* A0 = (bf16_t*)P.out; const bf16_t* Kb = (const bf16_t*)(P.ws + OFF_K); const bf16_t* Vb = (const bf16_t*)(P.ws + OFF_V); const bf16_t* Gb = (const bf16_t*)(P.ws + OFF_G);
    const float* kmean = (const float*)(P.ws + OFF_KM);
    ldsp Kl = lds, Vl = lds + 34816; LAS float* gl = (LAS float*)(lds + 71680); LAS float* kml = (LAS float*)(lds + 89088); LAS unsigned* selm = (LAS unsigned*)(lds + 97280);
    const float c2 = 0.08838834764831845f * 1.4426950408889634f;
    const int G = gridDim.x, cb = blockIdx.x;
    const int sr = tid >> 4, sc = tid & 15;
    for (int kr = 0; kr * G < 1024; ++kr) {
        const int idx = (kr & 1) ? (kr * G + G - 1 - cb) : (kr * G + cb);
        if (idx >= 1024) continue;
        const int i = 15 - (idx >> 6), b = (idx & 63) >> 4, h = idx & 15;
        const size_t qrow0 = (size_t)b * 4096 + i * 256;
        __syncthreads();
        { const float* kq = kmean + (size_t)((b * 16 + h) * 16) * 128 + tid * 4; f32x4 v = *(const f32x4*)kq + *(const f32x4*)(kq + 131072); v *= (1.f / 256.f); *(LAS f32x4*)(kml + tid * 4) = v; }
        __syncthreads();
        { const int r = tid >> 1, hf = tid & 1; const bf16_t* qp = A0 + (qrow0 + r) * 4096 + 2048 + h * 128; float gs[8];
#pragma unroll
          for (int jb = 0; jb < 8; ++jb) gs[jb] = 0.f;
#pragma unroll 2
          for (int dc = 0; dc < 16; ++dc) { const u32x4 qv = *(const u32x4*)(qp + dc * 8);
              const float q0 = bf_lo(qv.x), q1 = bf_hi(qv.x), q2 = bf_lo(qv.y), q3 = bf_hi(qv.y), q4 = bf_lo(qv.z), q5 = bf_hi(qv.z), q6 = bf_lo(qv.w), q7 = bf_hi(qv.w);
#pragma unroll
              for (int jb = 0; jb < 8; ++jb) { const LAS float* kp = kml + (hf * 8 + jb) * 128 + dc * 8; const f32x4 k0 = *(const LAS f32x4*)kp, k1 = *(const LAS f32x4*)(kp + 4);
                  gs[jb] += (q0 * k0[0] + q1 * k0[1]) + (q2 * k0[2] + q3 * k0[3]) + (q4 * k1[0] + q5 * k1[1]) + (q6 * k1[2] + q7 * k1[3]); } }
#pragma unroll
          for (int jb = 0; jb < 8; ++jb) gl[r * 17 + hf * 8 + jb] = gs[jb]; }
        __syncthreads();
        if (tid < 256) { unsigned mask = 0u; const int nsel = i < 3 ? i : 3;
            for (int s = 0; s < nsel; ++s) { float best = -INFINITY; int bj = -1;
                for (int j = 0; j < i; ++j) { const float v = gl[tid * 17 + j]; if (!((mask >> j) & 1u) && v > best) { best = v; bj = j; } }
                if (bj >= 0) mask |= 1u << bj; }
            selm[tid] = mask; }
        bf16x8 qf[2][4];
#pragma unroll
        for (int nt = 0; nt < 2; ++nt)
#pragma unroll
            for (int ks = 0; ks < 4; ++ks) qf[nt][ks] = *(const bf16x8*)(A0 + (qrow0 + 32 * wave + 16 * nt + li) * 4096 + 2048 + h * 128 + 32 * ks + 8 * quad);
        const int ntile = 4 * (i + 1);
        u32x4 kreg[2], vreg[2];
        { const size_t kr0 = (qrow0 + sr) * 2048 + h * 128 + sc * 8;
          kreg[0] = *(const u32x4*)(Kb + kr0); kreg[1] = *(const u32x4*)(Kb + kr0 + 32 * 2048); vreg[0] = *(const u32x4*)(Vb + kr0); vreg[1] = *(const u32x4*)(Vb + kr0 + 32 * 2048); }
        *(LAS u32x4*)(Kl + sr * 272 + sc * 16) = kreg[0]; *(LAS u32x4*)(Kl + (sr + 32) * 272 + sc * 16) = kreg[1];
        *(LAS u32x4*)(Vl + sr * 288 + sc * 16) = vreg[0]; *(LAS u32x4*)(Vl + (sr + 32) * 288 + sc * 16) = vreg[1];
        __syncthreads();
        unsigned sel[2]; float mrun[2], lrun[2]; f32x4 oacc[2][8];
#pragma unroll
        for (int nt = 0; nt < 2; ++nt) { sel[nt] = selm[32 * wave + 16 * nt + li]; mrun[nt] = -1e30f; lrun[nt] = 0.f;
#pragma unroll
            for (int dt = 0; dt < 8; ++dt) oacc[nt][dt] = (f32x4){0.f, 0.f, 0.f, 0.f}; }
        for (int tt = 0; tt < ntile; ++tt) {
            const int buf = tt & 1;
            u32x4 kn0, kn1, vn0, vn1;
            { const int t1 = (tt + 1 < ntile) ? tt + 1 : tt; const int jb = (t1 < 4) ? i : (t1 >> 2) - 1; const int kt1 = t1 & 3;
                const size_t kr0 = ((size_t)b * 4096 + jb * 256 + kt1 * 64 + sr) * 2048 + h * 128 + sc * 8;
                kn0 = *(const u32x4*)(Kb + kr0); kn1 = *(const u32x4*)(Kb + kr0 + 32 * 2048); vn0 = *(const u32x4*)(Vb + kr0); vn1 = *(const u32x4*)(Vb + kr0 + 32 * 2048); }
            const bool own = tt < 4; const int kt = tt & 3; const int jblk = own ? i : (tt >> 2) - 1;
            bool active;
            if (own) active = (64 * kt <= 32 * wave + 31); else active = __any((int)(((sel[0] | sel[1]) >> jblk) & 1u)) != 0;
            if (active) {
                ldsp Kt = Kl + buf * 17408; ldsp Vt = Vl + buf * 18432;
                f32x4 sacc[2][4];
#pragma unroll
                for (int nt = 0; nt < 2; ++nt)
#pragma unroll
                    for (int mt = 0; mt < 4; ++mt) sacc[nt][mt] = (f32x4){0.f, 0.f, 0.f, 0.f};
                { bf16x8 kf[2][4];
#pragma unroll
                  for (int ks = 0; ks < 4; ++ks) kf[0][ks] = *(const LAS bf16x8*)(Kt + li * 272 + (32 * ks + 8 * quad) * 2);
#pragma unroll
                  for (int mt = 0; mt < 4; ++mt) {
                      if (mt < 3) {
#pragma unroll
                          for (int ks = 0; ks < 4; ++ks) kf[(mt + 1) & 1][ks] = *(const LAS bf16x8*)(Kt + (16 * (mt + 1) + li) * 272 + (32 * ks + 8 * quad) * 2); }
                      __builtin_amdgcn_sched_barrier(0);
#pragma unroll
                      for (int ks = 0; ks < 4; ++ks) { sacc[0][mt] = mfma16(kf[mt & 1][ks], qf[0][ks], sacc[0][mt]); sacc[1][mt] = mfma16(kf[mt & 1][ks], qf[1][ks], sacc[1][mt]); }
                      __builtin_amdgcn_sched_barrier(0);
                  } }
                bf16x8 pb[2][2];
#pragma unroll
                for (int nt = 0; nt < 2; ++nt) { const int qpos = 32 * wave + 16 * nt + li; const bool selj = ((sel[nt] >> jblk) & 1u) != 0u; float alpha, ps = 0.f;
                    if (own) {
                        float mx = -1e30f;
#pragma unroll
                        for (int mt = 0; mt < 4; ++mt)
#pragma unroll
                            for (int j = 0; j < 4; ++j) { const int kpos = 64 * kt + 16 * mt + 4 * quad + j;
                                const float s = (kpos <= qpos) ? sacc[nt][mt][j] * c2 : -1e30f; sacc[nt][mt][j] = s; mx = fmaxf(mx, s); }
                        mx = fmaxf(mx, __shfl_xor(mx, 16)); mx = fmaxf(mx, __shfl_xor(mx, 32));
                        const float mnew = fmaxf(mrun[nt], mx); alpha = __builtin_amdgcn_exp2f(mrun[nt] - mnew); mrun[nt] = mnew;
#pragma unroll
                        for (int mt = 0; mt < 4; ++mt)
#pragma unroll
                            for (int j = 0; j < 4; ++j) { const float p = __builtin_amdgcn_exp2f(sacc[nt][mt][j] - mnew); sacc[nt][mt][j] = p; ps += p; }
                    } else {
                        const float bias = selj ? 0.f : -1e30f; float mx = sacc[nt][0][0];
#pragma unroll
                        for (int mt = 0; mt < 4; ++mt)
#pragma unroll
                            for (int j = 0; j < 4; ++j) mx = fmaxf(mx, sacc[nt][mt][j]);
                        mx = fmaxf(mx, __shfl_xor(mx, 16)); mx = fmaxf(mx, __shfl_xor(mx, 32));
                        const float mnew = fmaxf(mrun[nt], fmaf(mx, c2, bias)); alpha = __builtin_amdgcn_exp2f(mrun[nt] - mnew); mrun[nt] = mnew; const float nb = bias - mnew;
#pragma unroll
                        for (int mt = 0; mt < 4; ++mt)
#pragma unroll
                            for (int j = 0; j < 4; ++j) { const float p = __builtin_amdgcn_exp2f(fmaf(sacc[nt][mt][j], c2, nb)); sacc[nt][mt][j] = p; ps += p; }
                    }
                    lrun[nt] = lrun[nt] * alpha + ps;
#pragma unroll
                    for (int dt = 0; dt < 8; ++dt) oacc[nt][dt] *= alpha;
#pragma unroll
                    for (int kk = 0; kk < 2; ++kk) { u32x4 t; t.x = pk2(sacc[nt][2 * kk][0], sacc[nt][2 * kk][1]); t.y = pk2(sacc[nt][2 * kk][2], sacc[nt][2 * kk][3]);
                        t.z = pk2(sacc[nt][2 * kk + 1][0], sacc[nt][2 * kk + 1][1]); t.w = pk2(sacc[nt][2 * kk + 1][2], sacc[nt][2 * kk + 1][3]); pb[nt][kk] = __builtin_bit_cast(bf16x8, t); }
                }
                { bf16x8 vf[2][2]; const ldsp vbase = Vt + (4 * quad + qq) * 288 + 8 * pp;
#pragma unroll
                  for (int kk = 0; kk < 2; ++kk) vf[0][kk] = cat8(vtr(vbase + (32 * kk) * 288), vtr(vbase + (32 * kk + 16) * 288));
#pragma unroll
                  for (int dt = 0; dt < 8; ++dt) {
                      if (dt < 7) {
#pragma unroll
                          for (int kk = 0; kk < 2; ++kk) vf[(dt + 1) & 1][kk] = cat8(vtr(vbase + (32 * kk) * 288 + 32 * (dt + 1)), vtr(vbase + (32 * kk + 16) * 288 + 32 * (dt + 1))); }
                      __builtin_amdgcn_sched_barrier(0);
#pragma unroll
                      for (int kk = 0; kk < 2; ++kk) { oacc[0][dt] = mfma16(vf[dt & 1][kk], pb[0][kk], oacc[0][dt]); oacc[1][dt] = mfma16(vf[dt & 1][kk], pb[1][kk], oacc[1][dt]); }
                      __builtin_amdgcn_sched_barrier(0);
                  } }
            }
            { ldsp Kn = Kl + (buf ^ 1) * 17408; ldsp Vn = Vl + (buf ^ 1) * 18432;
                *(LAS u32x4*)(Kn + sr * 272 + sc * 16) = kn0; *(LAS u32x4*)(Kn + (sr + 32) * 272 + sc * 16) = kn1;
                *(LAS u32x4*)(Vn + sr * 288 + sc * 16) = vn0; *(LAS u32x4*)(Vn + (sr + 32) * 288 + sc * 16) = vn1; }
            __syncthreads();
        }
#pragma unroll
        for (int nt = 0; nt < 2; ++nt) { float l = lrun[nt]; l += __shfl_xor(l, 16); l += __shfl_xor(l, 32); const float inv = 1.f / l; const size_t row = qrow0 + 32 * wave + 16 * nt + li;
#pragma unroll
            for (int dt = 0; dt < 8; ++dt) { const int col = h * 128 + 16 * dt + 4 * quad; const u32x2 gv = *(const u32x2*)(Gb + row * 2048 + col);
                u32x2 o; o.x = pk2(oacc[nt][dt][0] * inv * bf_lo(gv.x), oacc[nt][dt][1] * inv * bf_hi(gv.x)); o.y = pk2(oacc[nt][dt][2] * inv * bf_lo(gv.y), oacc[nt][dt][3] * inv * bf_hi(gv.y));
                *(u32x2*)(obase + (size_t)((unsigned)row & rmask) * old_ + col) = o; } }
    }
}

__device__ __forceinline__ void ln_phase(const float* Y, const float* g, const float* bta, float* outf, bf16_t* outb, int ldb_) {
    const int lane = threadIdx.x & 63; const int gw = blockIdx.x * 8 + __builtin_amdgcn_readfirstlane(threadIdx.x >> 6), NGW = gridDim.x * 8;
    f32x4 gv[8], bv[8];
#pragma unroll
    for (int k = 0; k < 8; ++k) { gv[k] = ((const f32x4*)g)[lane + 64 * k]; bv[k] = ((const f32x4*)bta)[lane + 64 * k]; }
    for (int row = gw; row < M; row += NGW) { const f32x4* yr = (const f32x4*)(Y + (size_t)row * 2048); f32x4 v[8]; float s = 0.f;
#pragma unroll
        for (int k = 0; k < 8; ++k) { v[k] = yr[lane + 64 * k]; s += (v[k][0] + v[k][1]) + (v[k][2] + v[k][3]); }
#pragma unroll
        for (int o = 1; o < 64; o <<= 1) s += __shfl_xor(s, o);
        const float mu = s * (1.f / 2048.f); float s2 = 0.f;
#pragma unroll
        for (int k = 0; k < 8; ++k) { v[k] = v[k] - mu; s2 += (v[k][0] * v[k][0] + v[k][1] * v[k][1]) + (v[k][2] * v[k][2] + v[k][3] * v[k][3]); }
#pragma unroll
        for (int o = 1; o < 64; o <<= 1) s2 += __shfl_xor(s2, o);
        const float rstd = rsqrtf(s2 * (1.f / 2048.f) + 1e-5f);
#pragma unroll
        for (int k = 0; k < 8; ++k) { const f32x4 o = v[k] * rstd * gv[k] + bv[k]; ((f32x4*)(outf + (size_t)row * 2048))[lane + 64 * k] = o;
            if (outb) { u32x2 ob; ob.x = pk2(o[0], o[1]); ob.y = pk2(o[2], o[3]); ((u32x2*)(outb + (size_t)row * ldb_))[lane + 64 * k] = ob; } }
    }
}

__device__ __forceinline__ void s5_phase(const Params& P, ldsp lds) {
    const int tid = threadIdx.x, wave = __builtin_amdgcn_readfirstlane(tid >> 6), lane = tid & 63, quad = lane >> 4, li = lane & 15, qq = li >> 2, pp = li & 3;
    const bf16_t* U = (const bf16_t*)(P.ws + OFF_K); bf16_t* YG = (bf16_t*)(P.ws + OFF_RB);
    const int sq = wave >> 2, role = (wave + 2 * sq) & 3;
    ldsp BUl = lds + sq * 32768; ldsp Hl = lds + sq * 32768 + 20480; ldsp Rl = lds + 65536 + sq * 8192;
    for (int it0 = blockIdx.x; it0 < 256; it0 += gridDim.x) {
        const int item = it0 + 256 * sq;
        const int b = item >> 7, g = item & 127;
        const float dtg = expf(P.log_dt[g]);
        float lbr = 0.f, lbi = 0.f; bf16x8 bbf[8], cmf[4]; f32x4 dsk = (f32x4){0.f, 0.f, 0.f, 0.f};
        if (role == 1) { const float lr = P.lam_re[g * 64 + lane], lim = P.lam_im[g * 64 + lane]; const float e = expf(lr * dtg); float s_, c_; sincos_d((double)(lim * dtg), s_, c_); lbr = e * c_; lbi = e * s_; }
        if (role == 0) {
            float lr4[4], li4[4]; f32x4 brr[4][2], bir[4][2];
#pragma unroll
            for (int q = 0; q < 4; ++q) { const int n = 16 * q + li; lr4[q] = P.lam_re[g * 64 + n]; li4[q] = P.lam_im[g * 64 + n];
                const float* br = P.b_re + ((size_t)(g * 64 + n)) * 16 + 8 * (quad & 1); const float* bi = P.b_im + ((size_t)(g * 64 + n)) * 16 + 8 * (quad & 1);
                brr[q][0] = *(const f32x4*)br; brr[q][1] = *(const f32x4*)(br + 4); bir[q][0] = *(const f32x4*)bi; bir[q][1] = *(const f32x4*)(bi + 4); }
#pragma unroll
            for (int q = 0; q < 4; ++q) { const float lr = lr4[q], lim = li4[q]; const float e = expf(lr * dtg); float s_, c_; sincos_d((double)(lim * dtg), s_, c_);
                const float ar = e * c_ - 1.f, aim = e * s_; const float den = 1.f / (lr * lr + lim * lim); const float cr = (ar * lr + aim * lim) * den, ci = (aim * lr - ar * lim) * den;
                float ore[8], oim[8];
#pragma unroll
                for (int e2 = 0; e2 < 8; ++e2) { const float xr = brr[q][e2 >> 2][e2 & 3], xi = bir[q][e2 >> 2][e2 & 3]; ore[e2] = cr * xr - ci * xi; oim[e2] = cr * xi + ci * xr; }
                u32x4 tr_ = (u32x4){0u, 0u, 0u, 0u}, ti_ = (u32x4){0u, 0u, 0u, 0u};
                if (quad < 2) { tr_.x = pk2(ore[0], ore[1]); tr_.y = pk2(ore[2], ore[3]); tr_.z = pk2(ore[4], ore[5]); tr_.w = pk2(ore[6], ore[7]);
                                ti_.x = pk2(oim[0], oim[1]); ti_.y = pk2(oim[2], oim[3]); ti_.z = pk2(oim[4], oim[5]); ti_.w = pk2(oim[6], oim[7]); }
                bbf[q] = __builtin_bit_cast(bf16x8, tr_); bbf[q + 4] = __builtin_bit_cast(bf16x8, ti_); }
        }
        if (role == 2) {
            f32x4 cr_[4][2];
#pragma unroll
            for (int ks = 0; ks < 4; ++ks) { const float* cp = (ks < 2 ? P.c_re : P.c_im) + ((size_t)(g * 16 + li)) * 64 + 32 * (ks & 1) + 8 * quad; cr_[ks][0] = *(const f32x4*)cp; cr_[ks][1] = *(const f32x4*)(cp + 4); }
            dsk = *(const f32x4*)(P.s5_d + g * 16 + 4 * quad);
#pragma unroll
            for (int ks = 0; ks < 4; ++ks) { const float sg = ks < 2 ? 1.f : -1.f; const f32x4 a_ = cr_[ks][0] * sg, b_ = cr_[ks][1] * sg;
                u32x4 t; t.x = pk2(a_[0], a_[1]); t.y = pk2(a_[2], a_[3]); t.z = pk2(b_[0], b_[1]); t.w = pk2(b_[2], b_[3]); cmf[ks] = __builtin_bit_cast(bf16x8, t); }
        }
        const bf16_t* ub = U + ((size_t)b * 4096) * 2048 + g * 16;
        bf16_t* yb = YG + ((size_t)b * 4096) * 2048 + g * 16;
        float hr = 0.f, hi = 0.f;
#define S5_BAR() do { asm volatile("s_waitcnt lgkmcnt(0)" ::: "memory"); __builtin_amdgcn_s_barrier(); asm volatile("" ::: "memory"); } while (0)
#define S5_DMA(st) __builtin_amdgcn_global_load_lds((const unsigned*)(ub + (size_t)((st) * 16 + li) * 2048 + 8 * (quad & 1)), (LAS unsigned*)(Rl + ((st) & 7) * 1024), 16, 0, 0)
        if (role == 3) {
            S5_DMA(0); S5_DMA(1); S5_DMA(2); S5_DMA(3);
            asm volatile("s_waitcnt vmcnt(0)" ::: "memory"); S5_BAR();
            for (int s = -1; s <= 256; ++s) { if (s + 5 < 256) S5_DMA(s + 5); asm volatile("s_waitcnt vmcnt(2)" ::: "memory"); S5_BAR(); }
        } else if (role == 0) {
            S5_BAR();
            for (int s = -1; s <= 256; ++s) {
                if (s + 1 < 256) { u32x4 areg = *(const LAS u32x4*)(Rl + ((s + 1) & 7) * 1024 + lane * 16); if (quad >= 2) areg = (u32x4){0u, 0u, 0u, 0u};
                    const bf16x8 a_ = __builtin_bit_cast(bf16x8, areg); ldsp bw_ = BUl + ((s + 1) & 1) * 10240;
#pragma unroll
                    for (int tile = 0; tile < 8; ++tile) { const f32x4 bu = mfma16(a_, bbf[tile], (f32x4){0.f, 0.f, 0.f, 0.f}); *(LAS f32x4*)(bw_ + (16 * tile + li) * 80 + 16 * quad) = bu; } }
                S5_BAR(); }
        } else if (role == 1) {
            S5_BAR();
            for (int s = -1; s <= 256; ++s) {
                if (s >= 0 && s < 256) { f32x4 br[4], bi[4]; ldsp br_ = BUl + (s & 1) * 10240;
#pragma unroll
                    for (int q = 0; q < 4; ++q) { br[q] = *(const LAS f32x4*)(br_ + lane * 80 + 16 * q); bi[q] = *(const LAS f32x4*)(br_ + (64 + lane) * 80 + 16 * q); }
                    float hrs[16], his[16];
#pragma unroll
                    for (int t = 0; t < 16; ++t) { const float nr = lbr * hr - lbi * hi + br[t >> 2][t & 3], ni = lbr * hi + lbi * hr + bi[t >> 2][t & 3]; hr = nr; hi = ni; hrs[t] = hr; his[t] = hi; }
                    ldsp hw_ = Hl + (s & 1) * 6144;
#pragma unroll
                    for (int q = 0; q < 2; ++q) { u32x4 wr_, wi_;
                        wr_.x = pk2(hrs[8 * q + 0], hrs[8 * q + 1]); wr_.y = pk2(hrs[8 * q + 2], hrs[8 * q + 3]); wr_.z = pk2(hrs[8 * q + 4], hrs[8 * q + 5]); wr_.w = pk2(hrs[8 * q + 6], hrs[8 * q + 7]);
                        wi_.x = pk2(his[8 * q + 0], his[8 * q + 1]); wi_.y = pk2(his[8 * q + 2], his[8 * q + 3]); wi_.z = pk2(his[8 * q + 4], his[8 * q + 5]); wi_.w = pk2(his[8 * q + 6], his[8 * q + 7]);
                        *(LAS u32x4*)(hw_ + lane * 48 + 16 * q) = wr_; *(LAS u32x4*)(hw_ + (64 + lane) * 48 + 16 * q) = wi_; } }
                S5_BAR(); }
        } else {
            S5_BAR();
            for (int s = -1; s <= 256; ++s) {
                if (s >= 1) { const u32x2 uu = *(const LAS u32x2*)(Rl + ((s - 1) & 7) * 1024 + (li + 16 * (quad >> 1)) * 16 + 8 * (quad & 1));
                    ldsp hp_ = Hl + ((s - 1) & 1) * 6144; f32x4 yacc = (f32x4){0.f, 0.f, 0.f, 0.f};
#pragma unroll
                    for (int ks = 0; ks < 4; ++ks) { const int r0 = 32 * ks + 8 * quad + qq; const bf16x8 bop = cat8(vtr(hp_ + r0 * 48 + 8 * pp), vtr(hp_ + (r0 + 4) * 48 + 8 * pp)); yacc = mfma16(cmf[ks], bop, yacc); }
                    const float y0 = yacc[0] + dsk[0] * bf_lo(uu.x), y1 = yacc[1] + dsk[1] * bf_hi(uu.x), y2 = yacc[2] + dsk[2] * bf_lo(uu.y), y3 = yacc[3] + dsk[3] * bf_hi(uu.y);
                    u32x2 o; o.x = pk2(gelu_tanh_f(y0), gelu_tanh_f(y1)); o.y = pk2(gelu_tanh_f(y2), gelu_tanh_f(y3)); *(u32x2*)(yb + (size_t)((s - 1) * 16 + li) * 2048 + 4 * quad) = o; }
                S5_BAR(); }
        }
#undef S5_BAR
#undef S5_DMA
        asm volatile("s_waitcnt vmcnt(0) lgkmcnt(0)" ::: "memory"); __syncthreads();
    }
}

template <class Epi> __device__ __forceinline__ void run_gemm(ldsp lds, const bf16_t* A, int lda, const bf16_t* Bt, int ldb, int N, int K, const Epi& E) {
    pg8::Gemm g; g.A = A; g.Bt = Bt; g.M = M; g.N = N; g.K = K; g.lda = lda; g.ldb = ldb; g.alias_a = 0;
    pg8::StaticOrder S; S.init(M, N, (int)gridDim.x, (int)blockIdx.x);
#if GEMM_SKEW_TICKS > 0
    {
      const unsigned sk = (unsigned)GEMM_SKEW_TICKS * (((blockIdx.x >> 3) & 7u) + ((blockIdx.x >> 6) & 3u));
      if (threadIdx.x == 0) { const unsigned long long t0 = __builtin_amdgcn_s_memrealtime(); while (__builtin_amdgcn_s_memrealtime() - t0 < sk) __builtin_amdgcn_s_sleep(8); }
      __syncthreads(); }
#endif
    pg8::gemm_phase<Epi, pg8::StaticOrder, false>(lds, g, S, E, nullptr);
}

__device__ __forceinline__ void gsync(cg::grid_group& grid) {
    asm volatile("s_waitcnt vmcnt(0) lgkmcnt(0)" ::: "memory");
    __syncthreads();
    if (threadIdx.x < 64) { __builtin_amdgcn_fence(__ATOMIC_RELEASE, "agent"); asm volatile("s_waitcnt vmcnt(0)" ::: "memory"); }
    grid.sync();
#if GSYNC_WAVE_ACQ
    __builtin_amdgcn_fence(__ATOMIC_ACQUIRE, ""); asm volatile("s_waitcnt vmcnt(0)" ::: "memory");
#else
    if (threadIdx.x < 64) { __builtin_amdgcn_fence(__ATOMIC_ACQUIRE, "agent"); asm volatile("s_waitcnt vmcnt(0)" ::: "memory"); }
#endif
    __syncthreads();
}
#ifndef REP_P0
#define REP_P0 1
#endif
#ifndef REP_IN0
#define REP_IN0 1
#endif
#ifndef REP_CONV
#define REP_CONV 1
#endif
#ifndef REP_MOBA_DUMMY
#define REP_MOBA_DUMMY 0
#endif
#ifndef REP_SSDA
#define REP_SSDA 1
#endif
#ifndef REP_SSDB
#define REP_SSDB 1
#endif
#ifndef REP_LN0
#define REP_LN0 1
#endif
#ifndef REP_IN1
#define REP_IN1 1
#endif
#ifndef REP_S5
#define REP_S5 1
#endif
#ifndef PHASE_MASK
#define PHASE_MASK 0x3fff
#endif
#if defined(__HIP_DEVICE_COMPILE__)
#define GETP() ({ const __attribute__((address_space(4))) Params* kp_ = (const __attribute__((address_space(4))) Params*)__builtin_amdgcn_kernarg_segment_ptr(); asm volatile("" : "+s"(kp_)); *kp_; })
#else
#define GETP() (P_unused)
#endif
__global__ void __launch_bounds__(512, 2) mega_fwd(Params P_unused) {
    constexpr int PM = PHASE_MASK;
    extern __shared__ __attribute__((aligned(16))) unsigned char shm[];
    ldsp lds = (ldsp)shm;
    cg::grid_group grid = cg::this_grid();
    for (int rep = 0; rep < REP_P0; ++rep) { const Params P = GETP(); p0_phase(P, lds); }
    gsync(grid);
    for (int rep = 0; rep < REP_IN0; ++rep) { const Params P = GETP(); unsigned char* ws = P.ws;
      EpiIn0 E; E.A0 = (bf16_t*)P.out; E.XBCraw = (bf16_t*)(ws + OFF_RB); E.Kb = (bf16_t*)(ws + OFF_K); E.Vb = (bf16_t*)(ws + OFF_V); E.Gb = (bf16_t*)(ws + OFF_G);
      E.DTf = (float*)(ws + OFF_DT); E.kmean = (float*)(ws + OFF_KM); E.ctab = (const float*)(ws + OFF_CT); E.stab = (const float*)(ws + OFF_STB); E.dt_bias = P.dt_bias;
      run_gemm(lds, (const bf16_t*)(ws + OFF_XB), 2048, (const bf16_t*)(ws + OFF_W0T), 2048, N0P, 2048, E); }
    gsync(grid);
    for (int rep = 0; rep < REP_CONV; ++rep) { const Params P = GETP(); conv_phase(P); }
    gsync(grid);
    for (int rep = 0; rep < REP_MOBA_DUMMY; ++rep) { const Params P = GETP(); moba_phase(P, lds, (bf16_t*)(P.ws + WS_END), 2048, 4095u); }
    if (PM & 8) { const Params P = GETP(); moba_phase(P, lds, (bf16_t*)P.out + 2048, 4096, 0xffffffffu); }
    for (int rep = 0; rep < REP_SSDA; ++rep) { const Params P = GETP(); ssd_a_phase(P, lds); }
    gsync(grid);
    for (int rep = 0; rep < REP_SSDB; ++rep) { const Params P = GETP(); ssd_b_phase(P); }
    gsync(grid);
    if (PM & 64) { const Params P = GETP(); ssd_c_phase(P, lds); }
    gsync(grid);
    if (PM & 128) { const Params P = GETP(); unsigned char* ws = P.ws;
      EpiOut<32> E; E.resid = P.x; E.Y = (float*)(ws + OFF_K); E.rsl = (const LAS float*)(lds + 131072);
      { pg8::StaticOrder S; S.init(M, 2048, (int)gridDim.x, (int)blockIdx.x); const float* ssq = (const float*)(ws + OFF_SSQ); LAS float* rw = (LAS float*)(lds + 131072);
        for (int q = threadIdx.x; q < 2048; q += 512) { const int ui = q >> 8; Unit u; if (S.next(ui, u)) { const f32x4* p = (const f32x4*)(ssq + (size_t)(u.pm * 256 + (q & 255)) * 32); float sm = 0.f;
#pragma unroll
            for (int k = 0; k < 8; ++k) { const f32x4 v = p[k]; sm += (v[0] + v[1]) + (v[2] + v[3]); }
            rw[q] = rsqrtf(sm * (1.f / 2048.f) + 1e-5f); } }
        __syncthreads(); }
      run_gemm(lds, (const bf16_t*)P.out, 4096, (const bf16_t*)(ws + OFF_WO0), 4096, 2048, 4096, E); }
    gsync(grid);
    for (int rep = 0; rep < REP_LN0; ++rep) { const Params P = GETP(); unsigned char* ws = P.ws; ln_phase((const float*)(ws + OFF_K), P.ln_g, P.ln_b, P.out, (bf16_t*)(ws + X1B_OFF), X1B_LD); }
    gsync(grid);
#ifdef PROBE_L2GEMM
    { const Params P = GETP(); unsigned char* ws = P.ws; EpiIn1 E; E.U = (bf16_t*)(ws + OFF_XB); E.SG = (bf16_t*)(ws + OFF_RB);
      pg8::Gemm g; g.A = (const bf16_t*)(ws + X1B_OFF); g.Bt = (const bf16_t*)(ws + W1_OFF); g.M = M; g.N = 4096; g.K = 2048; g.lda = X1B_LD; g.ldb = W1_LD; g.alias_a = 1;
      pg8::StaticOrder S; S.init(M, 4096, (int)gridDim.x, (int)blockIdx.x); pg8::gemm_phase<EpiIn1, pg8::StaticOrder, false>(lds, g, S, E, nullptr); }
#endif
    for (int rep = 0; rep < REP_IN1; ++rep) { const Params P = GETP(); unsigned char* ws = P.ws;
      EpiIn1 E; E.U = (bf16_t*)(ws + OFF_K); E.SG = (bf16_t*)(ws + OFF_V);
      run_gemm(lds, (const bf16_t*)(ws + X1B_OFF), X1B_LD, (const bf16_t*)(ws + W1_OFF), W1_LD, 4096, 2048, E); }
    gsync(grid);
    for (int rep = 0; rep < REP_S5; ++rep) { const Params P = GETP(); s5_phase(P, lds); }
    gsync(grid);
    if (PM & 2048) { const Params P = GETP(); unsigned char* ws = P.ws;
      EpiGlu E; E.A1 = (bf16_t*)(ws + OFF_XB); E.SG = (const bf16_t*)(ws + OFF_V);
      run_gemm(lds, (const bf16_t*)(ws + OFF_RB), 2048, (const bf16_t*)(ws + OFF_WG), 2048, 4096, 2048, E); }
    gsync(grid);
    if (PM & 4096) { const Params P = GETP(); unsigned char* ws = P.ws;
      EpiOut<-1> E; E.resid = P.out; E.Y = (float*)(ws + OFF_K); E.rsl = nullptr;
      run_gemm(lds, (const bf16_t*)(ws + OFF_XB), 2048, (const bf16_t*)(ws + OFF_WO1), 2048, 2048, 2048, E); }
    gsync(grid);
    if (PM & 8192) { const Params P = GETP(); unsigned char* ws = P.ws; ln_phase((const float*)(ws + OFF_K), P.ln_g + 2048, P.ln_b + 2048, P.out, nullptr, 0); }
}

extern "C" void kernel_launch(void* const* d_in, const int* in_sizes, int n_in, void* d_out, int out_size, void* d_ws, size_t ws_size, hipStream_t stream) {
    static int grid_blocks = 0;
    if (grid_blocks == 0) {
        if (n_in != 22 || out_size != M * DM || ws_size < WS_END) { fprintf(stderr, "kernel_launch: unexpected shapes (n_in %d out %d ws %zu need %zu)\n", n_in, out_size, ws_size, (size_t)WS_END); grid_blocks = -1; return; }
        int dev = 0, cus = 0, per_cu = 0;
        hipGetDevice(&dev); hipDeviceGetAttribute(&cus, hipDeviceAttributeMultiprocessorCount, dev);
        if (hipFuncSetAttribute((const void*)mega_fwd, hipFuncAttributeMaxDynamicSharedMemorySize, LDS_BYTES) != hipSuccess) { fprintf(stderr, "kernel_launch: hipFuncSetAttribute failed\n"); grid_blocks = -1; return; }
        if (hipOccupancyMaxActiveBlocksPerMultiprocessor(&per_cu, (const void*)mega_fwd, 512, LDS_BYTES) != hipSuccess || per_cu < 1) { fprintf(stderr, "kernel_launch: occupancy query failed (%d)\n", per_cu); (void)hipGetLastError(); per_cu = 1; }
        grid_blocks = cus * 1;
        if (grid_blocks > 256) grid_blocks = 256;
    }
    if (grid_blocks < 0) return;
    Params p{};
    const float** pp = (const float**)&p;
    for (int i = 0; i < 22; ++i) pp[i] = (const float*)d_in[i];
    p.out = (float*)d_out; p.ws = (unsigned char*)d_ws;
    void* args[] = {&p};
    hipError_t e = hipLaunchCooperativeKernel((const void*)mega_fwd, dim3(grid_blocks), dim3(512), args, LDS_BYTES, stream);
    if (e != hipSuccess) fprintf(stderr, "cooperative launch failed: %s (grid %d)\n", hipGetErrorString(e), grid_blocks);
}
```

```cpp
#include <hip/hip_runtime.h>
#include <hip/hip_cooperative_groups.h>
#include <cstdio>
#include <cstdint>
namespace cg = cooperative_groups;
namespace pg8 {
#define PG8_LAS __attribute__((address_space(3)))
typedef unsigned short bf16_t;
typedef short bf16x8 __attribute__((ext_vector_type(8)));
typedef float f32x4 __attribute__((ext_vector_type(4)));
typedef unsigned u32x4 __attribute__((ext_vector_type(4)));
constexpr int BM = 256, BK = 64, HALF = 128, HTB = HALF * BK * 2  , STAGE_BYTES = 8 * HTB, NXCD = 8, WGM = 8;

__host__ __device__ __forceinline__ int lds_byte(int r, int c) { const int st = (r >> 4) * 2 + (c >> 5), rr = r & 15, cc = c & 31, ob = rr * 64 + cc * 2; return st * 1024 + (ob ^ (((ob >> 9) & 1) << 5)); }
__host__ __device__ __forceinline__ void stage_rc(int b, int& R, int& C) { const int st = b / 1024, sb = b % 1024, swz = sb ^ (((sb >> 9) & 1) << 5); R = (st >> 1) * 16 + swz / 64; C = (st & 1) * 32 + (swz % 64) / 2; }
__host__ __device__ __forceinline__ int perm32(int rho) { const int n = rho >> 4, i = rho & 15; return 8 * (i >> 2) + 4 * n + (i & 3); }

struct Unit { int pm, pn; };
struct Gemm { const bf16_t* A; const bf16_t* Bt; int M, N, K, lda, ldb, alias_a; };

struct StaticOrder {
    int nM, nN, nwg, G, c;
    __host__ __device__ void init(int M, int N, int G_, int c_) { nM = M / BM; nN = N / BM; nwg = nM * nN; G = G_; c = c_; }
    __host__ __device__ bool next(int i, Unit& u) const {
        const long L = (long)i * G + c; if (L >= nwg) return false;
        int wgid = (int)L; { const int q = nwg / NXCD, r = nwg % NXCD, xcd = wgid % NXCD, off = wgid / NXCD; wgid = (xcd < r ? xcd * (q + 1) : r * (q + 1) + (xcd - r) * q) + off; }
        const int nig = WGM * nN, gid = wgid / nig, fm = gid * WGM, gsz = (nM - fm) < WGM ? (nM - fm) : WGM;
        u.pm = fm + ((wgid % nig) % gsz); u.pn = (wgid % nig) / gsz; return true;
    }
    __device__ __forceinline__ void a_ready(const Unit&) const {}
    __device__ __forceinline__ void done(const Unit&) const {}
};
__device__ __forceinline__ unsigned cvt_pk_bf16(float lo, float hi) { unsigned r; asm volatile("v_cvt_pk_bf16_f32 %0, %1, %2" : "=v"(r) : "v"(lo), "v"(hi)); return r; }
template <class Epi, class Sched, bool STAMP = false>
__device__ __forceinline__ void gemm_phase(PG8_LAS unsigned char* lds, const Gemm g, const Sched& S, const Epi& E, unsigned long long* stamps) {
    const int tid = threadIdx.x, wid = __builtin_amdgcn_readfirstlane(tid >> 6), lane = tid & 63, wr = wid >> 2, wc = wid & 3, fr = lane & 15, fq = lane >> 4;
    const int K = g.K, nt = K / BK;
    int ts_lo = 0, ts_hi = 0, nts = 0; const unsigned long long rt_entry = STAMP ? (unsigned long long)wall_clock64() : 0ull;
#define PG8_STAMP() do { if (STAMP && wid == 0 && nts < 64) { const unsigned long long _c = (unsigned long long)clock64(); \
        ts_lo = (lane == nts) ? (int)(unsigned)_c : ts_lo; ts_hi = (lane == nts) ? (int)(unsigned)(_c >> 32) : ts_hi; ++nts; } } while (0)
    PG8_STAMP();
    unsigned voffA[2], voffB[2];
#pragma unroll
    for (int i = 0; i < 2; ++i) { int R, C; stage_rc(tid * 16 + i * 8192, R, C); const int Rb = Epi::PERM ? ((R & ~31) + perm32(R & 31)) : R;
        voffA[i] = (unsigned)(R * g.lda + C) * 2u; voffB[i] = (unsigned)(Rb * g.ldb + C) * 2u; }
    const size_t kstep = (size_t)(BK * 2);
    const size_t hstepA = (size_t)HALF * g.lda * 2, hstepB = (size_t)HALF * g.ldb * 2;
    const size_t tstepA = g.alias_a ? (size_t)0 : 2 * hstepA, tstepB = 2 * hstepB;
    const unsigned ldsw = (unsigned)wid * 1024u;
    const int aoff = lds_byte(wr * 64 + fr, fq * 8), boff = lds_byte(wc * 32 + fr, fq * 8);
#define PG8_SA(b, h) (((b) * 2 + (h)) * HTB)
#define PG8_SB(b, h) ((4 + (b) * 2 + (h)) * HTB)
#define PG8_STAGE(bufoff, gbase, voff) do { _Pragma("unroll") for (int _i = 0; _i < 2; ++_i) \
        __builtin_amdgcn_global_load_lds((const unsigned*)((const char*)(gbase) + (voff)[_i]), (PG8_LAS unsigned*)(lds + (bufoff) + ldsw + _i * 8192), 16, 0, 0); } while (0)
#define PG8_LDA(dst, b, h) do { _Pragma("unroll") for (int m = 0; m < 4; ++m) _Pragma("unroll") for (int k = 0; k < 2; ++k) dst[m][k] = *(const PG8_LAS bf16x8*)(lds + PG8_SA(b, h) + aoff + m * 2048 + k * 1024); } while (0)
#define PG8_LDB(dst, b, h) do { _Pragma("unroll") for (int n = 0; n < 2; ++n) _Pragma("unroll") for (int k = 0; k < 2; ++k) dst[n][k] = *(const PG8_LAS bf16x8*)(lds + PG8_SB(b, h) + boff + n * 2048 + k * 1024); } while (0)
#define PG8_MMA(ai, bj, At, Bt) do { __builtin_amdgcn_s_setprio(1); _Pragma("unroll") for (int m = 0; m < 4; ++m) _Pragma("unroll") for (int n = 0; n < 2; ++n) _Pragma("unroll") for (int k = 0; k < 2; ++k) \
        acc[ai][bj][m][n] = __builtin_amdgcn_mfma_f32_16x16x32_bf16(Bt[n][k], At[m][k], acc[ai][bj][m][n], 0, 0, 0); __builtin_amdgcn_s_setprio(0); } while (0)
#define PG8_WAIT_V(n) asm volatile("s_waitcnt vmcnt(" #n ")" ::: "memory")
#define PG8_WAIT_L(n) asm volatile("s_waitcnt lgkmcnt(" #n ")" ::: "memory")
#define PG8_BAR __builtin_amdgcn_s_barrier()
#define PG8_SCHED __builtin_amdgcn_sched_barrier(0)
    Unit cur, nxt; int ui = 0;
    if (!S.next(0, cur)) return;
    f32x4 acc[2][2][4][2];
#pragma unroll
    for (int a = 0; a < 2; ++a)
#pragma unroll
        for (int b = 0; b < 2; ++b)
#pragma unroll
            for (int m = 0; m < 4; ++m)
#pragma unroll
                for (int n = 0; n < 2; ++n) acc[a][b][m][n] = (f32x4){0.f, 0.f, 0.f, 0.f};
    bf16x8 At[4][2], B0[2][2], B1[2][2];
    const char* cA = (const char*)g.A + (size_t)cur.pm * tstepA; const char* cB = (const char*)g.Bt + (size_t)cur.pn * tstepB;
    S.a_ready(cur);
    PG8_STAGE(PG8_SB(0, 0), cB, voffB); PG8_STAGE(PG8_SA(0, 0), cA, voffA); PG8_STAGE(PG8_SB(0, 1), cB + hstepB, voffB); PG8_STAGE(PG8_SA(0, 1), cA + hstepA, voffA);
    if (wr == 1) PG8_BAR;
    PG8_WAIT_V(4); PG8_BAR;
    PG8_STAGE(PG8_SB(1, 0), cB + kstep, voffB); PG8_STAGE(PG8_SA(1, 0), cA + kstep, voffA); PG8_STAGE(PG8_SB(1, 1), cB + hstepB + kstep, voffB);
    PG8_WAIT_V(6); PG8_BAR;
    PG8_STAMP();
    for (;;) {
        const bool has_next = S.next(ui + 1, nxt);
        const char* nA = has_next ? (const char*)g.A + (size_t)nxt.pm * tstepA : cA; const char* nB = has_next ? (const char*)g.Bt + (size_t)nxt.pn * tstepB : cB;
        for (int t = 0; t < nt; t += 2) {
            if constexpr (Epi::MID >= 0) { if (t == Epi::MID) E.mid(acc, cur, ui, wr, wc, fr, fq); }
            const bool last = (t == nt - 2);
            const char* a1 = cA + (size_t)(t + 1) * kstep;
            const char* a2 = last ? nA : cA + (size_t)(t + 2) * kstep; const char* b2 = last ? nB : cB + (size_t)(t + 2) * kstep;
            const char* a3 = a2 + kstep; const char* b3 = b2 + kstep;
            if (last && has_next) S.a_ready(nxt);
            PG8_LDB(B0, 0, 0); PG8_SCHED; PG8_LDA(At, 0, 0); PG8_STAGE(PG8_SA(1, 1), a1 + hstepA, voffA);
            PG8_WAIT_L(8); PG8_BAR; PG8_WAIT_L(0); PG8_MMA(0, 0, At, B0); PG8_BAR; PG8_SCHED;
            PG8_LDB(B1, 0, 1); PG8_STAGE(PG8_SB(0, 0), b2, voffB);
            PG8_BAR; PG8_WAIT_L(0); PG8_MMA(0, 1, At, B1); PG8_BAR;
            PG8_LDA(At, 0, 1); PG8_STAGE(PG8_SA(0, 0), a2, voffA);
            PG8_BAR; PG8_WAIT_L(0); PG8_MMA(1, 0, At, B0); PG8_BAR; PG8_SCHED;
            PG8_STAGE(PG8_SB(0, 1), b2 + hstepB, voffB);
            PG8_WAIT_V(6); PG8_BAR; PG8_MMA(1, 1, At, B1); PG8_BAR;
            PG8_LDB(B0, 1, 0); PG8_SCHED; PG8_LDA(At, 1, 0); PG8_STAGE(PG8_SA(0, 1), a2 + hstepA, voffA);
            PG8_WAIT_L(8); PG8_BAR; PG8_WAIT_L(0); PG8_MMA(0, 0, At, B0); PG8_BAR; PG8_SCHED;
            PG8_LDB(B1, 1, 1); PG8_STAGE(PG8_SB(1, 0), b3, voffB);
            PG8_BAR; PG8_WAIT_L(0); PG8_MMA(0, 1, At, B1); PG8_BAR;
            PG8_LDA(At, 1, 1); PG8_STAGE(PG8_SA(1, 0), a3, voffA);
            PG8_BAR; PG8_WAIT_L(0); PG8_MMA(1, 0, At, B0); PG8_BAR; PG8_SCHED;
            PG8_STAGE(PG8_SB(1, 1), b3 + hstepB, voffB);
            PG8_WAIT_V(6); PG8_BAR; PG8_MMA(1, 1, At, B1); PG8_BAR;
        }
        PG8_STAMP();
        if constexpr (!Epi::AFTER_DRAIN) { E(acc, cur, wr, wc, fr, fq); S.done(cur); }
        PG8_STAMP();
        if (!has_next) break;
#pragma unroll
        for (int a = 0; a < 2; ++a)
#pragma unroll
            for (int b = 0; b < 2; ++b)
#pragma unroll
                for (int m = 0; m < 4; ++m)
#pragma unroll
                    for (int n = 0; n < 2; ++n) acc[a][b][m][n] = (f32x4){0.f, 0.f, 0.f, 0.f};
        cur = nxt; cA = nA; cB = nB; ++ui;
    }
    PG8_WAIT_V(0);
    if (wr == 0) PG8_BAR;
    PG8_BAR;
    if constexpr (Epi::AFTER_DRAIN) { E.fused(acc, cur, wr, wc, fr, fq, lds, wid, lane); S.done(cur); }
    PG8_STAMP();
    if (STAMP && wid == 0) { stamps[lane] = lane < nts ? (((unsigned long long)(unsigned)ts_hi << 32) | (unsigned)ts_lo) : 0ull;
        if (lane == 62) stamps[62] = rt_entry; if (lane == 63) stamps[63] = (unsigned long long)wall_clock64(); }
#undef PG8_STAMP
#undef PG8_SA
#undef PG8_SB
#undef PG8_STAGE
#undef PG8_LDA
#undef PG8_LDB
#undef PG8_MMA
#undef PG8_WAIT_V
#undef PG8_WAIT_L
#undef PG8_BAR
#undef PG8_SCHED
}
}

using pg8::bf16_t; using pg8::bf16x8; using pg8::f32x4; using pg8::u32x4; using pg8::Unit;
#define LAS __attribute__((address_space(3)))
#ifndef GSYNC_WAVE_ACQ
#define GSYNC_WAVE_ACQ 0
#endif
#ifndef GEMM_SKEW_TICKS
#define GEMM_SKEW_TICKS 0
#endif
typedef short s16x4 __attribute__((ext_vector_type(4)));
typedef short v4i16_t __attribute__((ext_vector_type(4)));
typedef unsigned u32x2 __attribute__((ext_vector_type(2)));
typedef LAS unsigned char* ldsp;

constexpr int M = 16384, DM = 2048, SEQ = 4096;
constexpr int N0P = 13568;
constexpr float ALPHA = 1.41421356237309515f;
constexpr int LDS_BYTES = 131072 + 8192;

constexpr size_t OFF_XB = 0;
constexpr size_t OFF_W0T = 67108864;
constexpr size_t OFF_RB = 122683392;
constexpr size_t OFF_SIN = OFF_RB + 67108864;
constexpr size_t OFF_K = 223346688;
constexpr size_t OFF_V = 290455552;
constexpr size_t OFF_G = 357564416;
constexpr size_t OFF_WO0 = 424673280;
constexpr size_t OFF_W1 = 441450496;
constexpr size_t OFF_WG = 458227712;
constexpr size_t OFF_WO1 = 475004928;
constexpr size_t OFF_DT = 483393536;
constexpr size_t OFF_CUM = 485490688;
constexpr size_t OFF_SSQ = 487587840;
constexpr size_t OFF_KM = 490733568;
constexpr size_t OFF_CT = 490209280;
constexpr size_t OFF_STB = 490471424;
constexpr size_t WS_END = 490733568 + 1048576;
#ifdef PITCH_EXP
constexpr size_t X1B_OFF = OFF_XB, W1_OFF = WS_END; constexpr int X1B_LD = 2112, W1_LD = 2112;
#else
constexpr size_t X1B_OFF = OFF_G, W1_OFF = OFF_W1; constexpr int X1B_LD = 2048, W1_LD = 2048;
#endif

struct Params {
    const float *x, *in0_w, *conv_w, *conv_b, *dt_bias, *a_log, *ssd_d, *ssd_norm_g, *out0_w, *in1_w,
                *lam_re, *lam_im, *log_dt, *b_re, *b_im, *c_re, *c_im, *s5_d, *glu_w, *out1_w, *ln_g, *ln_b;
    float* out; unsigned char* ws;
};

__constant__ float INVF[16] = {1.000000000e+00f, 4.403665960e-01f, 1.939227432e-01f, 8.539710194e-02f, 3.760603070e-02f, 1.656043902e-02f, 7.292664610e-03f, 3.211445874e-03f,
                               1.414213562e-03f, 6.227723788e-04f, 2.742481884e-04f, 1.207697351e-04f, 5.318296098e-05f, 2.341999971e-05f, 1.031338616e-05f, 4.541670478e-06f};

#define LDS_WAIT() asm volatile("s_waitcnt lgkmcnt(0)" ::: "memory")
__device__ __forceinline__ unsigned pk2(float lo, float hi) { return pg8::cvt_pk_bf16(lo, hi); }
__device__ __forceinline__ float bf_lo(unsigned u) { return __uint_as_float(u << 16); }
__device__ __forceinline__ float bf_hi(unsigned u) { return __uint_as_float(u & 0xffff0000u); }
__device__ __forceinline__ float bf1(bf16_t h) { return __uint_as_float(((unsigned)h) << 16); }
__device__ __forceinline__ float silu_f(float v) { return v * __builtin_amdgcn_rcpf(1.f + __expf(-v)); }
__device__ __forceinline__ float sigmoid_f(float v) { return __builtin_amdgcn_rcpf(1.f + __expf(-v)); }
__device__ __forceinline__ float softplus_f(float v) { return fmaxf(v, 0.f) + log1pf(__expf(-fabsf(v))); }
__device__ __forceinline__ float gelu_tanh_f(float v) { const float u = 0.7978845608028654f * (v + 0.044715f * v * v * v); const float t = 1.f - 2.f * __builtin_amdgcn_rcpf(1.f + __expf(2.f * u)); return 0.5f * v * (1.f + t); }
__device__ __forceinline__ s16x4 vtr(const LAS unsigned char* p) { return __builtin_bit_cast(s16x4, __builtin_amdgcn_ds_read_tr16_b64_v4i16((LAS v4i16_t*)p)); }
__device__ __forceinline__ bf16x8 cat8(s16x4 lo, s16x4 hi) { return __builtin_shufflevector(lo, hi, 0, 1, 2, 3, 4, 5, 6, 7); }
__device__ __forceinline__ f32x4 mfma16(bf16x8 a, bf16x8 b, f32x4 c) { return __builtin_amdgcn_mfma_f32_16x16x32_bf16(a, b, c, 0, 0, 0); }
__device__ __forceinline__ void sincos_d(double a, float& s, float& c) {
    const double k = rint(a * 0.63661977236758134308);
    double r = fma(-k, 1.57079632679489661923, a); r = fma(-k, 6.123233995736766e-17, r);
    const double r2 = r * r;
    const double sp = r * (1.0 + r2 * (-1.0 / 6.0 + r2 * (1.0 / 120.0 + r2 * (-1.0 / 5040.0 + r2 * (1.0 / 362880.0 + r2 * (-1.0 / 39916800.0 + r2 * (1.0 / 6227020800.0)))))));
    const double cp = 1.0 + r2 * (-0.5 + r2 * (1.0 / 24.0 + r2 * (-1.0 / 720.0 + r2 * (1.0 / 40320.0 + r2 * (-1.0 / 3628800.0 + r2 * (1.0 / 479001600.0 + r2 * (-1.0 / 87178291200.0)))))));
    const int q = ((int)k) & 3;
    const double ss = (q == 0) ? sp : (q == 1) ? cp : (q == 2) ? -sp : -cp;
    const double cc = (q == 0) ? cp : (q == 1) ? -sp : (q == 2) ? -cp : sp;
    s = (float)ss; c = (float)cc;
}

struct EpiIn0 {
    static constexpr bool PERM = false, AFTER_DRAIN = false; static constexpr int MID = -1;
    bf16_t *A0, *XBCraw, *Kb, *Vb, *Gb; float *DTf, *kmean; const float *ctab, *stab, *dt_bias;
    __device__ __forceinline__ void mid(f32x4 (&)[2][2][4][2], const Unit&, int, int, int, int, int) const {}
    __device__ __forceinline__ void operator()(const f32x4 (&acc)[2][2][4][2], const Unit& u, int wr, int wc, int fr, int fq) const {
        const int pn = u.pn, rowb = u.pm * 256 + wr * 64 + fr, colw = wc * 32 + 4 * fq;
        if (pn >= 52) {
            if (pn == 52 && wc == 0) {
#pragma unroll
                for (int ai = 0; ai < 2; ++ai)
#pragma unroll
                    for (int m = 0; m < 4; ++m) { const int row = rowb + ai * 128 + m * 16;
#pragma unroll
                        for (int n = 0; n < 2; ++n) { const f32x4 v = acc[ai][0][m][n]; const f32x4 bb = *(const f32x4*)(dt_bias + 16 * n + 4 * fq); f32x4 r;
                            r[0] = softplus_f(v[0] + bb[0]); r[1] = softplus_f(v[1] + bb[1]); r[2] = softplus_f(v[2] + bb[2]); r[3] = softplus_f(v[3] + bb[3]);
                            *(f32x4*)(DTf + (size_t)row * 32 + 16 * n + 4 * fq) = r; } }
            }
            return;
        }
        bf16_t* dst; int ld; int mode;
        if (pn < 8) { dst = A0 + 256 * pn; ld = 4096; mode = 0; }
        else if (pn < 20) { dst = XBCraw + 256 * (pn - 8); ld = 3072; mode = 0; }
        else if (pn < 28) { dst = A0 + 2048 + 256 * (pn - 20); ld = 4096; mode = 1; }
        else if (pn < 36) { dst = Kb + 256 * (pn - 28); ld = 2048; mode = 2; }
        else if (pn < 44) { dst = Vb + 256 * (pn - 36); ld = 2048; mode = 0; }
        else { dst = Gb + 256 * (pn - 44); ld = 2048; mode = 3; }
        const bool rot = (mode == 1 || mode == 2) && (wc == 0);
        f32x4 cs[2][2];
#pragma unroll
        for (int bj = 0; bj < 2; ++bj)
#pragma unroll
            for (int n = 0; n < 2; ++n) cs[bj][n] = (f32x4){0.f, 0.f, 0.f, 0.f};
#pragma unroll
        for (int ai = 0; ai < 2; ++ai)
#pragma unroll
            for (int m = 0; m < 4; ++m) { const int row = rowb + ai * 128 + m * 16; f32x4 v[2][2];
#pragma unroll
                for (int bj = 0; bj < 2; ++bj)
#pragma unroll
                    for (int n = 0; n < 2; ++n) v[bj][n] = acc[ai][bj][m][n];
                if (rot) { const int pos = row & (SEQ - 1); const f32x4 cv = *(const f32x4*)(ctab + pos * 16 + 4 * fq), sv = *(const f32x4*)(stab + pos * 16 + 4 * fq);
#pragma unroll
                    for (int bj = 0; bj < 2; ++bj) { const f32x4 x1 = v[bj][0], x2 = v[bj][1]; v[bj][0] = x1 * cv - x2 * sv; v[bj][1] = x1 * sv + x2 * cv; } }
                if (mode == 2) {
#pragma unroll
                    for (int bj = 0; bj < 2; ++bj)
#pragma unroll
                        for (int n = 0; n < 2; ++n) cs[bj][n] += v[bj][n]; }
                if (mode == 3) {
#pragma unroll
                    for (int bj = 0; bj < 2; ++bj)
#pragma unroll
                        for (int n = 0; n < 2; ++n)
#pragma unroll
                            for (int j = 0; j < 4; ++j) v[bj][n][j] = silu_f(v[bj][n][j]); }
                bf16_t* rp = dst + (size_t)row * ld + colw;
#pragma unroll
                for (int bj = 0; bj < 2; ++bj)
#pragma unroll
                    for (int n = 0; n < 2; ++n) { u32x2 o; o.x = pk2(v[bj][n][0], v[bj][n][1]); o.y = pk2(v[bj][n][2], v[bj][n][3]); *(u32x2*)(rp + bj * 128 + n * 16) = o; }
            }
        if (mode == 2) {
#pragma unroll
            for (int bj = 0; bj < 2; ++bj)
#pragma unroll
                for (int n = 0; n < 2; ++n)
#pragma unroll
                    for (int j = 0; j < 4; ++j) { float s = cs[bj][n][j]; s += __shfl_xor(s, 1); s += __shfl_xor(s, 2); s += __shfl_xor(s, 4); s += __shfl_xor(s, 8); cs[bj][n][j] = s; }
            if (fr == 0) { const int b = u.pm >> 4, blk = u.pm & 15;
#pragma unroll
                for (int bj = 0; bj < 2; ++bj) { const int head = 2 * (pn - 28) + bj; float* kp = kmean + ((size_t)((b * 16 + head) * 16 + blk)) * 128 + colw;
#pragma unroll
                    for (int n = 0; n < 2; ++n) *(f32x4*)(kp + wr * 131072 + n * 16) = cs[bj][n]; } }
        }
    }
};
struct EpiIn1 {
    static constexpr bool PERM = false, AFTER_DRAIN = false; static constexpr int MID = -1;
    bf16_t *U, *SG;
    __device__ __forceinline__ void mid(f32x4 (&)[2][2][4][2], const Unit&, int, int, int, int, int) const {}
    __device__ __forceinline__ void operator()(const f32x4 (&acc)[2][2][4][2], const Unit& u, int wr, int wc, int fr, int fq) const {
        const int pn = u.pn, rowb = u.pm * 256 + wr * 64 + fr, colw = wc * 32 + 4 * fq; const bool sg = pn >= 8;
        bf16_t* dst = sg ? SG + 256 * (pn - 8) : U + 256 * pn;
#pragma unroll
        for (int ai = 0; ai < 2; ++ai)
#pragma unroll
            for (int m = 0; m < 4; ++m) { bf16_t* rp = dst + (size_t)(rowb + ai * 128 + m * 16) * 2048 + colw;
#pragma unroll
                for (int bj = 0; bj < 2; ++bj)
#pragma unroll
                    for (int n = 0; n < 2; ++n) { f32x4 v = acc[ai][bj][m][n];
                        if (sg) { v[0] = silu_f(v[0]); v[1] = silu_f(v[1]); v[2] = silu_f(v[2]); v[3] = silu_f(v[3]); }
                        u32x2 o; o.x = pk2(v[0], v[1]); o.y = pk2(v[2], v[3]); *(u32x2*)(rp + bj * 128 + n * 16) = o; } }
    }
};
struct EpiGlu {
    static constexpr bool PERM = false, AFTER_DRAIN = false; static constexpr int MID = -1;
    bf16_t* __restrict__ A1; const bf16_t* __restrict__ SG;
    __device__ __forceinline__ void mid(f32x4 (&)[2][2][4][2], const Unit&, int, int, int, int, int) const {}
    __device__ __forceinline__ void operator()(const f32x4 (&acc)[2][2][4][2], const Unit& u, int wr, int wc, int fr, int fq) const {
        const int rowb = u.pm * 256 + wr * 64 + fr, colb = u.pn * 128 + wc * 32 + 4 * fq;
        u32x2 sgv[2][4][2];
#pragma unroll
        for (int ai = 0; ai < 2; ++ai)
#pragma unroll
            for (int m = 0; m < 4; ++m)
#pragma unroll
                for (int n = 0; n < 2; ++n) sgv[ai][m][n] = *(const u32x2*)(SG + (size_t)(rowb + ai * 128 + m * 16) * 2048 + colb + n * 16);
#pragma unroll
        for (int ai = 0; ai < 2; ++ai)
#pragma unroll
            for (int m = 0; m < 4; ++m) { const size_t ro = (size_t)(rowb + ai * 128 + m * 16) * 2048 + colb;
#pragma unroll
                for (int n = 0; n < 2; ++n) { const f32x4 ga = acc[ai][0][m][n], gb = acc[ai][1][m][n]; const u32x2 s = sgv[ai][m][n];
                    const float o0 = ga[0] * sigmoid_f(gb[0]) * bf_lo(s.x), o1 = ga[1] * sigmoid_f(gb[1]) * bf_hi(s.x), o2 = ga[2] * sigmoid_f(gb[2]) * bf_lo(s.y), o3 = ga[3] * sigmoid_f(gb[3]) * bf_hi(s.y);
                    u32x2 o; o.x = pk2(o0, o1); o.y = pk2(o2, o3); *(u32x2*)(A1 + ro + n * 16) = o; } }
    }
};
template <int MIDK> struct EpiOut {
    static constexpr bool PERM = false, AFTER_DRAIN = false; static constexpr int MID = MIDK;
    const float* __restrict__ resid; float* __restrict__ Y; const LAS float* rsl;
    __device__ __forceinline__ void mid(f32x4 (&acc)[2][2][4][2], const Unit& u, int ui, int wr, int wc, int fr, int fq) const {
        const LAS float* rp = rsl + ui * 256 + wr * 64 + fr;
#pragma unroll
        for (int ai = 0; ai < 2; ++ai)
#pragma unroll
            for (int m = 0; m < 4; ++m) { const float rs = rp[ai * 128 + m * 16];
#pragma unroll
                for (int bj = 0; bj < 2; ++bj)
#pragma unroll
                    for (int n = 0; n < 2; ++n) acc[ai][bj][m][n] *= rs; }
    }
    __device__ __forceinline__ void operator()(const f32x4 (&acc)[2][2][4][2], const Unit& u, int wr, int wc, int fr, int fq) const {
        const int rowb = u.pm * 256 + wr * 64 + fr, colb = u.pn * 256 + wc * 32 + 4 * fq;
#pragma unroll
        for (int ai = 0; ai < 2; ++ai)
#pragma unroll
            for (int mp = 0; mp < 2; ++mp) { f32x4 r[2][2][2];
#pragma unroll
                for (int mm = 0; mm < 2; ++mm) { const size_t ro = (size_t)(rowb + ai * 128 + (2 * mp + mm) * 16) * 2048 + colb;
#pragma unroll
                    for (int bj = 0; bj < 2; ++bj)
#pragma unroll
                        for (int n = 0; n < 2; ++n) r[mm][bj][n] = *(const f32x4*)(resid + ro + bj * 128 + n * 16); }
#pragma unroll
                for (int mm = 0; mm < 2; ++mm) { const size_t ro = (size_t)(rowb + ai * 128 + (2 * mp + mm) * 16) * 2048 + colb;
#pragma unroll
                    for (int bj = 0; bj < 2; ++bj)
#pragma unroll
                        for (int n = 0; n < 2; ++n) *(f32x4*)(Y + ro + bj * 128 + n * 16) = r[mm][bj][n] * ALPHA + acc[ai][bj][2 * mp + mm][n]; } }
    }
};

__device__ __forceinline__ void transpose_item(const float* W, int Nsrc, int nsrc0, bf16_t* WT, int Kdim, int k0, int ndst0, const float* kscale, LAS float* scr, int lane) {
    if (nsrc0 >= 0) {
#pragma unroll 8
        for (int i = 0; i < 32; ++i) { const int kk = 2 * i + (lane >> 5); float v = W[(size_t)(k0 + kk) * Nsrc + nsrc0 + (lane & 31)]; if (kscale) v *= kscale[k0 + kk]; scr[kk * 33 + (lane & 31)] = v; }
    } else {
#pragma unroll 8
        for (int i = 0; i < 32; ++i) { const int kk = 2 * i + (lane >> 5); scr[kk * 33 + (lane & 31)] = 0.f; }
    }
    LDS_WAIT();
    const int c = lane & 7;
#pragma unroll
    for (int j = 0; j < 4; ++j) { const int n = (lane >> 3) + 8 * j; const LAS float* s = scr + (8 * c) * 33 + n;
        u32x4 o; o.x = pk2(s[0 * 33], s[1 * 33]); o.y = pk2(s[2 * 33], s[3 * 33]); o.z = pk2(s[4 * 33], s[5 * 33]); o.w = pk2(s[6 * 33], s[7 * 33]);
        *(u32x4*)(WT + (size_t)(ndst0 + n) * Kdim + k0 + 8 * c) = o; }
    LDS_WAIT();
}
__device__ __forceinline__ void p0_phase(const Params& P, ldsp lds) {
    const int tid = threadIdx.x, wave = __builtin_amdgcn_readfirstlane(tid >> 6), lane = tid & 63;
    const int gw = blockIdx.x * 8 + wave, NGW = gridDim.x * 8;
    const size_t gtid = (size_t)blockIdx.x * 512 + tid, nth = (size_t)gridDim.x * 512;
    unsigned char* ws = P.ws;
    LAS float* scr = (LAS float*)(lds + wave * 8704);
    constexpr int I0 = 32 * 424, I1 = 64 * 64, I2 = 32 * 128, I3 = 32 * 128, I4 = 32 * 64;
    for (int it = gw; it < I0; it += NGW) { const int r = it;
        const int kb = r / 424, nb = r % 424, nd = 32 * nb; const int ns = nd < 5120 ? nd : (nd < 13312 ? nd + 32 : (nd == 13312 ? 5120 : -1));
        transpose_item(P.in0_w, 13344, ns, (bf16_t*)(ws + OFF_W0T), 2048, 64 * kb, nd, nullptr, scr, lane); }
    { const f32x4* xs = (const f32x4*)P.x; u32x2* xd = (u32x2*)(ws + OFF_XB);
      for (size_t i = gtid; i < (size_t)M * DM / 4; i += nth) { const f32x4 v = xs[i]; u32x2 o; o.x = pk2(v[0], v[1]); o.y = pk2(v[2], v[3]); xd[i] = o; } }
    { float* ct = (float*)(ws + OFF_CT); float* st = (float*)(ws + OFF_STB);
      for (size_t i = gtid; i < 4096 * 16; i += nth) { const int pos = (int)(i >> 4), k = (int)(i & 15); const float ang = (float)pos * INVF[k]; float s, c; sincos_d((double)ang, s, c); ct[i] = c; st[i] = s; } }

}

__device__ __forceinline__ void late_transposes(const Params& P, ldsp lds, int wi, int nw) {
    const int tid = threadIdx.x, wave = __builtin_amdgcn_readfirstlane(tid >> 6), lane = tid & 63;
    unsigned char* ws = P.ws; LAS float* scr = (LAS float*)(lds + wave * 8704);
    constexpr int I1 = 64 * 64, I2 = 32 * 128, I3 = 32 * 128, I4 = 32 * 64;
    for (int it = wi * 8 + wave; it < I1 + I2 + I3 + I4; it += nw * 8) {
        int r = it;
        if (r < I1) { const int kb = r / 64, nb = r % 64; transpose_item(P.out0_w, 2048, 32 * nb, (bf16_t*)(ws + OFF_WO0), 4096, 64 * kb, 32 * nb, kb < 32 ? P.ssd_norm_g : nullptr, scr, lane); continue; } r -= I1;
        if (r < I2) { const int kb = r / 128, nb = r % 128; transpose_item(P.in1_w, 4096, 32 * nb, (bf16_t*)(ws + W1_OFF), W1_LD, 64 * kb, 32 * nb, nullptr, scr, lane); continue; } r -= I2;
        if (r < I3) { const int kb = r / 128, nb = r % 128, nd = 32 * nb; const int ns = ((nd >> 7) & 1) * 2048 + 128 * (nd >> 8) + (nd & 127);
            transpose_item(P.glu_w, 4096, ns, (bf16_t*)(ws + OFF_WG), 2048, 64 * kb, nd, nullptr, scr, lane); continue; } r -= I3;
        { const int kb = r / 64, nb = r % 64; transpose_item(P.out1_w, 2048, 32 * nb, (bf16_t*)(ws + OFF_WO1), 2048, 64 * kb, 32 * nb, nullptr, scr, lane); }
    }
}

__device__ __forceinline__ void conv_phase(const Params& P) {
    const int tid = threadIdx.x, wave = __builtin_amdgcn_readfirstlane(tid >> 6), lane = tid & 63;
    const size_t gtid = (size_t)blockIdx.x * 512 + tid, nth = (size_t)gridDim.x * 512;
    const bf16_t* XR = (const bf16_t*)(P.ws + OFF_RB); bf16_t* X2 = (bf16_t*)(P.ws + OFF_XB);
    for (size_t it = gtid; it < (size_t)1024 * 384; it += nth) {
        const int tb = (int)(it / 384), cc = (int)(it % 384), t0 = tb * 16, ch = cc * 8;
        float w[4][8], bb[8];
#pragma unroll
        for (int j = 0; j < 4; ++j) { const f32x4 a = *(const f32x4*)(P.conv_w + j * 3072 + ch), b = *(const f32x4*)(P.conv_w + j * 3072 + ch + 4);
            w[j][0] = a[0]; w[j][1] = a[1]; w[j][2] = a[2]; w[j][3] = a[3]; w[j][4] = b[0]; w[j][5] = b[1]; w[j][6] = b[2]; w[j][7] = b[3]; }
        { const f32x4 a = *(const f32x4*)(P.conv_b + ch), b = *(const f32x4*)(P.conv_b + ch + 4); bb[0] = a[0]; bb[1] = a[1]; bb[2] = a[2]; bb[3] = a[3]; bb[4] = b[0]; bb[5] = b[1]; bb[6] = b[2]; bb[7] = b[3]; }
        const bool first = (t0 & (SEQ - 1)) == 0;
        u32x4 raw[19];
#pragma unroll
        for (int r = 0; r < 19; ++r) { if (r < 3 && first) raw[r] = (u32x4){0u, 0u, 0u, 0u}; else raw[r] = *(const u32x4*)(XR + (size_t)(t0 - 3 + r) * 3072 + ch); }
#pragma unroll
        for (int r = 0; r < 16; ++r) { float o[8];
#pragma unroll
            for (int e = 0; e < 8; ++e) o[e] = bb[e];
#pragma unroll
            for (int j = 0; j < 4; ++j) { const u32x4 q = raw[r + j];
                o[0] += w[j][0] * bf_lo(q.x); o[1] += w[j][1] * bf_hi(q.x); o[2] += w[j][2] * bf_lo(q.y); o[3] += w[j][3] * bf_hi(q.y);
                o[4] += w[j][4] * bf_lo(q.z); o[5] += w[j][5] * bf_hi(q.z); o[6] += w[j][6] * bf_lo(q.w); o[7] += w[j][7] * bf_hi(q.w); }
#pragma unroll
            for (int e = 0; e < 8; ++e) o[e] = silu_f(o[e]);
            u32x4 ov; ov.x = pk2(o[0], o[1]); ov.y = pk2(o[2], o[3]); ov.z = pk2(o[4], o[5]); ov.w = pk2(o[6], o[7]);
            *(u32x4*)(X2 + (size_t)(t0 + r) * 3072 + ch) = ov; }
    }
    const float* DTf = (const float*)(P.ws + OFF_DT); float* CUM = (float*)(P.ws + OFF_CUM);
    for (int it = blockIdx.x * 8 + wave; it < 2048; it += gridDim.x * 8) {
        const int b = it >> 9, c = (it >> 5) & 15, h = it & 31; const size_t rowbase = (size_t)b * 4096 + c * 256 + 4 * lane;
        const float Ah = -__expf(P.a_log[h]);
        const float a0 = DTf[(rowbase + 0) * 32 + h] * Ah, a1 = DTf[(rowbase + 1) * 32 + h] * Ah, a2 = DTf[(rowbase + 2) * 32 + h] * Ah, a3 = DTf[(rowbase + 3) * 32 + h] * Ah;
        const float s0 = a0, s1 = s0 + a1, s2 = s1 + a2, s3 = s2 + a3;
        float x = s3;
#pragma unroll
        for (int o = 1; o < 64; o <<= 1) { const float t = __shfl_up(x, o); if (lane >= o) x += t; }
        const float off = x - s3;
        CUM[(rowbase + 0) * 32 + h] = off + s0; CUM[(rowbase + 1) * 32 + h] = off + s1; CUM[(rowbase + 2) * 32 + h] = off + s2; CUM[(rowbase + 3) * 32 + h] = off + s3;
    }
}

__device__ __forceinline__ void ssd_a_phase(const Params& P, ldsp lds) {
    const int tid = threadIdx.x, wave = __builtin_amdgcn_readfirstlane(tid >> 6), lane = tid & 63, quad = lane >> 4, li = lane & 15, qq = li >> 2, pp = li & 3;
    const bf16_t* X2 = (const bf16_t*)(P.ws + OFF_XB); const float* DTf = (const float*)(P.ws + OFF_DT); const float* CUM = (const float*)(P.ws + OFF_CUM); float* ST = (float*)(P.ws + OFF_RB);
    ldsp Bl = lds, Xl = lds + 69632;
    for (int item = blockIdx.x; item < 256; item += gridDim.x) {
        const int b = item >> 6, c = (item >> 2) & 15, g = item & 3; const size_t rowbase = (size_t)b * 4096 + c * 256;
        __syncthreads();
#pragma unroll
        for (int k = 0; k < 8; ++k) { const int idx = tid + 512 * k, r = idx >> 4, ch = idx & 15; *(LAS u32x4*)(Bl + r * 272 + ch * 16) = *(const u32x4*)(X2 + (rowbase + r) * 3072 + 2048 + g * 128 + ch * 8); }
        for (int hh = 0; hh < 8; ++hh) { const int h = g * 8 + hh;
            __syncthreads();
            const float cl = CUM[(rowbase + 255) * 32 + h];
#pragma unroll
            for (int k = 0; k < 4; ++k) { const int idx = tid + 512 * k, r = idx >> 3, ch = idx & 7; const size_t row = rowbase + r;
                const float w = __expf(cl - CUM[row * 32 + h]) * DTf[row * 32 + h]; const u32x4 v = *(const u32x4*)(X2 + row * 3072 + h * 64 + ch * 8); u32x4 o;
                o.x = pk2(bf_lo(v.x) * w, bf_hi(v.x) * w); o.y = pk2(bf_lo(v.y) * w, bf_hi(v.y) * w); o.z = pk2(bf_lo(v.z) * w, bf_hi(v.z) * w); o.w = pk2(bf_lo(v.w) * w, bf_hi(v.w) * w);
                *(LAS u32x4*)(Xl + r * 160 + ch * 16) = o; }
            __syncthreads();
            f32x4 acc[4];
#pragma unroll
            for (int pt = 0; pt < 4; ++pt) acc[pt] = (f32x4){0.f, 0.f, 0.f, 0.f};
#pragma unroll
            for (int ks = 0; ks < 8; ++ks) { const int l0 = 32 * ks + 8 * quad + qq;
                const bf16x8 bop = cat8(vtr(Bl + l0 * 272 + (16 * wave + 4 * pp) * 2), vtr(Bl + (l0 + 4) * 272 + (16 * wave + 4 * pp) * 2));
#pragma unroll
                for (int pt = 0; pt < 4; ++pt) { const bf16x8 aop = cat8(vtr(Xl + l0 * 160 + (16 * pt + 4 * pp) * 2), vtr(Xl + (l0 + 4) * 160 + (16 * pt + 4 * pp) * 2)); acc[pt] = mfma16(aop, bop, acc[pt]); } }
            float* sp = ST + ((size_t)((b * 16 + c) * 32 + h) * 64) * 128 + 16 * wave + li;
#pragma unroll
            for (int pt = 0; pt < 4; ++pt)
#pragma unroll
                for (int j = 0; j < 4; ++j) sp[(size_t)(16 * pt + 4 * quad + j) * 128] = acc[pt][j];
        }
    }
}
__device__ __forceinline__ void ssd_b_phase(const Params& P) {
    const size_t gtid = (size_t)blockIdx.x * 512 + threadIdx.x, nth = (size_t)gridDim.x * 512;
    const float* ST = (const float*)(P.ws + OFF_RB); bf16_t* SIN = (bf16_t*)(P.ws + OFF_SIN); const float* CUM = (const float*)(P.ws + OFF_CUM);
    for (size_t it = gtid; it < (size_t)4 * 32 * 64 * 32; it += nth) {
        const int n4 = (int)(it & 31), p = (int)((it >> 5) & 63), h = (int)((it >> 11) & 31), b = (int)(it >> 16);
        f32x4 cur = (f32x4){0.f, 0.f, 0.f, 0.f};
#pragma unroll 4
        for (int c = 0; c < 16; ++c) { const size_t base = ((size_t)((b * 16 + c) * 32 + h) * 64 + p) * 128 + 4 * n4;
            u32x2 o; o.x = pk2(cur[0], cur[1]); o.y = pk2(cur[2], cur[3]); *(u32x2*)(SIN + base) = o;
            const float dec = __expf(CUM[((size_t)b * 4096 + c * 256 + 255) * 32 + h]); const f32x4 st = *(const f32x4*)(ST + base); cur = cur * dec + st; }
    }
}
__device__ __forceinline__ void ssd_c_phase(const Params& P, ldsp lds) {
    const int tid = threadIdx.x, wave = __builtin_amdgcn_readfirstlane(tid >> 6), lane = tid & 63, quad = lane >> 4, li = lane & 15, qq = li >> 2, pp = li & 3;
    const bf16_t* X2 = (const bf16_t*)(P.ws + OFF_XB); const float* DTf = (const float*)(P.ws + OFF_DT); const float* CUM = (const float*)(P.ws + OFF_CUM);
    const bf16_t* SIN = (const bf16_t*)(P.ws + OFF_SIN); float* SSQ = (float*)(P.ws + OFF_SSQ); bf16_t* A0 = (bf16_t*)P.out;
    ldsp Bl = lds, Xl = lds + 69632, Sl = lds + 110592; LAS float* cuml = (LAS float*)(lds + 128000); LAS float* dtl = cuml + 256;
    for (int item = blockIdx.x; item < 256; item += gridDim.x) {
        const int b = item >> 6, c = (item >> 2) & 15, g = item & 3; const size_t rowbase = (size_t)b * 4096 + c * 256;
        __syncthreads();
#pragma unroll
        for (int k = 0; k < 8; ++k) { const int idx = tid + 512 * k, r = idx >> 4, ch = idx & 15; *(LAS u32x4*)(Bl + r * 272 + ch * 16) = *(const u32x4*)(X2 + (rowbase + r) * 3072 + 2048 + g * 128 + ch * 8); }
        bf16x8 qf[2][4];
#pragma unroll
        for (int nt = 0; nt < 2; ++nt)
#pragma unroll
            for (int ks = 0; ks < 4; ++ks) qf[nt][ks] = *(const bf16x8*)(X2 + (rowbase + 32 * wave + 16 * nt + li) * 3072 + 2560 + g * 128 + 32 * ks + 8 * quad);
        for (int hh = 0; hh < 8; ++hh) { const int h = g * 8 + hh;
            __syncthreads();
#pragma unroll
            for (int k = 0; k < 4; ++k) { const int idx = tid + 512 * k, r = idx >> 3, ch = idx & 7; *(LAS u32x4*)(Xl + r * 160 + ch * 16) = *(const u32x4*)(X2 + (rowbase + r) * 3072 + h * 64 + ch * 8); }
#pragma unroll
            for (int k = 0; k < 2; ++k) { const int idx = tid + 512 * k, r = idx >> 4, ch = idx & 15; *(LAS u32x4*)(Sl + r * 272 + ch * 16) = *(const u32x4*)(SIN + ((size_t)((b * 16 + c) * 32 + h) * 64 + r) * 128 + ch * 8); }
            if (tid < 256) { cuml[tid] = CUM[(rowbase + tid) * 32 + h]; dtl[tid] = DTf[(rowbase + tid) * 32 + h]; }
            __syncthreads();
            f32x4 oacc[2][4];
#pragma unroll
            for (int nt = 0; nt < 2; ++nt)
#pragma unroll
                for (int pt = 0; pt < 4; ++pt) oacc[nt][pt] = (f32x4){0.f, 0.f, 0.f, 0.f};
#pragma unroll
            for (int pt = 0; pt < 4; ++pt)
#pragma unroll
                for (int ks = 0; ks < 4; ++ks) { const bf16x8 a = *(const LAS bf16x8*)(Sl + (16 * pt + li) * 272 + (32 * ks + 8 * quad) * 2);
                    oacc[0][pt] = mfma16(a, qf[0][ks], oacc[0][pt]); oacc[1][pt] = mfma16(a, qf[1][ks], oacc[1][pt]); }
            int lq[2]; float cq[2];
#pragma unroll
            for (int nt = 0; nt < 2; ++nt) { lq[nt] = 32 * wave + 16 * nt + li; cq[nt] = cuml[lq[nt]]; const float e = __expf(cq[nt]);
#pragma unroll
                for (int pt = 0; pt < 4; ++pt) oacc[nt][pt] *= e; }
            const int nkt = (32 * wave + 31) / 64 + 1;
#pragma unroll 1
            for (int kt = 0; kt < nkt; ++kt) {
                {
                    f32x4 sacc[2][4];
#pragma unroll
                    for (int nt = 0; nt < 2; ++nt)
#pragma unroll
                        for (int mt = 0; mt < 4; ++mt) sacc[nt][mt] = (f32x4){0.f, 0.f, 0.f, 0.f};
#pragma unroll
                    for (int mt = 0; mt < 4; ++mt)
#pragma unroll
                        for (int ks = 0; ks < 4; ++ks) { const bf16x8 a = *(const LAS bf16x8*)(Bl + (64 * kt + 16 * mt + li) * 272 + (32 * ks + 8 * quad) * 2);
                            sacc[0][mt] = mfma16(a, qf[0][ks], sacc[0][mt]); sacc[1][mt] = mfma16(a, qf[1][ks], sacc[1][mt]); }
#pragma unroll
                    for (int mt = 0; mt < 4; ++mt) { const int s0 = 64 * kt + 16 * mt + 4 * quad; const f32x4 cs = *(const LAS f32x4*)(cuml + s0), ds = *(const LAS f32x4*)(dtl + s0);
#pragma unroll
                        for (int nt = 0; nt < 2; ++nt)
#pragma unroll
                            for (int j = 0; j < 4; ++j) { const float v = sacc[nt][mt][j] * __expf(cq[nt] - cs[j]) * ds[j]; sacc[nt][mt][j] = (s0 + j <= lq[nt]) ? v : 0.f; } }
                    bf16x8 pb[2][2];
#pragma unroll
                    for (int nt = 0; nt < 2; ++nt)
#pragma unroll
                        for (int kk = 0; kk < 2; ++kk) { u32x4 t; t.x = pk2(sacc[nt][2 * kk][0], sacc[nt][2 * kk][1]); t.y = pk2(sacc[nt][2 * kk][2], sacc[nt][2 * kk][3]);
                            t.z = pk2(sacc[nt][2 * kk + 1][0], sacc[nt][2 * kk + 1][1]); t.w = pk2(sacc[nt][2 * kk + 1][2], sacc[nt][2 * kk + 1][3]); pb[nt][kk] = __builtin_bit_cast(bf16x8, t); }
#pragma unroll
                    for (int pt = 0; pt < 4; ++pt)
#pragma unroll
                        for (int kk = 0; kk < 2; ++kk) { const int r0 = 64 * kt + 32 * kk + 4 * quad + qq;
                            const bf16x8 a = cat8(vtr(Xl + r0 * 160 + (16 * pt + 4 * pp) * 2), vtr(Xl + (r0 + 16) * 160 + (16 * pt + 4 * pp) * 2));
                            oacc[0][pt] = mfma16(a, pb[0][kk], oacc[0][pt]); oacc[1][pt] = mfma16(a, pb[1][kk], oacc[1][pt]); }
                }
            }
            const float Dh = P.ssd_d[h];
#pragma unroll
            for (int nt = 0; nt < 2; ++nt) { const size_t row = rowbase + lq[nt]; float ss = 0.f;
#pragma unroll
                for (int pt = 0; pt < 4; ++pt) { const int col = h * 64 + 16 * pt + 4 * quad; const u32x2 xs = *(const u32x2*)(X2 + row * 3072 + col); const u32x2 z = *(const u32x2*)(A0 + row * 4096 + col);
                    const float t0 = (oacc[nt][pt][0] + Dh * bf_lo(xs.x)) * silu_f(bf_lo(z.x)), t1 = (oacc[nt][pt][1] + Dh * bf_hi(xs.x)) * silu_f(bf_hi(z.x));
                    const float t2 = (oacc[nt][pt][2] + Dh * bf_lo(xs.y)) * silu_f(bf_lo(z.y)), t3 = (oacc[nt][pt][3] + Dh * bf_hi(xs.y)) * silu_f(bf_hi(z.y));
                    ss += (t0 * t0 + t1 * t1) + (t2 * t2 + t3 * t3); u32x2 o; o.x = pk2(t0, t1); o.y = pk2(t2, t3); *(u32x2*)(A0 + row * 4096 + col) = o; }
                ss += __shfl_xor(ss, 16); ss += __shfl_xor(ss, 32);
                if (quad == 0) SSQ[row * 32 + h] = ss; }
        }
    }
}

__device__ __forceinline__ void moba_phase(const Params& P, ldsp lds, bf16_t* obase, int old_, unsigned rmask) {
    const int tid = threadIdx.x, wave = __builtin_amdgcn_readfirstlane(tid >> 6), lane = tid & 63, quad = lane >> 4, li = lane & 15, qq = li >> 2, pp = li & 3;
    bf16_t* A0 = (bf16_t*)P.out; const bf16_t* Kb = (const bf16_t*)(P.ws + OFF_K); const bf16_t* Vb = (const bf16_t*)(P.ws + OFF_V); const bf16_t* Gb = (const bf16_t*)(P.ws + OFF_G);
    const float* kmean = (const float*)(P.ws + OFF_KM);
    ldsp Kl = lds, Vl = lds + 34816; LAS float* gl = (LAS float*)(lds + 71680); LAS float* kml = (LAS float*)(lds + 89088); LAS unsigned* selm = (LAS unsigned*)(lds + 97280);
    const float c2 = 0.08838834764831845f * 1.4426950408889634f;
    const int G = gridDim.x, cb = blockIdx.x;
    const int sr = tid >> 4, sc = tid & 15;
    for (int kr = 0; kr * G < 1024; ++kr) {
        const int idx = (kr & 1) ? (kr * G + G - 1 - cb) : (kr * G + cb);
        if (idx >= 1024) continue;
        const int i = 15 - (idx >> 6), b = (idx & 63) >> 4, h = idx & 15;
        const size_t qrow0 = (size_t)b * 4096 + i * 256;
        __syncthreads();
        { const float* kq = kmean + (size_t)((b * 16 + h) * 16) * 128 + tid * 4; f32x4 v = *(const f32x4*)kq + *(const f32x4*)(kq + 131072); v *= (1.f / 256.f); *(LAS f32x4*)(kml + tid * 4) = v; }
        __syncthreads();
        { const int r = tid >> 1, hf = tid & 1; const bf16_t* qp = A0 + (qrow0 + r) * 4096 + 2048 + h * 128; float gs[8];
#pragma unroll
          for (int jb = 0; jb < 8; ++jb) gs[jb] = 0.f;
#pragma unroll 2
          for (int dc = 0; dc < 16; ++dc) { const u32x4 qv = *(const u32x4*)(qp + dc * 8);
              const float q0 = bf_lo(qv.x), q1 = bf_hi(qv.x), q2 = bf_lo(qv.y), q3 = bf_hi(qv.y), q4 = bf_lo(qv.z), q5 = bf_hi(qv.z), q6 = bf_lo(qv.w), q7 = bf_hi(qv.w);
#pragma unroll
              for (int jb = 0; jb < 8; ++jb) { const LAS float* kp = kml + (hf * 8 + jb) * 128 + dc * 8; const f32x4 k0 = *(const LAS f32x4*)kp, k1 = *(const LAS f32x4*)(kp + 4);
                  gs[jb] += (q0 * k0[0] + q1 * k0[1]) + (q2 * k0[2] + q3 * k0[3]) + (q4 * k1[0] + q5 * k1[1]) + (q6 * k1[2] + q7 * k1[3]); } }
#pragma unroll
          for (int jb = 0; jb < 8; ++jb) gl[r * 17 + hf * 8 + jb] = gs[jb]; }
        __syncthreads();
        if (tid < 256) { unsigned mask = 0u; const int nsel = i < 3 ? i : 3;
            for (int s = 0; s < nsel; ++s) { float best = -INFINITY; int bj = -1;
                for (int j = 0; j < i; ++j) { const float v = gl[tid * 17 + j]; if (!((mask >> j) & 1u) && v > best) { best = v; bj = j; } }
                if (bj >= 0) mask |= 1u << bj; }
            selm[tid] = mask; }
        bf16x8 qf[2][4];
#pragma unroll
        for (int nt = 0; nt < 2; ++nt)
#pragma unroll
            for (int ks = 0; ks < 4; ++ks) qf[nt][ks] = *(const bf16x8*)(A0 + (qrow0 + 32 * wave + 16 * nt + li) * 4096 + 2048 + h * 128 + 32 * ks + 8 * quad);
        const int ntile = 4 * (i + 1);
        u32x4 kreg[2], vreg[2];
        { const size_t kr0 = (qrow0 + sr) * 2048 + h * 128 + sc * 8;
          kreg[0] = *(const u32x4*)(Kb + kr0); kreg[1] = *(const u32x4*)(Kb + kr0 + 32 * 2048); vreg[0] = *(const u32x4*)(Vb + kr0); vreg[1] = *(const u32x4*)(Vb + kr0 + 32 * 2048); }
        *(LAS u32x4*)(Kl + sr * 272 + sc * 16) = kreg[0]; *(LAS u32x4*)(Kl + (sr + 32) * 272 + sc * 16) = kreg[1];
        *(LAS u32x4*)(Vl + sr * 288 + sc * 16) = vreg[0]; *(LAS u32x4*)(Vl + (sr + 32) * 288 + sc * 16) = vreg[1];
        __syncthreads();
        unsigned sel[2]; float mrun[2], lrun[2]; f32x4 oacc[2][8];
#pragma unroll
        for (int nt = 0; nt < 2; ++nt) { sel[nt] = selm[32 * wave + 16 * nt + li]; mrun[nt] = -1e30f; lrun[nt] = 0.f;
#pragma unroll
            for (int dt = 0; dt < 8; ++dt) oacc[nt][dt] = (f32x4){0.f, 0.f, 0.f, 0.f}; }
        for (int tt = 0; tt < ntile; ++tt) {
            const int buf = tt & 1;
            u32x4 kn0, kn1, vn0, vn1;
            { const int t1 = (tt + 1 < ntile) ? tt + 1 : tt; const int jb = (t1 < 4) ? i : (t1 >> 2) - 1; const int kt1 = t1 & 3;
                const size_t kr0 = ((size_t)b * 4096 + jb * 256 + kt1 * 64 + sr) * 2048 + h * 128 + sc * 8;
                kn0 = *(const u32x4*)(Kb + kr0); kn1 = *(const u32x4*)(Kb + kr0 + 32 * 2048); vn0 = *(const u32x4*)(Vb + kr0); vn1 = *(const u32x4*)(Vb + kr0 + 32 * 2048); }
            const bool own = tt < 4; const int kt = tt & 3; const int jblk = own ? i : (tt >> 2) - 1;
            bool active;
            if (own) active = (64 * kt <= 32 * wave + 31); else active = __any((int)(((sel[0] | sel[1]) >> jblk) & 1u)) != 0;
            if (active) {
                ldsp Kt = Kl + buf * 17408; ldsp Vt = Vl + buf * 18432;
                f32x4 sacc[2][4];
#pragma unroll
                for (int nt = 0; nt < 2; ++nt)
#pragma unroll
                    for (int mt = 0; mt < 4; ++mt) sacc[nt][mt] = (f32x4){0.f, 0.f, 0.f, 0.f};
                { bf16x8 kf[2][4];
#pragma unroll
                  for (int ks = 0; ks < 4; ++ks) kf[0][ks] = *(const LAS bf16x8*)(Kt + li * 272 + (32 * ks + 8 * quad) * 2);
#pragma unroll
                  for (int mt = 0; mt < 4; ++mt) {
                      if (mt < 3) {
#pragma unroll
                          for (int ks = 0; ks < 4; ++ks) kf[(mt + 1) & 1][ks] = *(const LAS bf16x8*)(Kt + (16 * (mt + 1) + li) * 272 + (32 * ks + 8 * quad) * 2); }
                      __builtin_amdgcn_sched_barrier(0);
#pragma unroll
                      for (int ks = 0; ks < 4; ++ks) { sacc[0][mt] = mfma16(kf[mt & 1][ks], qf[0][ks], sacc[0][mt]); sacc[1][mt] = mfma16(kf[mt & 1][ks], qf[1][ks], sacc[1][mt]); }
                      __builtin_amdgcn_sched_barrier(0);
                  } }
                bf16x8 pb[2][2];
#pragma unroll
                for (int nt = 0; nt < 2; ++nt) { const int qpos = 32 * wave + 16 * nt + li; const bool selj = ((sel[nt] >> jblk) & 1u) != 0u; float alpha, ps = 0.f;
                    if (own) {
                        float mx = -1e30f;
#pragma unroll
                        for (int mt = 0; mt < 4; ++mt)
#pragma unroll
                            for (int j = 0; j < 4; ++j) { const int kpos = 64 * kt + 16 * mt + 4 * quad + j;
                                const float s = (kpos <= qpos) ? sacc[nt][mt][j] * c2 : -1e30f; sacc[nt][mt][j] = s; mx = fmaxf(mx, s); }
                        mx = fmaxf(mx, __shfl_xor(mx, 16)); mx = fmaxf(mx, __shfl_xor(mx, 32));
                        const float mnew = fmaxf(mrun[nt], mx); alpha = __builtin_amdgcn_exp2f(mrun[nt] - mnew); mrun[nt] = mnew;
#pragma unroll
                        for (int mt = 0; mt < 4; ++mt)
#pragma unroll
                            for (int j = 0; j < 4; ++j) { const float p = __builtin_amdgcn_exp2f(sacc[nt][mt][j] - mnew); sacc[nt][mt][j] = p; ps += p; }
                    } else {
                        const float bias = selj ? 0.f : -1e30f; float mx = sacc[nt][0][0];
#pragma unroll
                        for (int mt = 0; mt < 4; ++mt)
#pragma unroll
                            for (int j = 0; j < 4; ++j) mx = fmaxf(mx, sacc[nt][mt][j]);
                        mx = fmaxf(mx, __shfl_xor(mx, 16)); mx = fmaxf(mx, __shfl_xor(mx, 32));
                        const float mnew = fmaxf(mrun[nt], fmaf(mx, c2, bias)); alpha = __builtin_amdgcn_exp2f(mrun[nt] - mnew); mrun[nt] = mnew; const float nb = bias - mnew;
#pragma unroll
                        for (int mt = 0; mt < 4; ++mt)
#pragma unroll
                            for (int j = 0; j < 4; ++j) { const float p = __builtin_amdgcn_exp2f(fmaf(sacc[nt][mt][j], c2, nb)); sacc[nt][mt][j] = p; ps += p; }
                    }
                    lrun[nt] = lrun[nt] * alpha + ps;
#pragma unroll
                    for (int dt = 0; dt < 8; ++dt) oacc[nt][dt] *= alpha;
#pragma unroll
                    for (int kk = 0; kk < 2; ++kk) { u32x4 t; t.x = pk2(sacc[nt][2 * kk][0], sacc[nt][2 * kk][1]); t.y = pk2(sacc[nt][2 * kk][2], sacc[nt][2 * kk][3]);
                        t.z = pk2(sacc[nt][2 * kk + 1][0], sacc[nt][2 * kk + 1][1]); t.w = pk2(sacc[nt][2 * kk + 1][2], sacc[nt][2 * kk + 1][3]); pb[nt][kk] = __builtin_bit_cast(bf16x8, t); }
                }
                { bf16x8 vf[2][2]; const ldsp vbase = Vt + (4 * quad + qq) * 288 + 8 * pp;
#pragma unroll
                  for (int kk = 0; kk < 2; ++kk) vf[0][kk] = cat8(vtr(vbase + (32 * kk) * 288), vtr(vbase + (32 * kk + 16) * 288));
#pragma unroll
                  for (int dt = 0; dt < 8; ++dt) {
                      if (dt < 7) {
#pragma unroll
                          for (int kk = 0; kk < 2; ++kk) vf[(dt + 1) & 1][kk] = cat8(vtr(vbase + (32 * kk) * 288 + 32 * (dt + 1)), vtr(vbase + (32 * kk + 16) * 288 + 32 * (dt + 1))); }
                      __builtin_amdgcn_sched_barrier(0);
#pragma unroll
                      for (int kk = 0; kk < 2; ++kk) { oacc[0][dt] = mfma16(vf[dt & 1][kk], pb[0][kk], oacc[0][dt]); oacc[1][dt] = mfma16(vf[dt & 1][kk], pb[1][kk], oacc[1][dt]); }
                      __builtin_amdgcn_sched_barrier(0);
                  } }
            }
            { ldsp Kn = Kl + (buf ^ 1) * 17408; ldsp Vn = Vl + (buf ^ 1) * 18432;
                *(LAS u32x4*)(Kn + sr * 272 + sc * 16) = kn0; *(LAS u32x4*)(Kn + (sr + 32) * 272 + sc * 16) = kn1;
                *(LAS u32x4*)(Vn + sr * 288 + sc * 16) = vn0; *(LAS u32x4*)(Vn + (sr + 32) * 288 + sc * 16) = vn1; }
            __syncthreads();
        }
#pragma unroll
        for (int nt = 0; nt < 2; ++nt) { float l = lrun[nt]; l += __shfl_xor(l, 16); l += __shfl_xor(l, 32); const float inv = 1.f / l; const size_t row = qrow0 + 32 * wave + 16 * nt + li;
#pragma unroll
            for (int dt = 0; dt < 8; ++dt) { const int col = h * 128 + 16 * dt + 4 * quad; const u32x2 gv = *(const u32x2*)(Gb + row * 2048 + col);
                u32x2 o; o.x = pk2(oacc[nt][dt][0] * inv * bf_lo(gv.x), oacc[nt][dt][1] * inv * bf_hi(gv.x)); o.y = pk2(oacc[nt][dt][2] * inv * bf_lo(gv.y), oacc[nt][dt][3] * inv * bf_hi(gv.y));
                *(u32x2*)(obase + (size_t)((unsigned)row & rmask) * old_ + col) = o; } }
    }
}

__device__ __forceinline__ void ln_phase(const float* Y, const float* g, const float* bta, float* outf, bf16_t* outb, int ldb_) {
    const int lane = threadIdx.x & 63; const int gw = blockIdx.x * 8 + __builtin_amdgcn_readfirstlane(threadIdx.x >> 6), NGW = gridDim.x * 8;
    f32x4 gv[8], bv[8];
#pragma unroll
    for (int k = 0; k < 8; ++k) { gv[k] = ((const f32x4*)g)[lane + 64 * k]; bv[k] = ((const f32x4*)bta)[lane + 64 * k]; }
    for (int row = gw; row < M; row += NGW) { const f32x4* yr = (const f32x4*)(Y + (size_t)row * 2048); f32x4 v[8]; float s = 0.f;
#pragma unroll
        for (int k = 0; k < 8; ++k) { v[k] = yr[lane + 64 * k]; s += (v[k][0] + v[k][1]) + (v[k][2] + v[k][3]); }
#pragma unroll
        for (int o = 1; o < 64; o <<= 1) s += __shfl_xor(s, o);
        const float mu = s * (1.f / 2048.f); float s2 = 0.f;
#pragma unroll
        for (int k = 0; k < 8; ++k) { v[k] = v[k] - mu; s2 += (v[k][0] * v[k][0] + v[k][1] * v[k][1]) + (v[k][2] * v[k][2] + v[k][3] * v[k][3]); }
#pragma unroll
        for (int o = 1; o < 64; o <<= 1) s2 += __shfl_xor(s2, o);
        const float rstd = rsqrtf(s2 * (1.f / 2048.f) + 1e-5f);
#pragma unroll
        for (int k = 0; k < 8; ++k) { const f32x4 o = v[k] * rstd * gv[k] + bv[k]; ((f32x4*)(outf + (size_t)row * 2048))[lane + 64 * k] = o;
            if (outb) { u32x2 ob; ob.x = pk2(o[0], o[1]); ob.y = pk2(o[2], o[3]); ((u32x2*)(outb + (size_t)row * ldb_))[lane + 64 * k] = ob; } }
    }
}

__device__ __forceinline__ void s5_phase(const Params& P, ldsp lds) {
    const int tid = threadIdx.x, wave = __builtin_amdgcn_readfirstlane(tid >> 6), lane = tid & 63, quad = lane >> 4, li = lane & 15, qq = li >> 2, pp = li & 3;
    const bf16_t* U = (const bf16_t*)(P.ws + OFF_K); bf16_t* YG = (bf16_t*)(P.ws + OFF_RB);
    const int sq = wave >> 2, role = (wave + 2 * sq) & 3;
    ldsp BUl = lds + sq * 32768; ldsp Hl = lds + sq * 32768 + 20480; ldsp Rl = lds + 65536 + sq * 8192;
    for (int it0 = blockIdx.x; it0 < 256; it0 += gridDim.x) {
        const int item = it0 + 256 * sq;
        const int b = item >> 7, g = item & 127;
        const float dtg = expf(P.log_dt[g]);
        float lbr = 0.f, lbi = 0.f; bf16x8 bbf[8], cmf[4]; f32x4 dsk = (f32x4){0.f, 0.f, 0.f, 0.f};
        if (role == 1) { const float lr = P.lam_re[g * 64 + lane], lim = P.lam_im[g * 64 + lane]; const float e = expf(lr * dtg); float s_, c_; sincos_d((double)(lim * dtg), s_, c_); lbr = e * c_; lbi = e * s_; }
        if (role == 0) {
            float lr4[4], li4[4]; f32x4 brr[4][2], bir[4][2];
#pragma unroll
            for (int q = 0; q < 4; ++q) { const int n = 16 * q + li; lr4[q] = P.lam_re[g * 64 + n]; li4[q] = P.lam_im[g * 64 + n];
                const float* br = P.b_re + ((size_t)(g * 64 + n)) * 16 + 8 * (quad & 1); const float* bi = P.b_im + ((size_t)(g * 64 + n)) * 16 + 8 * (quad & 1);
                brr[q][0] = *(const f32x4*)br; brr[q][1] = *(const f32x4*)(br + 4); bir[q][0] = *(const f32x4*)bi; bir[q][1] = *(const f32x4*)(bi + 4); }
#pragma unroll
            for (int q = 0; q < 4; ++q) { const float lr = lr4[q], lim = li4[q]; const float e = expf(lr * dtg); float s_, c_; sincos_d((double)(lim * dtg), s_, c_);
                const float ar = e * c_ - 1.f, aim = e * s_; const float den = 1.f / (lr * lr + lim * lim); const float cr = (ar * lr + aim * lim) * den, ci = (aim * lr - ar * lim) * den;
                float ore[8], oim[8];
#pragma unroll
                for (int e2 = 0; e2 < 8; ++e2) { const float xr = brr[q][e2 >> 2][e2 & 3], xi = bir[q][e2 >> 2][e2 & 3]; ore[e2] = cr * xr - ci * xi; oim[e2] = cr * xi + ci * xr; }
                u32x4 tr_ = (u32x4){0u, 0u, 0u, 0u}, ti_ = (u32x4){0u, 0u, 0u, 0u};
                if (quad < 2) { tr_.x = pk2(ore[0], ore[1]); tr_.y = pk2(ore[2], ore[3]); tr_.z = pk2(ore[4], ore[5]); tr_.w = pk2(ore[6], ore[7]);
                                ti_.x = pk2(oim[0], oim[1]); ti_.y = pk2(oim[2], oim[3]); ti_.z = pk2(oim[4], oim[5]); ti_.w = pk2(oim[6], oim[7]); }
                bbf[q] = __builtin_bit_cast(bf16x8, tr_); bbf[q + 4] = __builtin_bit_cast(bf16x8, ti_); }
        }
        if (role == 2) {
            f32x4 cr_[4][2];
#pragma unroll
            for (int ks = 0; ks < 4; ++ks) { const float* cp = (ks < 2 ? P.c_re : P.c_im) + ((size_t)(g * 16 + li)) * 64 + 32 * (ks & 1) + 8 * quad; cr_[ks][0] = *(const f32x4*)cp; cr_[ks][1] = *(const f32x4*)(cp + 4); }
            dsk = *(const f32x4*)(P.s5_d + g * 16 + 4 * quad);
#pragma unroll
            for (int ks = 0; ks < 4; ++ks) { const float sg = ks < 2 ? 1.f : -1.f; const f32x4 a_ = cr_[ks][0] * sg, b_ = cr_[ks][1] * sg;
                u32x4 t; t.x = pk2(a_[0], a_[1]); t.y = pk2(a_[2], a_[3]); t.z = pk2(b_[0], b_[1]); t.w = pk2(b_[2], b_[3]); cmf[ks] = __builtin_bit_cast(bf16x8, t); }
        }
        const bf16_t* ub = U + ((size_t)b * 4096) * 2048 + g * 16;
        bf16_t* yb = YG + ((size_t)b * 4096) * 2048 + g * 16;
        float hr = 0.f, hi = 0.f;
#define S5_BAR() do { asm volatile("s_waitcnt lgkmcnt(0)" ::: "memory"); __builtin_amdgcn_s_barrier(); asm volatile("" ::: "memory"); } while (0)
#define S5_DMA(st) __builtin_amdgcn_global_load_lds((const unsigned*)(ub + (size_t)((st) * 16 + li) * 2048 + 8 * (quad & 1)), (LAS unsigned*)(Rl + ((st) & 7) * 1024), 16, 0, 0)
        if (role == 3) {
            S5_DMA(0); S5_DMA(1); S5_DMA(2); S5_DMA(3);
            asm volatile("s_waitcnt vmcnt(0)" ::: "memory"); S5_BAR();
            for (int s = -1; s <= 256; ++s) { if (s + 5 < 256) S5_DMA(s + 5); asm volatile("s_waitcnt vmcnt(2)" ::: "memory"); S5_BAR(); }
        } else if (role == 0) {
            S5_BAR();
            for (int s = -1; s <= 256; ++s) {
                if (s + 1 < 256) { u32x4 areg = *(const LAS u32x4*)(Rl + ((s + 1) & 7) * 1024 + lane * 16); if (quad >= 2) areg = (u32x4){0u, 0u, 0u, 0u};
                    const bf16x8 a_ = __builtin_bit_cast(bf16x8, areg); ldsp bw_ = BUl + ((s + 1) & 1) * 10240;
#pragma unroll
                    for (int tile = 0; tile < 8; ++tile) { const f32x4 bu = mfma16(a_, bbf[tile], (f32x4){0.f, 0.f, 0.f, 0.f}); *(LAS f32x4*)(bw_ + (16 * tile + li) * 80 + 16 * quad) = bu; } }
                S5_BAR(); }
        } else if (role == 1) {
            S5_BAR();
            for (int s = -1; s <= 256; ++s) {
                if (s >= 0 && s < 256) { f32x4 br[4], bi[4]; ldsp br_ = BUl + (s & 1) * 10240;
#pragma unroll
                    for (int q = 0; q < 4; ++q) { br[q] = *(const LAS f32x4*)(br_ + lane * 80 + 16 * q); bi[q] = *(const LAS f32x4*)(br_ + (64 + lane) * 80 + 16 * q); }
                    float hrs[16], his[16];
#pragma unroll
                    for (int t = 0; t < 16; ++t) { const float nr = lbr * hr - lbi * hi + br[t >> 2][t & 3], ni = lbr * hi + lbi * hr + bi[t >> 2][t & 3]; hr = nr; hi = ni; hrs[t] = hr; his[t] = hi; }
                    ldsp hw_ = Hl + (s & 1) * 6144;
#pragma unroll
                    for (int q = 0; q < 2; ++q) { u32x4 wr_, wi_;
                        wr_.x = pk2(hrs[8 * q + 0], hrs[8 * q + 1]); wr_.y = pk2(hrs[8 * q + 2], hrs[8 * q + 3]); wr_.z = pk2(hrs[8 * q + 4], hrs[8 * q + 5]); wr_.w = pk2(hrs[8 * q + 6], hrs[8 * q + 7]);
                        wi_.x = pk2(his[8 * q + 0], his[8 * q + 1]); wi_.y = pk2(his[8 * q + 2], his[8 * q + 3]); wi_.z = pk2(his[8 * q + 4], his[8 * q + 5]); wi_.w = pk2(his[8 * q + 6], his[8 * q + 7]);
                        *(LAS u32x4*)(hw_ + lane * 48 + 16 * q) = wr_; *(LAS u32x4*)(hw_ + (64 + lane) * 48 + 16 * q) = wi_; } }
                S5_BAR(); }
        } else {
            S5_BAR();
            for (int s = -1; s <= 256; ++s) {
                if (s >= 1) { const u32x2 uu = *(const LAS u32x2*)(Rl + ((s - 1) & 7) * 1024 + (li + 16 * (quad >> 1)) * 16 + 8 * (quad & 1));
                    ldsp hp_ = Hl + ((s - 1) & 1) * 6144; f32x4 yacc = (f32x4){0.f, 0.f, 0.f, 0.f};
#pragma unroll
                    for (int ks = 0; ks < 4; ++ks) { const int r0 = 32 * ks + 8 * quad + qq; const bf16x8 bop = cat8(vtr(hp_ + r0 * 48 + 8 * pp), vtr(hp_ + (r0 + 4) * 48 + 8 * pp)); yacc = mfma16(cmf[ks], bop, yacc); }
                    const float y0 = yacc[0] + dsk[0] * bf_lo(uu.x), y1 = yacc[1] + dsk[1] * bf_hi(uu.x), y2 = yacc[2] + dsk[2] * bf_lo(uu.y), y3 = yacc[3] + dsk[3] * bf_hi(uu.y);
                    u32x2 o; o.x = pk2(gelu_tanh_f(y0), gelu_tanh_f(y1)); o.y = pk2(gelu_tanh_f(y2), gelu_tanh_f(y3)); *(u32x2*)(yb + (size_t)((s - 1) * 16 + li) * 2048 + 4 * quad) = o; }
                S5_BAR(); }
        }
#undef S5_BAR
#undef S5_DMA
        asm volatile("s_waitcnt vmcnt(0) lgkmcnt(0)" ::: "memory"); __syncthreads();
    }
}

template <class Epi> __device__ __forceinline__ void run_gemm(ldsp lds, const bf16_t* A, int lda, const bf16_t* Bt, int ldb, int N, int K, const Epi& E) {
    pg8::Gemm g; g.A = A; g.Bt = Bt; g.M = M; g.N = N; g.K = K; g.lda = lda; g.ldb = ldb; g.alias_a = 0;
    pg8::StaticOrder S; S.init(M, N, (int)gridDim.x, (int)blockIdx.x);
#if GEMM_SKEW_TICKS > 0
    {
      const unsigned sk = (unsigned)GEMM_SKEW_TICKS * (((blockIdx.x >> 3) & 7u) + ((blockIdx.x >> 6) & 3u));
      if (threadIdx.x == 0) { const unsigned long long t0 = __builtin_amdgcn_s_memrealtime(); while (__builtin_amdgcn_s_memrealtime() - t0 < sk) __builtin_amdgcn_s_sleep(8); }
      __syncthreads(); }
#endif
    pg8::gemm_phase<Epi, pg8::StaticOrder, false>(lds, g, S, E, nullptr);
}

__device__ __forceinline__ void gsync(cg::grid_group& grid) {
    asm volatile("s_waitcnt vmcnt(0) lgkmcnt(0)" ::: "memory");
    __syncthreads();
    if (threadIdx.x < 64) { __builtin_amdgcn_fence(__ATOMIC_RELEASE, "agent"); asm volatile("s_waitcnt vmcnt(0)" ::: "memory"); }
    grid.sync();
#if GSYNC_WAVE_ACQ
    __builtin_amdgcn_fence(__ATOMIC_ACQUIRE, ""); asm volatile("s_waitcnt vmcnt(0)" ::: "memory");
#else
    if (threadIdx.x < 64) { __builtin_amdgcn_fence(__ATOMIC_ACQUIRE, "agent"); asm volatile("s_waitcnt vmcnt(0)" ::: "memory"); }
#endif
    __syncthreads();
}
#ifndef REP_P0
#define REP_P0 1
#endif
#ifndef REP_IN0
#define REP_IN0 1
#endif
#ifndef REP_CONV
#define REP_CONV 1
#endif
#ifndef REP_MOBA_DUMMY
#define REP_MOBA_DUMMY 0
#endif
#ifndef REP_SSDA
#define REP_SSDA 1
#endif
#ifndef REP_SSDB
#define REP_SSDB 1
#endif
#ifndef REP_LN0
#define REP_LN0 1
#endif
#ifndef REP_IN1
#define REP_IN1 1
#endif
#ifndef REP_S5
#define REP_S5 1
#endif
#ifndef PHASE_MASK
#define PHASE_MASK 0x3fff
#endif
#if defined(__HIP_DEVICE_COMPILE__)
#define GETP() ({ const __attribute__((address_space(4))) Params* kp_ = (const __attribute__((address_space(4))) Params*)__builtin_amdgcn_kernarg_segment_ptr(); asm volatile("" : "+s"(kp_)); *kp_; })
#else
#define GETP() (P_unused)
#endif
__global__ void __launch_bounds__(512, 2) mega_fwd(Params P_unused) {
    constexpr int PM = PHASE_MASK;
    extern __shared__ __attribute__((aligned(16))) unsigned char shm[];
    ldsp lds = (ldsp)shm;
    cg::grid_group grid = cg::this_grid();
    for (int rep = 0; rep < REP_P0; ++rep) { const Params P = GETP(); p0_phase(P, lds); }
    gsync(grid);
    for (int rep = 0; rep < REP_IN0; ++rep) { const Params P = GETP(); unsigned char* ws = P.ws;
      EpiIn0 E; E.A0 = (bf16_t*)P.out; E.XBCraw = (bf16_t*)(ws + OFF_RB); E.Kb = (bf16_t*)(ws + OFF_K); E.Vb = (bf16_t*)(ws + OFF_V); E.Gb = (bf16_t*)(ws + OFF_G);
      E.DTf = (float*)(ws + OFF_DT); E.kmean = (float*)(ws + OFF_KM); E.ctab = (const float*)(ws + OFF_CT); E.stab = (const float*)(ws + OFF_STB); E.dt_bias = P.dt_bias;
      run_gemm(lds, (const bf16_t*)(ws + OFF_XB), 2048, (const bf16_t*)(ws + OFF_W0T), 2048, N0P, 2048, E);
      { const int G = (int)gridDim.x, rem = (64 * (N0P / 256)) % G;
        if (rem == 0) late_transposes(P, lds, (int)blockIdx.x, G); else if ((int)blockIdx.x >= rem) late_transposes(P, lds, (int)blockIdx.x - rem, G - rem); } }
    gsync(grid);
    for (int rep = 0; rep < REP_CONV; ++rep) { const Params P = GETP(); conv_phase(P); }
    gsync(grid);
    for (int rep = 0; rep < REP_MOBA_DUMMY; ++rep) { const Params P = GETP(); moba_phase(P, lds, (bf16_t*)(P.ws + WS_END), 2048, 4095u); }
    if (PM & 8) { const Params P = GETP(); moba_phase(P, lds, (bf16_t*)P.out + 2048, 4096, 0xffffffffu); }
    for (int rep = 0; rep < REP_SSDA; ++rep) { const Params P = GETP(); ssd_a_phase(P, lds); }
    gsync(grid);
    for (int rep = 0; rep < REP_SSDB; ++rep) { const Params P = GETP(); ssd_b_phase(P); }
    gsync(grid);
    if (PM & 64) { const Params P = GETP(); ssd_c_phase(P, lds); }
    gsync(grid);
    if (PM & 128) { const Params P = GETP(); unsigned char* ws = P.ws;
      EpiOut<32> E; E.resid = P.x; E.Y = (float*)(ws + OFF_K); E.rsl = (const LAS float*)(lds + 131072);
      { pg8::StaticOrder S; S.init(M, 2048, (int)gridDim.x, (int)blockIdx.x); const float* ssq = (const float*)(ws + OFF_SSQ); LAS float* rw = (LAS float*)(lds + 131072);
        for (int q = threadIdx.x; q < 2048; q += 512) { const int ui = q >> 8; Unit u; if (S.next(ui, u)) { const f32x4* p = (const f32x4*)(ssq + (size_t)(u.pm * 256 + (q & 255)) * 32); float sm = 0.f;
#pragma unroll
            for (int k = 0; k < 8; ++k) { const f32x4 v = p[k]; sm += (v[0] + v[1]) + (v[2] + v[3]); }
            rw[q] = rsqrtf(sm * (1.f / 2048.f) + 1e-5f); } }
        __syncthreads(); }
      run_gemm(lds, (const bf16_t*)P.out, 4096, (const bf16_t*)(ws + OFF_WO0), 4096, 2048, 4096, E); }
    gsync(grid);
    for (int rep = 0; rep < REP_LN0; ++rep) { const Params P = GETP(); unsigned char* ws = P.ws; ln_phase((const float*)(ws + OFF_K), P.ln_g, P.ln_b, P.out, (bf16_t*)(ws + X1B_OFF), X1B_LD); }
    gsync(grid);
#ifdef PROBE_L2GEMM
    { const Params P = GETP(); unsigned char* ws = P.ws; EpiIn1 E; E.U = (bf16_t*)(ws + OFF_XB); E.SG = (bf16_t*)(ws + OFF_RB);
      pg8::Gemm g; g.A = (const bf16_t*)(ws + X1B_OFF); g.Bt = (const bf16_t*)(ws + W1_OFF); g.M = M; g.N = 4096; g.K = 2048; g.lda = X1B_LD; g.ldb = W1_LD; g.alias_a = 1;
      pg8::StaticOrder S; S.init(M, 4096, (int)gridDim.x, (int)blockIdx.x); pg8::gemm_phase<EpiIn1, pg8::StaticOrder, false>(lds, g, S, E, nullptr); }
#endif
    for (int rep = 0; rep < REP_IN1; ++rep) { const Params P = GETP(); unsigned char* ws = P.ws;
      EpiIn1 E; E.U = (bf16_t*)(ws + OFF_K); E.SG = (bf16_t*)(ws + OFF_V);
      run_gemm(lds, (const bf16_t*)(ws + X1B_OFF), X1B_LD, (const bf16_t*)(ws + W1_OFF), W1_LD, 4096, 2048, E); }
    gsync(grid);
    for (int rep = 0; rep < REP_S5; ++rep) { const Params P = GETP(); s5_phase(P, lds); }
    gsync(grid);
    if (PM & 2048) { const Params P = GETP(); unsigned char* ws = P.ws;
      EpiGlu E; E.A1 = (bf16_t*)(ws + OFF_XB); E.SG = (const bf16_t*)(ws + OFF_V);
      run_gemm(lds, (const bf16_t*)(ws + OFF_RB), 2048, (const bf16_t*)(ws + OFF_WG), 2048, 4096, 2048, E); }
    gsync(grid);
    if (PM & 4096) { const Params P = GETP(); unsigned char* ws = P.ws;
      EpiOut<-1> E; E.resid = P.out; E.Y = (float*)(ws + OFF_K); E.rsl = nullptr;
      run_gemm(lds, (const bf16_t*)(ws + OFF_XB), 2048, (const bf16_t*)(ws + OFF_WO1), 2048, 2048, 2048, E); }
    gsync(grid);
    if (PM & 8192) { const Params P = GETP(); unsigned char* ws = P.ws; ln_phase((const float*)(ws + OFF_K), P.ln_g + 2048, P.ln_b + 2048, P.out, nullptr, 0); }
}

extern "C" void kernel_launch(void* const* d_in, const int* in_sizes, int n_in, void* d_out, int out_size, void* d_ws, size_t ws_size, hipStream_t stream) {
    static int grid_blocks = 0;
    if (grid_blocks == 0) {
        if (n_in != 22 || out_size != M * DM || ws_size < WS_END) { fprintf(stderr, "kernel_launch: unexpected shapes (n_in %d out %d ws %zu need %zu)\n", n_in, out_size, ws_size, (size_t)WS_END); grid_blocks = -1; return; }
        int dev = 0, cus = 0, per_cu = 0;
        hipGetDevice(&dev); hipDeviceGetAttribute(&cus, hipDeviceAttributeMultiprocessorCount, dev);
        if (hipFuncSetAttribute((const void*)mega_fwd, hipFuncAttributeMaxDynamicSharedMemorySize, LDS_BYTES) != hipSuccess) { fprintf(stderr, "kernel_launch: hipFuncSetAttribute failed\n"); grid_blocks = -1; return; }
        if (hipOccupancyMaxActiveBlocksPerMultiprocessor(&per_cu, (const void*)mega_fwd, 512, LDS_BYTES) != hipSuccess || per_cu < 1) { fprintf(stderr, "kernel_launch: occupancy query failed (%d)\n", per_cu); (void)hipGetLastError(); per_cu = 1; }
        grid_blocks = cus * 1;
        if (grid_blocks > 256) grid_blocks = 256;
    }
    if (grid_blocks < 0) return;
    Params p{};
    const float** pp = (const float**)&p;
    for (int i = 0; i < 22; ++i) pp[i] = (const float*)d_in[i];
    p.out = (float*)d_out; p.ws = (unsigned char*)d_ws;
    void* args[] = {&p};
    hipError_t e = hipLaunchCooperativeKernel((const void*)mega_fwd, dim3(grid_blocks), dim3(512), args, LDS_BYTES, stream);
    if (e != hipSuccess) fprintf(stderr, "cooperative launch failed: %s (grid %d)\n", hipGetErrorString(e), grid_blocks);
}
```
